# Optimizing an MI355X kernel written in HIP

```python
import math
import numpy as np
import jax, jax.numpy as jnp
from jax import lax

D_MODEL = 1024
BATCH = 4
SEQ = 8192
DEPTH = 2

D_MIX = D_MODEL
RG_WIDTH = D_MIX // 2
RG_BLOCKS = 8
RG_BLOCK = RG_WIDTH // RG_BLOCKS
CONV_W = 4
RG_C = 8.0
A_MIN = 0.9
A_MAX = 0.999

NSA_WIDTH = D_MIX - RG_WIDTH
HEAD_DIM = 64
N_HEADS = NSA_WIDTH // HEAD_DIM
N_KV = 2
HPG = N_HEADS // N_KV
KV_WIDTH = N_KV * HEAD_DIM
ROPE_DIM = HEAD_DIM // 4
ROPE_THETA = 500000.0
CMP_LEN = 32
CMP_STRIDE = 16
CMP_HIDDEN = 2 * HEAD_DIM
SEL_LEN = 64
SEL_TOPN = 16
WINDOW = 512
N_BRANCH = 3
Q_BLOCK = 128
EPS = 1e-6
NEG = -1e30
BIG = 1e30
N_IN = 2 * RG_WIDTH + 2 * NSA_WIDTH + 6 * KV_WIDTH + N_BRANCH * N_HEADS

kernel_name = "hybrid_rglru_nsa_parallel_heads"


def rms_norm(x, g):
    xf = x.astype(jnp.float32)
    y = xf * lax.rsqrt(jnp.mean(xf * xf, axis=-1, keepdims=True) + EPS)
    return (y * g.astype(jnp.float32)).astype(x.dtype)


def rope_partial(x, pos):
    half = ROPE_DIM // 2
    inv = ROPE_THETA ** (-jnp.arange(half, dtype=jnp.float32) / half)
    ang = pos[:, None] * inv[None, :]
    cos, sin = jnp.cos(ang), jnp.sin(ang)
    xf = x.astype(jnp.float32)
    x1, x2, xp = xf[..., :half], xf[..., half:ROPE_DIM], xf[..., ROPE_DIM:]
    out = jnp.concatenate([x1 * cos - x2 * sin, x2 * cos + x1 * sin, xp], axis=-1)
    return out.astype(x.dtype)


def masked_softmax(s, mask):
    s = jnp.where(mask, s.astype(jnp.float32), NEG)
    return jax.nn.softmax(s, axis=-1) * mask


def causal_depthwise_conv(x, w, b):
    S = x.shape[1]
    xp = jnp.pad(x, ((0, 0), (CONV_W - 1, 0), (0, 0)))
    y = sum(xp[:, k:k + S] * w[k] for k in range(CONV_W))
    return y + b


def rg_lru(x, w_r, b_r, w_i, b_i, lam):
    B, S, C = x.shape
    xb = x.reshape(B, S, RG_BLOCKS, RG_BLOCK)
    r = jax.nn.sigmoid(jnp.einsum('bsnc,ncd->bsnd', xb, w_r).reshape(B, S, C) + b_r)
    i = jax.nn.sigmoid(jnp.einsum('bsnc,ncd->bsnd', xb, w_i).reshape(B, S, C) + b_i)
    log_a = (-RG_C * r.astype(jnp.float32)) * jax.nn.softplus(-lam.astype(jnp.float32))
    a = jnp.exp(log_a)
    u = jnp.sqrt(-jnp.expm1(2.0 * log_a)) * (i * x).astype(jnp.float32)

    def combine(left, right):
        a1, b1 = left
        a2, b2 = right
        return a1 * a2, a2 * b1 + b2

    _, h = lax.associative_scan(combine, (a, u), axis=1)
    return h.astype(x.dtype)


def compress_blocks(blocks, pe, w1, w2):
    z = (blocks + pe).reshape(blocks.shape[:-2] + (CMP_LEN * HEAD_DIM,))
    return jax.nn.silu(z @ w1) @ w2


def nsa(q, k_c, v_c, k_s, v_s, k_w, v_w, gates, q_g, k_g,
        pe_k, w1_k, w2_k, pe_v, w1_v, w2_v):
    B, S, _ = q.shape
    pos = jnp.arange(S, dtype=jnp.float32)
    scale = 1.0 / math.sqrt(HEAD_DIM)
    n_cmp = (S - CMP_LEN) // CMP_STRIDE + 1
    n_sel = S // SEL_LEN
    top_n = min(SEL_TOPN, n_sel)
    n_qb = S // Q_BLOCK

    def kv_heads(t):
        return t.reshape(B, S, N_KV, HEAD_DIM).transpose(0, 2, 1, 3)

    qh = q.reshape(B, S, N_KV, HPG, HEAD_DIM).transpose(0, 2, 3, 1, 4)
    qh = rope_partial(rms_norm(qh, q_g), pos)

    blk_idx = np.arange(n_cmp)[:, None] * CMP_STRIDE + np.arange(CMP_LEN)[None, :]
    kc = compress_blocks(kv_heads(k_c)[:, :, blk_idx], pe_k, w1_k, w2_k)
    vc = compress_blocks(kv_heads(v_c)[:, :, blk_idx], pe_v, w1_v, w2_v)
    cmp_end = jnp.arange(n_cmp) * CMP_STRIDE + (CMP_LEN - 1)
    kc = rope_partial(rms_norm(kc, k_g[0]), cmp_end.astype(jnp.float32))

    cs = np.arange(n_cmp)[:, None] * CMP_STRIDE
    ss = np.arange(n_sel)[None, :] * SEL_LEN
    ov = np.maximum(0, np.minimum(cs + CMP_LEN, ss + SEL_LEN) - np.maximum(cs, ss))
    overlap = jnp.asarray((ov / CMP_LEN).astype(np.float32))

    ks = rope_partial(rms_norm(kv_heads(k_s), k_g[1]), pos)
    ks_blk = ks.reshape(B, N_KV, n_sel, SEL_LEN * HEAD_DIM)
    vs_blk = kv_heads(v_s).reshape(B, N_KV, n_sel, SEL_LEN * HEAD_DIM)

    kw = rope_partial(rms_norm(kv_heads(k_w), k_g[2]), pos)
    kw_pad = jnp.pad(kw, ((0, 0), (0, 0), (WINDOW, 0), (0, 0)))
    vw_pad = jnp.pad(kv_heads(v_w), ((0, 0), (0, 0), (WINDOW, 0), (0, 0)))

    g = jax.nn.sigmoid(gates).reshape(B, S, N_KV, HPG, N_BRANCH).transpose(0, 2, 3, 1, 4)
    j_sel = jnp.arange(n_sel)

    def q_block(qi):
        q0 = qi * Q_BLOCK
        t = q0 + jnp.arange(Q_BLOCK)
        qb = lax.dynamic_slice_in_dim(qh, q0, Q_BLOCK, axis=3)
        gb = lax.dynamic_slice_in_dim(g, q0, Q_BLOCK, axis=3)
        s_c = jnp.einsum('bghqd,bgkd->bghqk', qb, kc) * scale
        p_c = masked_softmax(s_c, cmp_end[None, :] <= t[:, None])
        o_c = jnp.einsum('bghqk,bgkd->bghqd', p_c.astype(vc.dtype), vc)
        imp = jnp.einsum('bghqk,kj->bgqj', p_c, overlap)
        bt = (t // SEL_LEN)[:, None]
        force = (j_sel[None, :] == 0) | (j_sel[None, :] == bt) | (j_sel[None, :] == bt - 1)
        imp = jnp.where(force, BIG, jnp.where(j_sel[None, :] <= bt, imp, NEG))
        _, idx = lax.top_k(imp, top_n)
        flat = idx.reshape(B, N_KV, Q_BLOCK * top_n)[..., None]
        kg = jnp.take_along_axis(ks_blk, flat, axis=2).reshape(
            B, N_KV, Q_BLOCK, top_n * SEL_LEN, HEAD_DIM)
        vg = jnp.take_along_axis(vs_blk, flat, axis=2).reshape(
            B, N_KV, Q_BLOCK, top_n * SEL_LEN, HEAD_DIM)
        kpos = (idx[..., None] * SEL_LEN + jnp.arange(SEL_LEN)).reshape(
            B, N_KV, Q_BLOCK, top_n * SEL_LEN)
        m_s = (kpos <= t[None, None, :, None])[:, :, None]
        s_s = jnp.einsum('bghqd,bgqkd->bghqk', qb, kg) * scale
        p_s = masked_softmax(s_s, m_s)
        o_s = jnp.einsum('bghqk,bgqkd->bghqd', p_s.astype(vg.dtype), vg)
        kwb = lax.dynamic_slice_in_dim(kw_pad, q0, WINDOW + Q_BLOCK, axis=2)
        vwb = lax.dynamic_slice_in_dim(vw_pad, q0, WINDOW + Q_BLOCK, axis=2)
        kp = (q0 - WINDOW + jnp.arange(WINDOW + Q_BLOCK))[None, :]
        m_w = (kp <= t[:, None]) & (kp > t[:, None] - WINDOW) & (kp >= 0)
        s_w = jnp.einsum('bghqd,bgkd->bghqk', qb, kwb) * scale
        p_w = masked_softmax(s_w, m_w)
        o_w = jnp.einsum('bghqk,bgkd->bghqd', p_w.astype(vwb.dtype), vwb)
        return gb[..., 0:1] * o_c + gb[..., 1:2] * o_s + gb[..., 2:3] * o_w

    outs = lax.map(q_block, jnp.arange(n_qb))
    return outs.transpose(1, 0, 4, 2, 3, 5).reshape(B, S, NSA_WIDTH)


def hybrid_layer(x, norm_g, w_in, conv_w, conv_b, rg_wr, rg_br, rg_wi, rg_bi, rg_lam,
                 q_g, k_g, pe_k, w1_k, w2_k, pe_v, w1_v, w2_v, w_out):
    h = rms_norm(x, norm_g)
    z = h @ w_in
    sizes = [RG_WIDTH, RG_WIDTH, NSA_WIDTH] + [KV_WIDTH] * 6 + [NSA_WIDTH]
    cuts = list(np.cumsum(sizes))
    (rg_x, rg_gate, q, k_c, v_c, k_s, v_s, k_w, v_w, nsa_gate, br_gate) = jnp.split(
        z, cuts, axis=-1)
    y_a = rg_lru(causal_depthwise_conv(rg_x, conv_w, conv_b), rg_wr, rg_br, rg_wi, rg_bi, rg_lam)
    y_a = y_a * jax.nn.silu(rg_gate)
    y_b = nsa(q, k_c, v_c, k_s, v_s, k_w, v_w, br_gate, q_g, k_g,
              pe_k, w1_k, w2_k, pe_v, w1_v, w2_v)
    y_b = y_b * jax.nn.silu(nsa_gate)
    y = jnp.concatenate([y_a, y_b], axis=-1)
    return x + y @ w_out


def setup_inputs(seed: int = 0) -> dict:
    key = jax.random.key(seed)
    ks = jax.random.split(key, 20)
    f32 = jnp.float32
    n = jax.random.normal
    a0 = jax.random.uniform(ks[10], (DEPTH, RG_WIDTH), f32, A_MIN, A_MAX)
    s0 = a0 ** (1.0 / RG_C)
    return {
        "x": n(ks[0], (BATCH, SEQ, D_MODEL), f32),
        "norm_g": 1.0 + 0.02 * n(ks[1], (DEPTH, D_MODEL), f32),
        "w_in": n(ks[2], (DEPTH, D_MODEL, N_IN), f32) * D_MODEL ** -0.5,
        "conv_w": n(ks[3], (DEPTH, CONV_W, RG_WIDTH), f32) * CONV_W ** -0.5,
        "conv_b": 0.01 * n(ks[4], (DEPTH, RG_WIDTH), f32),
        "rg_wr": n(ks[5], (DEPTH, RG_BLOCKS, RG_BLOCK, RG_BLOCK), f32) * RG_BLOCK ** -0.5,
        "rg_br": 0.01 * n(ks[6], (DEPTH, RG_WIDTH), f32),
        "rg_wi": n(ks[7], (DEPTH, RG_BLOCKS, RG_BLOCK, RG_BLOCK), f32) * RG_BLOCK ** -0.5,
        "rg_bi": 0.01 * n(ks[8], (DEPTH, RG_WIDTH), f32),
        "rg_lambda": jnp.log(s0) - jnp.log1p(-s0),
        "q_norm_g": 1.0 + 0.02 * n(ks[9], (DEPTH, HEAD_DIM), f32),
        "k_norm_g": 1.0 + 0.02 * n(ks[11], (DEPTH, N_BRANCH, HEAD_DIM), f32),
        "cmp_pe_k": 0.02 * n(ks[12], (DEPTH, CMP_LEN, HEAD_DIM), f32),
        "cmp_w1_k": n(ks[13], (DEPTH, CMP_LEN * HEAD_DIM, CMP_HIDDEN), f32) * (CMP_LEN * HEAD_DIM) ** -0.5,
        "cmp_w2_k": n(ks[14], (DEPTH, CMP_HIDDEN, HEAD_DIM), f32) * CMP_HIDDEN ** -0.5,
        "cmp_pe_v": 0.02 * n(ks[15], (DEPTH, CMP_LEN, HEAD_DIM), f32),
        "cmp_w1_v": n(ks[16], (DEPTH, CMP_LEN * HEAD_DIM, CMP_HIDDEN), f32) * (CMP_LEN * HEAD_DIM) ** -0.5,
        "cmp_w2_v": n(ks[17], (DEPTH, CMP_HIDDEN, HEAD_DIM), f32) * CMP_HIDDEN ** -0.5,
        "w_out": n(ks[18], (DEPTH, D_MIX, D_MODEL), f32) * D_MIX ** -0.5,
    }


def reference(x, norm_g, w_in, conv_w, conv_b, rg_wr, rg_br, rg_wi, rg_bi, rg_lambda,
              q_norm_g, k_norm_g, cmp_pe_k, cmp_w1_k, cmp_w2_k, cmp_pe_v, cmp_w1_v,
              cmp_w2_v, w_out):
    for l in range(DEPTH):
        x = hybrid_layer(x, norm_g[l], w_in[l], conv_w[l], conv_b[l], rg_wr[l], rg_br[l],
                         rg_wi[l], rg_bi[l], rg_lambda[l], q_norm_g[l], k_norm_g[l],
                         cmp_pe_k[l], cmp_w1_k[l], cmp_w2_k[l], cmp_pe_v[l], cmp_w1_v[l],
                         cmp_w2_v[l], w_out[l])
    return x
```

```cpp
#include <hip/hip_runtime.h>
#include <hip/hip_cooperative_groups.h>
#include <stdint.h>
#include <stdio.h>
namespace cg = cooperative_groups;

typedef unsigned short bf16_t;
typedef short bf16x8 __attribute__((ext_vector_type(8)));
typedef float f32x4 __attribute__((ext_vector_type(4)));
typedef unsigned u32x4 __attribute__((ext_vector_type(4)));
typedef unsigned u32x2 __attribute__((ext_vector_type(2)));

constexpr int NB = 4, SEQ = 8192, NT = NB * SEQ, DM = 1024, DEPTH = 2;
constexpr int NIN = 2840, ZW = 2944;
constexpr int C_RGX = 0, C_RGG = 512, C_Q = 1024, C_KC = 1536, C_VC = 1664, C_KS = 1792, C_VS = 1920, C_KW = 2048, C_VW = 2176,
              C_NG = 2304, C_BG = 2816;
constexpr int NCH = SEQ / 64;
constexpr float EPS = 1e-6f;
constexpr float LOG2E = 1.4426950408889634f;

constexpr size_t AL(size_t x) { return (x + 255) & ~(size_t)255; }
constexpr size_t WS_WTIN = 0;
constexpr size_t WS_WTOUT = WS_WTIN + AL((size_t)DEPTH * ZW * DM * 2);
constexpr size_t WS_ROPE = WS_WTOUT + AL((size_t)DEPTH * DM * DM * 2);
constexpr size_t WS_W1T = WS_ROPE + AL((size_t)SEQ * 16 * 4);
constexpr size_t WS_B1 = WS_W1T + AL((size_t)DEPTH * 2 * 128 * 2048 * 2);
constexpr size_t WS_W2P = WS_B1 + AL((size_t)DEPTH * 2 * 128 * 4);
constexpr size_t WS_RGW = WS_W2P + AL((size_t)DEPTH * 2 * 8192 * 2);
constexpr size_t WS_SP = WS_RGW + AL((size_t)DEPTH * 2 * 8 * 4096 * 2);
constexpr size_t WS_MB = WS_SP + AL((size_t)DEPTH * 512 * 4);
constexpr size_t WS_XB = WS_MB + AL(256);
constexpr size_t WS_RSTD = WS_XB + AL((size_t)NT * DM * 2);
constexpr size_t WS_Z = WS_RSTD + AL((size_t)NT * 4);
constexpr size_t WS_QN = WS_Z + AL((size_t)NT * ZW * 2);
constexpr size_t WS_KS = WS_QN + AL((size_t)NT * 512 * 2);
constexpr size_t WS_KW = WS_KS + AL((size_t)NT * 128 * 2);
constexpr size_t WS_VST = WS_KW + AL((size_t)NT * 128 * 2);
constexpr size_t WS_VWT = WS_VST + AL((size_t)NT * 128 * 2);
constexpr size_t WS_KC = WS_VWT + AL((size_t)NT * 128 * 2);
constexpr size_t WS_VCT = WS_KC + AL((size_t)8 * 512 * 64 * 2);
constexpr size_t WS_HLOC = WS_VCT + AL((size_t)8 * 512 * 64 * 2);
constexpr size_t WS_PC = WS_HLOC + AL((size_t)NT * 512 * 2);
constexpr size_t WS_SUMH = WS_PC + AL((size_t)NT * 512 * 2);
constexpr size_t WS_SUMP = WS_SUMH + AL((size_t)NB * NCH * 512 * 4);
constexpr size_t WS_Y = WS_SUMP + AL((size_t)NB * NCH * 512 * 4);
constexpr size_t WS_END = WS_Y + AL((size_t)NT * DM * 2);

struct Params {
    const float *x, *norm_g, *w_in, *conv_w, *conv_b, *rg_wr, *rg_br, *rg_wi, *rg_bi, *rg_lam, *q_g, *k_g, *pe_k, *w1_k, *w2_k, *pe_v,
        *w1_v, *w2_v, *w_out;
    float* out;
    unsigned char* ws;
};

__device__ __forceinline__ unsigned pk2(float lo, float hi) {
    unsigned r;
    asm volatile("v_cvt_pk_bf16_f32 %0, %1, %2" : "=v"(r) : "v"(lo), "v"(hi));
    return r;
}
__device__ __forceinline__ bf16_t f2bf(float f) { return (bf16_t)(pk2(f, 0.f) & 0xffffu); }
__device__ __forceinline__ float bf2f(unsigned h) { return __uint_as_float(h << 16); }
__device__ __forceinline__ float bflo(unsigned w) { return __uint_as_float(w << 16); }
__device__ __forceinline__ float bfhi(unsigned w) { return __uint_as_float(w & 0xffff0000u); }
__device__ __forceinline__ float sigmoidf_(float v) { return 1.f / (1.f + __expf(-v)); }
__device__ __forceinline__ float siluf_(float v) { return v / (1.f + __expf(-v)); }
__device__ __forceinline__ bf16x8 as_bf16x8(u32x4 v) { return __builtin_bit_cast(bf16x8, v); }
#define MFMA16(a, b, c) __builtin_amdgcn_mfma_f32_16x16x32_bf16((a), (b), (c), 0, 0, 0)
#define LDS_FENCE() asm volatile("s_waitcnt lgkmcnt(0)" ::: "memory")

__device__ __forceinline__ void transpose_items(const float* W, int K, int N, int Npad, const float* kscale, bf16_t* Wt, int gtid, int gthreads) {
    const int total = (K / 8) * Npad;
    for (int it = gtid; it < total; it += gthreads) {
        const int n = it % Npad, kc = it / Npad;
        float v[8];
#pragma unroll
        for (int i = 0; i < 8; ++i) {
            const int k = kc * 8 + i;
            float w = (n < N) ? W[(size_t)k * N + n] : 0.f;
            if (kscale) w *= kscale[k];
            v[i] = w;
        }
        u32x4 o;
        o.x = pk2(v[0], v[1]); o.y = pk2(v[2], v[3]); o.z = pk2(v[4], v[5]); o.w = pk2(v[6], v[7]);
        *(u32x4*)(Wt + (size_t)n * K + kc * 8) = o;
    }
}

__device__ __forceinline__ void xrow_item(const float* xr, bf16_t* xb, float* rstd, int lane) {
    const f32x4* p = (const f32x4*)xr;
    f32x4 v[4];
    float s = 0.f;
#pragma unroll
    for (int j = 0; j < 4; ++j) { v[j] = p[j * 64 + lane]; s += v[j].x * v[j].x + v[j].y * v[j].y + v[j].z * v[j].z + v[j].w * v[j].w; }
#pragma unroll
    for (int o = 1; o < 64; o <<= 1) s += __shfl_xor(s, o);
    u32x2* q = (u32x2*)xb;
#pragma unroll
    for (int j = 0; j < 4; ++j) { u32x2 w; w.x = pk2(v[j].x, v[j].y); w.y = pk2(v[j].z, v[j].w); q[j * 64 + lane] = w; }
    if (lane == 0) *rstd = 1.0f / sqrtf(s * (1.0f / DM) + EPS);
}

__device__ __forceinline__ void phase_xprep(const Params& p, const float* xin) {
    const int lane = threadIdx.x & 63, gw = blockIdx.x * 4 + (threadIdx.x >> 6), nw = gridDim.x * 4;
    bf16_t* xb = (bf16_t*)(p.ws + WS_XB);
    float* rstd = (float*)(p.ws + WS_RSTD);
    for (int r = gw; r < NT; r += nw) xrow_item(xin + (size_t)r * DM, xb + (size_t)r * DM, rstd + r, lane);
}

__device__ __forceinline__ void phase_prologue(const Params& p) {
    const int gtid = blockIdx.x * 256 + threadIdx.x, gth = gridDim.x * 256;
    for (int l = 0; l < DEPTH; ++l) {
        transpose_items(p.w_in + (size_t)l * DM * NIN, DM, NIN, ZW, p.norm_g + l * DM, (bf16_t*)(p.ws + WS_WTIN) + (size_t)l * ZW * DM, gtid, gth);
        transpose_items(p.w_out + (size_t)l * DM * DM, DM, DM, DM, nullptr, (bf16_t*)(p.ws + WS_WTOUT) + (size_t)l * DM * DM, gtid, gth);
        transpose_items(p.w1_k + (size_t)l * 2048 * 128, 2048, 128, 128, nullptr, (bf16_t*)(p.ws + WS_W1T) + (size_t)(l * 2 + 0) * 128 * 2048, gtid, gth);
        transpose_items(p.w1_v + (size_t)l * 2048 * 128, 2048, 128, 128, nullptr, (bf16_t*)(p.ws + WS_W1T) + (size_t)(l * 2 + 1) * 128 * 2048, gtid, gth);
    }
    float* rope = (float*)(p.ws + WS_ROPE);
    for (int it = gtid; it < SEQ * 8; it += gth) {
        const int pos = it >> 3, i = it & 7;
        const float inv = powf(500000.0f, -(float)i / 8.0f);
        const float ang = (float)pos * inv;
        float sn, cs;
        sincosf(ang, &sn, &cs);
        rope[pos * 16 + i] = cs;
        rope[pos * 16 + 8 + i] = sn;
    }
    float* b1 = (float*)(p.ws + WS_B1);
    for (int it = gtid; it < DEPTH * 2 * 128; it += gth) {
        const int hu = it & 127, kv = (it >> 7) & 1, l = it >> 8;
        const float* pe = (kv ? p.pe_v : p.pe_k) + (size_t)l * 2048;
        const float* w1 = (kv ? p.w1_v : p.w1_k) + (size_t)l * 2048 * 128;
        float s = 0.f;
        for (int k = 0; k < 2048; ++k) s += pe[k] * w1[(size_t)k * 128 + hu];
        b1[it] = s;
    }
    bf16_t* w2p = (bf16_t*)(p.ws + WS_W2P);
    for (int it = gtid; it < DEPTH * 2 * 8192; it += gth) {
        const int jj = it & 7, quad = (it >> 3) & 3, r = (it >> 5) & 15, dt = (it >> 9) & 3, s = (it >> 11) & 3, kv = (it >> 13) & 1, l = it >> 14;
        const int hu = 16 * (2 * s + (jj >> 2)) + 4 * quad + (jj & 3), d = 16 * dt + r;
        const float* w2 = (kv ? p.w2_v : p.w2_k) + (size_t)l * 128 * 64;
        w2p[it] = f2bf(w2[hu * 64 + d]);
    }
    bf16_t* rgw = (bf16_t*)(p.ws + WS_RGW);
    for (int it = gtid; it < DEPTH * 2 * 8 * 4096; it += gth) {
        const int in = it & 63, out = (it >> 6) & 63, n = (it >> 12) & 7, gate = (it >> 15) & 1, l = it >> 16;
        const float* w = (gate ? p.rg_wi : p.rg_wr) + (size_t)l * 8 * 4096 + n * 4096;
        rgw[it] = f2bf(w[in * 64 + out]);
    }
    float* sp = (float*)(p.ws + WS_SP);
    for (int it = gtid; it < DEPTH * 512; it += gth) {
        const float v = -p.rg_lam[it];
        sp[it] = (v > 20.f) ? v : log1pf(expf(v));
    }
    if (gtid < DEPTH * 4) {
        const int l = gtid >> 2, br = gtid & 3;
        float mq = 0.f, mk = 0.f;
        for (int i = 0; i < 64; ++i) { mq = fmaxf(mq, fabsf(p.q_g[l * 64 + i])); if (br < 3) mk = fmaxf(mk, fabsf(p.k_g[(l * 3 + br) * 64 + i])); }
        ((float*)(p.ws + WS_MB))[gtid] = 8.0f * mq * mk * LOG2E * 1.0001f;
    }
    phase_xprep(p, p.x);
}

constexpr int GEMM_LDS = 65536;
template <int EPI>
__device__ __forceinline__ void gemm_tile(const bf16_t* __restrict__ A, const bf16_t* __restrict__ Bt, int K, int row0, int col0,
                                          unsigned char* lds, const float* rstd, bf16_t* zout, const float* xin, float* xout) {
    const int tid = threadIdx.x, wid = tid >> 6, lane = tid & 63, wr = wid >> 1, wc = wid & 1, fr = lane & 15, quad = lane >> 4;
    f32x4 acc[4][4];
#pragma unroll
    for (int m = 0; m < 4; ++m)
#pragma unroll
        for (int n = 0; n < 4; ++n) acc[m][n] = (f32x4){0.f, 0.f, 0.f, 0.f};
    const bf16_t* ag[4];
    const bf16_t* bg[4];
    int soff[4];
#pragma unroll
    for (int i = 0; i < 4; ++i) {
        const int id = tid + 256 * i, r = id >> 3, c = id & 7;
        ag[i] = A + (size_t)(row0 + r) * K + c * 8;
        bg[i] = Bt + (size_t)(col0 + r) * K + c * 8;
        soff[i] = r * 128 + ((c ^ (r & 7)) << 4);
    }
    u32x4 ra[4], rb[4];
#pragma unroll
    for (int i = 0; i < 4; ++i) { ra[i] = *(const u32x4*)(ag[i]); rb[i] = *(const u32x4*)(bg[i]); }
    __syncthreads();
#pragma unroll
    for (int i = 0; i < 4; ++i) { *(u32x4*)(lds + soff[i]) = ra[i]; *(u32x4*)(lds + 32768 + soff[i]) = rb[i]; }
    __syncthreads();
    const int nk = K / 64;
    for (int kt = 0; kt < nk; ++kt) {
        const int buf = kt & 1;
        if (kt + 1 < nk) {
#pragma unroll
            for (int i = 0; i < 4; ++i) { ra[i] = *(const u32x4*)(ag[i] + (kt + 1) * 64); rb[i] = *(const u32x4*)(bg[i] + (kt + 1) * 64); }
        }
        const unsigned char* la = lds + buf * 16384;
        const unsigned char* lb = lds + 32768 + buf * 16384;
#pragma unroll
        for (int ks = 0; ks < 2; ++ks) {
            bf16x8 af[4], bf[4];
#pragma unroll
            for (int m = 0; m < 4; ++m) { const int r = wr * 64 + m * 16 + fr; af[m] = *(const bf16x8*)(la + r * 128 + (((ks * 4 + quad) ^ (r & 7)) << 4)); }
#pragma unroll
            for (int n = 0; n < 4; ++n) { const int r = wc * 64 + n * 16 + fr; bf[n] = *(const bf16x8*)(lb + r * 128 + (((ks * 4 + quad) ^ (r & 7)) << 4)); }
#pragma unroll
            for (int m = 0; m < 4; ++m)
#pragma unroll
                for (int n = 0; n < 4; ++n) acc[m][n] = MFMA16(bf[n], af[m], acc[m][n]);
        }
        if (kt + 1 < nk) {
            unsigned char* wa = lds + (buf ^ 1) * 16384;
            unsigned char* wb = lds + 32768 + (buf ^ 1) * 16384;
#pragma unroll
            for (int i = 0; i < 4; ++i) { *(u32x4*)(wa + soff[i]) = ra[i]; *(u32x4*)(wb + soff[i]) = rb[i]; }
        }
        __syncthreads();
    }
#pragma unroll
    for (int m = 0; m < 4; ++m) {
        const int row = row0 + wr * 64 + m * 16 + fr;
        if (EPI == 0) {
            const float rs = rstd[row];
#pragma unroll
            for (int n = 0; n < 4; ++n) {
                const int col = col0 + wc * 64 + n * 16 + 4 * quad;
                u32x2 w; w.x = pk2(acc[m][n].x * rs, acc[m][n].y * rs); w.y = pk2(acc[m][n].z * rs, acc[m][n].w * rs);
                *(u32x2*)(zout + (size_t)row * ZW + col) = w;
            }
        } else {
#pragma unroll
            for (int n = 0; n < 4; ++n) {
                const int col = col0 + wc * 64 + n * 16 + 4 * quad;
                const f32x4 xv = *(const f32x4*)(xin + (size_t)row * DM + col);
                *(f32x4*)(xout + (size_t)row * DM + col) = xv + acc[m][n];
            }
        }
    }
}

__device__ __forceinline__ void phase_gemm_in(const Params& p, int l, unsigned char* lds) {
    const bf16_t* A = (const bf16_t*)(p.ws + WS_XB);
    const bf16_t* Bt = (const bf16_t*)(p.ws + WS_WTIN) + (size_t)l * ZW * DM;
    constexpr int NTN = ZW / 128, NTM = NT / 128;
    for (int t = blockIdx.x; t < NTM * NTN; t += gridDim.x) {
        const int tm = t / NTN, tn = t % NTN;
        gemm_tile<0>(A, Bt, DM, tm * 128, tn * 128, lds, (const float*)(p.ws + WS_RSTD), (bf16_t*)(p.ws + WS_Z), nullptr, nullptr);
    }
}
__device__ __forceinline__ void phase_gemm_out(const Params& p, int l, unsigned char* lds, const float* xin, float* xout) {
    const bf16_t* A = (const bf16_t*)(p.ws + WS_Y);
    const bf16_t* Bt = (const bf16_t*)(p.ws + WS_WTOUT) + (size_t)l * DM * DM;
    constexpr int NTN = DM / 128, NTM = NT / 128;
    for (int t = blockIdx.x; t < NTM * NTN; t += gridDim.x) {
        const int tm = t / NTN, tn = t % NTN;
        gemm_tile<1>(A, Bt, DM, tm * 128, tn * 128, lds, nullptr, nullptr, xin, xout);
    }
}

__device__ __forceinline__ void qkv_item(const Params& p, int l, int tt, int slot, int lane) {
    const bf16_t* z = (const bf16_t*)(p.ws + WS_Z);
    const int t = tt * 64 + lane, b = t / SEQ, s = t % SEQ;
    int col; const float* gp = nullptr;
    if (slot < 8) { col = C_Q + slot * 64; gp = p.q_g + l * 64; }
    else if (slot < 10) { col = C_KS + (slot - 8) * 64; gp = p.k_g + (l * 3 + 1) * 64; }
    else if (slot < 12) { col = C_KW + (slot - 10) * 64; gp = p.k_g + (l * 3 + 2) * 64; }
    else if (slot < 14) { col = C_VS + (slot - 12) * 64; }
    else { col = C_VW + (slot - 14) * 64; }
    const u32x4* zr = (const u32x4*)(z + (size_t)t * ZW + col);
    u32x4 raw[8];
#pragma unroll
    for (int i = 0; i < 8; ++i) raw[i] = zr[i];
    if (slot < 12) {
        float v[64];
#pragma unroll
        for (int i = 0; i < 8; ++i) {
            v[8 * i + 0] = bflo(raw[i].x); v[8 * i + 1] = bfhi(raw[i].x); v[8 * i + 2] = bflo(raw[i].y); v[8 * i + 3] = bfhi(raw[i].y);
            v[8 * i + 4] = bflo(raw[i].z); v[8 * i + 5] = bfhi(raw[i].z); v[8 * i + 6] = bflo(raw[i].w); v[8 * i + 7] = bfhi(raw[i].w);
        }
        float ss = 0.f;
#pragma unroll
        for (int d = 0; d < 64; ++d) ss += v[d] * v[d];
        const float rinv = 1.0f / sqrtf(ss * (1.0f / 64.0f) + EPS);
#pragma unroll
        for (int d = 0; d < 64; ++d) v[d] = v[d] * rinv * gp[d];
        const f32x4* rp = (const f32x4*)((const float*)(p.ws + WS_ROPE) + s * 16);
        const f32x4 c0 = rp[0], c1 = rp[1], s0 = rp[2], s1 = rp[3];
        const float cs[8] = {c0.x, c0.y, c0.z, c0.w, c1.x, c1.y, c1.z, c1.w};
        const float sn[8] = {s0.x, s0.y, s0.z, s0.w, s1.x, s1.y, s1.z, s1.w};
#pragma unroll
        for (int i = 0; i < 8; ++i) { const float x1 = v[i], x2 = v[8 + i]; v[i] = x1 * cs[i] - x2 * sn[i]; v[8 + i] = x2 * cs[i] + x1 * sn[i]; }
        bf16_t* dst;
        if (slot < 8) dst = (bf16_t*)(p.ws + WS_QN) + (size_t)t * 512 + slot * 64;
        else if (slot < 10) dst = (bf16_t*)(p.ws + WS_KS) + ((size_t)(b * 2 + (slot - 8)) * SEQ + s) * 64;
        else dst = (bf16_t*)(p.ws + WS_KW) + ((size_t)(b * 2 + (slot - 10)) * SEQ + s) * 64;
#pragma unroll
        for (int i = 0; i < 8; ++i) {
            u32x4 o; o.x = pk2(v[8 * i], v[8 * i + 1]); o.y = pk2(v[8 * i + 2], v[8 * i + 3]); o.z = pk2(v[8 * i + 4], v[8 * i + 5]); o.w = pk2(v[8 * i + 6], v[8 * i + 7]);
            ((u32x4*)dst)[i] = o;
        }
    } else {
        bf16_t* dst = (slot < 14) ? (bf16_t*)(p.ws + WS_VST) + ((size_t)(b * 2 + (slot - 12)) * 64) * SEQ + s
                                  : (bf16_t*)(p.ws + WS_VWT) + ((size_t)(b * 2 + (slot - 14)) * 64) * SEQ + s;
#pragma unroll
        for (int i = 0; i < 8; ++i) {
            const unsigned w[4] = {raw[i].x, raw[i].y, raw[i].z, raw[i].w};
#pragma unroll
            for (int k = 0; k < 4; ++k) {
                dst[(size_t)(8 * i + 2 * k) * SEQ] = (bf16_t)(w[k] & 0xffffu);
                dst[(size_t)(8 * i + 2 * k + 1) * SEQ] = (bf16_t)(w[k] >> 16);
            }
        }
    }
}

__device__ __forceinline__ void rg_item(const Params& p, int l, int b, int ch, int n, float* xcf, int lane) {
    const bf16_t* z = (const bf16_t*)(p.ws + WS_Z);
    const int fr = lane & 15, quad = lane >> 4;
    const size_t t0 = (size_t)b * SEQ + (size_t)ch * 64;
    {
        const int c = n * 64 + lane;
        const float w0 = p.conv_w[(l * 4 + 0) * 512 + c], w1 = p.conv_w[(l * 4 + 1) * 512 + c], w2 = p.conv_w[(l * 4 + 2) * 512 + c],
                    w3 = p.conv_w[(l * 4 + 3) * 512 + c], cb = p.conv_b[l * 512 + c];
        const bf16_t* zc = z + t0 * ZW + C_RGX + c;
        float xm3 = 0.f, xm2 = 0.f, xm1 = 0.f;
        if (ch > 0) { xm3 = bf2f(zc[-3 * ZW]); xm2 = bf2f(zc[-2 * ZW]); xm1 = bf2f(zc[-1 * ZW]); }
#pragma unroll 8
        for (int tt = 0; tt < 64; ++tt) {
            const float x0 = bf2f(zc[(size_t)tt * ZW]);
            xcf[tt * 68 + lane] = w0 * xm3 + w1 * xm2 + w2 * xm1 + w3 * x0 + cb;
            xm3 = xm2; xm2 = xm1; xm1 = x0;
        }
    }
    LDS_FENCE();
    bf16x8 af[4][2];
#pragma unroll
    for (int m = 0; m < 4; ++m)
#pragma unroll
        for (int ks = 0; ks < 2; ++ks) {
            const f32x4* src = (const f32x4*)(xcf + (16 * m + fr) * 68 + 32 * ks + 8 * quad);
            const f32x4 a = src[0], c = src[1];
            u32x4 w; w.x = pk2(a.x, a.y); w.y = pk2(a.z, a.w); w.z = pk2(c.x, c.y); w.w = pk2(c.z, c.w);
            af[m][ks] = as_bf16x8(w);
        }
    const bf16_t* wr_ = (const bf16_t*)(p.ws + WS_RGW) + ((size_t)(l * 2 + 0) * 8 + n) * 4096;
    const bf16_t* wi_ = (const bf16_t*)(p.ws + WS_RGW) + ((size_t)(l * 2 + 1) * 8 + n) * 4096;
    bf16_t* hloc = (bf16_t*)(p.ws + WS_HLOC);
    bf16_t* pc = (bf16_t*)(p.ws + WS_PC);
#pragma unroll 1
    for (int nt = 0; nt < 4; ++nt) {
        const int c = n * 64 + 16 * nt + fr;
        f32x4 ar[4], ai[4];
#pragma unroll
        for (int m = 0; m < 4; ++m) { ar[m] = (f32x4){0.f, 0.f, 0.f, 0.f}; ai[m] = (f32x4){0.f, 0.f, 0.f, 0.f}; }
#pragma unroll
        for (int ks = 0; ks < 2; ++ks) {
            const bf16x8 br = *(const bf16x8*)(wr_ + (16 * nt + fr) * 64 + 32 * ks + 8 * quad);
            const bf16x8 bi = *(const bf16x8*)(wi_ + (16 * nt + fr) * 64 + 32 * ks + 8 * quad);
#pragma unroll
            for (int m = 0; m < 4; ++m) { ar[m] = MFMA16(af[m][ks], br, ar[m]); ai[m] = MFMA16(af[m][ks], bi, ai[m]); }
        }
        const float brv = p.rg_br[l * 512 + c], biv = p.rg_bi[l * 512 + c], spv = ((const float*)(p.ws + WS_SP))[l * 512 + c];
        float Am = 1.f, Hm = 0.f;
#pragma unroll
        for (int m = 0; m < 4; ++m) {
            float Pl[4], hl[4];
            float pa = 1.f, ph = 0.f;
#pragma unroll
            for (int j = 0; j < 4; ++j) {
                const float xcv = xcf[(16 * m + 4 * quad + j) * 68 + 16 * nt + fr];
                const float r = sigmoidf_(ar[m][j] + brv), ig = sigmoidf_(ai[m][j] + biv);
                const float la = -8.0f * r * spv;
                const float a = __expf(la);
                const float u = sqrtf(-expm1f(2.0f * la)) * (ig * xcv);
                pa = pa * a; ph = a * ph + u;
                Pl[j] = pa; hl[j] = ph;
            }
            float Ai = pa, Hi = ph;
            {
                const float a1 = __shfl_up(Ai, 16), h1 = __shfl_up(Hi, 16);
                if (quad >= 1) { Hi = Ai * h1 + Hi; Ai = a1 * Ai; }
                const float a2 = __shfl_up(Ai, 32), h2 = __shfl_up(Hi, 32);
                if (quad >= 2) { Hi = Ai * h2 + Hi; Ai = a2 * Ai; }
            }
            float Ae = __shfl_up(Ai, 16), He = __shfl_up(Hi, 16);
            if (quad == 0) { Ae = 1.f; He = 0.f; }
            const float Pin = Am * Ae, Hin = Ae * Hm + He;
#pragma unroll
            for (int j = 0; j < 4; ++j) {
                const size_t t = t0 + 16 * m + 4 * quad + j;
                hloc[t * 512 + c] = f2bf(hl[j] + Pl[j] * Hin);
                pc[t * 512 + c] = f2bf(Pl[j] * Pin);
            }
            const float A3 = __shfl(Ai, 48 + fr), H3 = __shfl(Hi, 48 + fr);
            Hm = A3 * Hm + H3; Am = Am * A3;
        }
        if (quad == 0) {
            ((float*)(p.ws + WS_SUMH))[((size_t)b * NCH + ch) * 512 + c] = Hm;
            ((float*)(p.ws + WS_SUMP))[((size_t)b * NCH + ch) * 512 + c] = Am;
        }
    }
    LDS_FENCE();
}

__device__ __forceinline__ void cmp_item(const Params& p, int l, int kv, int bg, int blk32, int lane) {
    const bf16_t* z = (const bf16_t*)(p.ws + WS_Z);
    const int fr = lane & 15, quad = lane >> 4, b = bg >> 1, g = bg & 1;
    const int i0 = blk32 * 32;
    const bf16_t* w1t = (const bf16_t*)(p.ws + WS_W1T) + (size_t)(l * 2 + kv) * 128 * 2048;
    const int colbase = (kv ? C_VC : C_KC) + g * 64;
    f32x4 acc[8][2];
#pragma unroll
    for (int mt = 0; mt < 8; ++mt) { acc[mt][0] = (f32x4){0.f, 0.f, 0.f, 0.f}; acc[mt][1] = (f32x4){0.f, 0.f, 0.f, 0.f}; }
    const bf16_t* arow = w1t + (size_t)fr * 2048 + 8 * quad;
    const int blkA = i0 + fr, blkB = i0 + 16 + fr;
#pragma unroll 2
    for (int kk = 0; kk < 64; ++kk) {
        const int j = kk >> 1, d = 32 * (kk & 1) + 8 * quad;
        int tokA = 16 * blkA + j, tokB = 16 * blkB + j;
        tokA = tokA < SEQ ? tokA : SEQ - 1; tokB = tokB < SEQ ? tokB : SEQ - 1;
        const bf16x8 bA = *(const bf16x8*)(z + ((size_t)b * SEQ + tokA) * ZW + colbase + d);
        const bf16x8 bB = *(const bf16x8*)(z + ((size_t)b * SEQ + tokB) * ZW + colbase + d);
#pragma unroll
        for (int mt = 0; mt < 8; ++mt) {
            const bf16x8 a = *(const bf16x8*)(arow + (size_t)mt * 16 * 2048 + kk * 32);
            acc[mt][0] = MFMA16(a, bA, acc[mt][0]);
            acc[mt][1] = MFMA16(a, bB, acc[mt][1]);
        }
    }
    const float* b1 = (const float*)(p.ws + WS_B1) + (l * 2 + kv) * 128;
    const bf16_t* w2p = (const bf16_t*)(p.ws + WS_W2P) + (size_t)(l * 2 + kv) * 8192;
    f32x4 o[4][2];
#pragma unroll
    for (int dt = 0; dt < 4; ++dt) { o[dt][0] = (f32x4){0.f, 0.f, 0.f, 0.f}; o[dt][1] = (f32x4){0.f, 0.f, 0.f, 0.f}; }
#pragma unroll
    for (int s = 0; s < 4; ++s) {
        bf16x8 hf[2];
#pragma unroll
        for (int ct = 0; ct < 2; ++ct) {
            float h[8];
#pragma unroll
            for (int e = 0; e < 8; ++e) { const int mt = 2 * s + (e >> 2); h[e] = siluf_(acc[mt][ct][e & 3] + b1[16 * mt + 4 * quad + (e & 3)]); }
            u32x4 w; w.x = pk2(h[0], h[1]); w.y = pk2(h[2], h[3]); w.z = pk2(h[4], h[5]); w.w = pk2(h[6], h[7]);
            hf[ct] = as_bf16x8(w);
        }
#pragma unroll
        for (int dt = 0; dt < 4; ++dt) {
            const bf16x8 a = *(const bf16x8*)(w2p + ((((s * 4 + dt) * 16 + fr) * 4 + quad) * 8));
            o[dt][0] = MFMA16(a, hf[0], o[dt][0]);
            o[dt][1] = MFMA16(a, hf[1], o[dt][1]);
        }
    }
#pragma unroll
    for (int ct = 0; ct < 2; ++ct) {
        const int blk = i0 + 16 * ct + fr;
        const bool valid = blk < 511;
        if (kv == 0) {
            float ss = 0.f;
#pragma unroll
            for (int dt = 0; dt < 4; ++dt) ss += o[dt][ct].x * o[dt][ct].x + o[dt][ct].y * o[dt][ct].y + o[dt][ct].z * o[dt][ct].z + o[dt][ct].w * o[dt][ct].w;
            ss += __shfl_xor(ss, 16); ss += __shfl_xor(ss, 32);
            const float rinv = 1.0f / sqrtf(ss * (1.0f / 64.0f) + EPS);
            const float* kg = p.k_g + (l * 3 + 0) * 64;
            float v[4][4];
#pragma unroll
            for (int dt = 0; dt < 4; ++dt)
#pragma unroll
                for (int j = 0; j < 4; ++j) v[dt][j] = o[dt][ct][j] * rinv * kg[16 * dt + 4 * quad + j];
            const int pos = 16 * (valid ? blk : 0) + 31;
            const float* rp = (const float*)(p.ws + WS_ROPE) + pos * 16;
#pragma unroll
            for (int j = 0; j < 4; ++j) {
                const float own = v[0][j], oth = __shfl_xor(own, 32);
                const int i = 4 * (quad & 1) + j;
                const float cs = rp[i], sn = rp[8 + i];
                v[0][j] = (quad < 2) ? (own * cs - oth * sn) : (own * cs + oth * sn);
            }
            bf16_t* dst = (bf16_t*)(p.ws + WS_KC) + ((size_t)bg * 512 + blk) * 64;
#pragma unroll
            for (int dt = 0; dt < 4; ++dt) {
                u32x2 w; w.x = valid ? pk2(v[dt][0], v[dt][1]) : 0u; w.y = valid ? pk2(v[dt][2], v[dt][3]) : 0u;
                *(u32x2*)(dst + 16 * dt + 4 * quad) = w;
            }
        } else {
            bf16_t* dst = (bf16_t*)(p.ws + WS_VCT) + (size_t)bg * 64 * 512 + blk;
#pragma unroll
            for (int dt = 0; dt < 4; ++dt)
#pragma unroll
                for (int j = 0; j < 4; ++j) dst[(size_t)(16 * dt + 4 * quad + j) * 512] = valid ? f2bf(o[dt][ct][j]) : (bf16_t)0;
        }
    }
}

__device__ __forceinline__ void phase_post(const Params& p, int l, unsigned char* lds) {
    const int wid = threadIdx.x >> 6, lane = threadIdx.x & 63, gw = blockIdx.x * 4 + wid, nw = gridDim.x * 4;
    float* xcf = (float*)(lds + wid * 17408);
    constexpr int N_CMP = 2 * 8 * 16, N_RG = NB * NCH * 8, N_QKV = (NT / 64) * 16;
    for (int it = gw; it < N_CMP + N_RG + N_QKV; it += nw) {
        if (it < N_CMP) { cmp_item(p, l, it & 1, (it >> 1) & 7, it >> 4, lane); }
        else if (it < N_CMP + N_RG) { const int r = it - N_CMP; rg_item(p, l, r / (NCH * 8), (r / 8) % NCH, r & 7, xcf, lane); }
        else { const int r = it - N_CMP - N_RG; qkv_item(p, l, r >> 4, r & 15, lane); }
    }
}

template <bool DO_PV, bool NORM, bool IMP>
__device__ __forceinline__ void attn_step(const bf16_t* __restrict__ Kb, const bf16_t* __restrict__ Vt, int NK, int kb, int fr, int quad,
                                          const bf16x8 (&qf)[4][2], f32x4 (&O)[4][4], float (&lsum)[4], const float (&invl)[4], int lo, int hi,
                                          float sc, float mb, float (&ps)[8]) {
    f32x4 sT[2][4];
#pragma unroll
    for (int T = 0; T < 2; ++T) {
        const int key = kb + (fr >> 2) * 8 + T * 4 + (fr & 3);
        const bf16_t* kp = Kb + (size_t)key * 64 + 8 * quad;
        const bf16x8 k0 = *(const bf16x8*)kp, k1 = *(const bf16x8*)(kp + 32);
#pragma unroll
        for (int h = 0; h < 4; ++h) {
            sT[T][h] = MFMA16(k0, qf[h][0], ((f32x4){0.f, 0.f, 0.f, 0.f}));
            sT[T][h] = MFMA16(k1, qf[h][1], sT[T][h]);
        }
    }
    bool vm[8];
#pragma unroll
    for (int e = 0; e < 8; ++e) { const int k = kb + 8 * quad + e; vm[e] = (k > lo) && (k <= hi); }
    bf16x8 pf[4];
#pragma unroll
    for (int h = 0; h < 4; ++h) {
        float pv[8];
#pragma unroll
        for (int e = 0; e < 8; ++e) {
            float v = __builtin_amdgcn_exp2f(sT[e >> 2][h][e & 3] * sc - mb);
            v = vm[e] ? v : 0.f;
            if (NORM) v *= invl[h]; else lsum[h] += v;
            if (IMP) ps[e] += v;
            pv[e] = v;
        }
        u32x4 w; w.x = pk2(pv[0], pv[1]); w.y = pk2(pv[2], pv[3]); w.z = pk2(pv[4], pv[5]); w.w = pk2(pv[6], pv[7]);
        pf[h] = as_bf16x8(w);
    }
    if (DO_PV) {
#pragma unroll
        for (int dt = 0; dt < 4; ++dt) {
            const bf16x8 vf = *(const bf16x8*)(Vt + (size_t)(16 * dt + fr) * NK + kb + 8 * quad);
#pragma unroll
            for (int h = 0; h < 4; ++h) O[dt][h] = MFMA16(vf, pf[h], O[dt][h]);
        }
    }
}

__device__ __forceinline__ void attn_item(const Params& p, int l, int bg, int qt, float* ldsw, int lane) {
    const bf16_t* z = (const bf16_t*)(p.ws + WS_Z);
    const int fr = lane & 15, quad = lane >> 4, b = bg >> 1, g = bg & 1;
    const int s0 = qt * 16, tq = s0 + fr;
    const size_t trow = (size_t)b * SEQ + tq;
    bf16x8 qf[4][2];
    {
        const bf16_t* qp = (const bf16_t*)(p.ws + WS_QN) + trow * 512 + (4 * g) * 64 + 8 * quad;
#pragma unroll
        for (int h = 0; h < 4; ++h) { qf[h][0] = *(const bf16x8*)(qp + h * 64); qf[h][1] = *(const bf16x8*)(qp + h * 64 + 32); }
    }
    float gate[4][3];
    {
        const bf16_t* gp = z + trow * ZW + C_BG + 12 * g;
#pragma unroll
        for (int h = 0; h < 4; ++h)
#pragma unroll
            for (int br = 0; br < 3; ++br) gate[h][br] = sigmoidf_(bf2f(gp[h * 3 + br]));
    }
    const float sc = 0.125f * LOG2E;
    const float* mbp = (const float*)(p.ws + WS_MB) + l * 4;
    const float one4[4] = {1.f, 1.f, 1.f, 1.f};
    f32x4 O[4][4];
    float lsum[4], invl[4], ps[8];
    const bf16_t* kc = (const bf16_t*)(p.ws + WS_KC) + (size_t)bg * 512 * 64;
    const bf16_t* vct = (const bf16_t*)(p.ws + WS_VCT) + (size_t)bg * 64 * 512;
    const int nmax = s0 >> 4;
    const int hi_c = ((fr == 15) ? nmax : nmax - 1) - 1;
    const int nsteps = (nmax + 31) >> 5;
    const float mb_c = mbp[0];
#pragma unroll
    for (int h = 0; h < 4; ++h) lsum[h] = 0.f;
#pragma unroll
    for (int dt = 0; dt < 4; ++dt)
#pragma unroll
        for (int h = 0; h < 4; ++h) O[dt][h] = (f32x4){0.f, 0.f, 0.f, 0.f};
    for (int st = 0; st < nsteps; ++st) attn_step<false, false, false>(kc, vct, 512, st * 32, fr, quad, qf, O, lsum, one4, -1, hi_c, sc, mb_c, ps);
#pragma unroll
    for (int h = 0; h < 4; ++h) {
        float v = lsum[h]; v += __shfl_xor(v, 16); v += __shfl_xor(v, 32);
        invl[h] = v > 0.f ? 1.0f / v : 0.f;
    }
    float co_prev = 0.f;
    for (int st = 0; st < nsteps; ++st) {
#pragma unroll
        for (int e = 0; e < 8; ++e) ps[e] = 0.f;
        attn_step<true, true, true>(kc, vct, 512, st * 32, fr, quad, qf, O, lsum, invl, -1, hi_c, sc, mb_c, ps);
        float X0 = ps[0] + ps[1] + ps[2] + 0.5f * ps[3];
        const float X1 = ps[4] + ps[5] + ps[6] + 0.5f * ps[7] + 0.5f * ps[3];
        const float co = 0.5f * ps[7];
        const float send = (quad == 3) ? co_prev : co;
        X0 += __shfl(send, (lane + 48) & 63);
        co_prev = co;
        const int j0 = st * 8 + 2 * quad;
        ldsw[j0 * 16 + fr] = X0;
        ldsw[(j0 + 1) * 16 + fr] = X1;
    }
    LDS_FENCE();
    const int bt = s0 >> 6;
    unsigned mymask = 0u;
    if (bt >= 16) {
        unsigned key[32];
#pragma unroll
        for (int i = 0; i < 32; ++i) {
            const int j = 32 * quad + i;
            const unsigned bits = __float_as_uint(ldsw[j * 16 + fr]);
            key[i] = (j >= 1 && j <= bt - 2) ? ((bits & ~127u) | (unsigned)(127 - j)) : 0u;
        }
        for (int it = 0; it < 13; ++it) {
            unsigned m = 0u;
#pragma unroll
            for (int i = 0; i < 32; ++i) m = key[i] > m ? key[i] : m;
            { const unsigned o = __shfl_xor(m, 16); m = o > m ? o : m; }
            { const unsigned o = __shfl_xor(m, 32); m = o > m ? o : m; }
            const int jsel = 127 - (int)(m & 127u);
            if ((jsel >> 5) == quad) mymask |= 1u << (jsel & 31);
#pragma unroll
            for (int i = 0; i < 32; ++i) key[i] = (key[i] == m) ? 0u : key[i];
        }
        if (quad == 0) mymask |= 1u;
        if (((bt - 1) >> 5) == quad) mymask |= 1u << ((bt - 1) & 31);
        if ((bt >> 5) == quad) mymask |= 1u << (bt & 31);
    } else {
        if (quad == 0) mymask = (2u << bt) - 1u;
    }
    LDS_FENCE();
#pragma unroll
    for (int dt = 0; dt < 4; ++dt)
#pragma unroll
        for (int h = 0; h < 4; ++h)
#pragma unroll
            for (int j = 0; j < 4; ++j) ldsw[((dt * 4 + h) * 4 + j) * 64 + lane] = gate[h][0] * O[dt][h][j];
    {
        const bf16_t* ksb = (const bf16_t*)(p.ws + WS_KS) + (size_t)bg * SEQ * 64;
        const bf16_t* vst = (const bf16_t*)(p.ws + WS_VST) + (size_t)bg * 64 * SEQ;
        const float mb_s = mbp[1];
#pragma unroll
        for (int h = 0; h < 4; ++h) lsum[h] = 0.f;
#pragma unroll
        for (int dt = 0; dt < 4; ++dt)
#pragma unroll
            for (int h = 0; h < 4; ++h) O[dt][h] = (f32x4){0.f, 0.f, 0.f, 0.f};
        unsigned curw = 0u;
        for (int jb = 0; jb <= bt; ++jb) {
            if ((jb & 31) == 0) curw = __shfl(mymask, fr + 16 * (jb >> 5));
            const bool sel = (curw >> (jb & 31)) & 1u;
            if (__ballot(sel) == 0ull) continue;
            const int hi = sel ? tq : -1;
            attn_step<true, false, false>(ksb, vst, SEQ, jb * 64, fr, quad, qf, O, lsum, one4, -1, hi, sc, mb_s, ps);
            attn_step<true, false, false>(ksb, vst, SEQ, jb * 64 + 32, fr, quad, qf, O, lsum, one4, -1, hi, sc, mb_s, ps);
        }
#pragma unroll
        for (int h = 0; h < 4; ++h) {
            float v = lsum[h]; v += __shfl_xor(v, 16); v += __shfl_xor(v, 32);
            const float coef = v > 0.f ? gate[h][1] / v : 0.f;
#pragma unroll
            for (int dt = 0; dt < 4; ++dt)
#pragma unroll
                for (int j = 0; j < 4; ++j) ldsw[((dt * 4 + h) * 4 + j) * 64 + lane] += coef * O[dt][h][j];
        }
    }
    {
        const bf16_t* kwb = (const bf16_t*)(p.ws + WS_KW) + (size_t)bg * SEQ * 64;
        const bf16_t* vwt = (const bf16_t*)(p.ws + WS_VWT) + (size_t)bg * 64 * SEQ;
        const float mb_w = mbp[2];
#pragma unroll
        for (int h = 0; h < 4; ++h) lsum[h] = 0.f;
#pragma unroll
        for (int dt = 0; dt < 4; ++dt)
#pragma unroll
            for (int h = 0; h < 4; ++h) O[dt][h] = (f32x4){0.f, 0.f, 0.f, 0.f};
        int kstart = s0 - 511; kstart = kstart < 0 ? 0 : kstart; kstart &= ~31;
        for (int kb = kstart; kb <= s0 + 15; kb += 32)
            attn_step<true, false, false>(kwb, vwt, SEQ, kb, fr, quad, qf, O, lsum, one4, tq - 512, tq, sc, mb_w, ps);
        const bf16_t* ng = z + trow * ZW + C_NG + (4 * g) * 64 + 4 * quad;
        bf16_t* yo = (bf16_t*)(p.ws + WS_Y) + trow * DM + 512 + (4 * g) * 64 + 4 * quad;
#pragma unroll
        for (int h = 0; h < 4; ++h) {
            float v = lsum[h]; v += __shfl_xor(v, 16); v += __shfl_xor(v, 32);
            const float coef = v > 0.f ? gate[h][2] / v : 0.f;
#pragma unroll
            for (int dt = 0; dt < 4; ++dt) {
                float r[4];
#pragma unroll
                for (int j = 0; j < 4; ++j) r[j] = ldsw[((dt * 4 + h) * 4 + j) * 64 + lane] + coef * O[dt][h][j];
                const u32x2 gw = *(const u32x2*)(ng + h * 64 + 16 * dt);
                r[0] *= siluf_(bflo(gw.x)); r[1] *= siluf_(bfhi(gw.x)); r[2] *= siluf_(bflo(gw.y)); r[3] *= siluf_(bfhi(gw.y));
                u32x2 w; w.x = pk2(r[0], r[1]); w.y = pk2(r[2], r[3]);
                *(u32x2*)(yo + h * 64 + 16 * dt) = w;
            }
        }
    }
    LDS_FENCE();
}

__device__ __forceinline__ void rgfin_item(const Params& p, int b, int ch, int n, int lane) {
    const bf16_t* z = (const bf16_t*)(p.ws + WS_Z);
    const int c = n * 64 + lane;
    const float* sh = (const float*)(p.ws + WS_SUMH) + (size_t)b * NCH * 512 + c;
    const float* sp = (const float*)(p.ws + WS_SUMP) + (size_t)b * NCH * 512 + c;
    float h = 0.f;
    for (int j = 0; j < ch; ++j) h = sp[(size_t)j * 512] * h + sh[(size_t)j * 512];
    const size_t t0 = (size_t)b * SEQ + (size_t)ch * 64;
    const bf16_t* hl = (const bf16_t*)(p.ws + WS_HLOC) + t0 * 512 + c;
    const bf16_t* pc = (const bf16_t*)(p.ws + WS_PC) + t0 * 512 + c;
    const bf16_t* zg = z + t0 * ZW + C_RGG + c;
    bf16_t* y = (bf16_t*)(p.ws + WS_Y) + t0 * DM + c;
#pragma unroll 8
    for (int tt = 0; tt < 64; ++tt) {
        const float v = bf2f(hl[(size_t)tt * 512]) + bf2f(pc[(size_t)tt * 512]) * h;
        y[(size_t)tt * DM] = f2bf(v * siluf_(bf2f(zg[(size_t)tt * ZW])));
    }
}

__device__ __forceinline__ void phase_attn(const Params& p, int l, unsigned char* lds) {
    const int wid = threadIdx.x >> 6, lane = threadIdx.x & 63, gw = blockIdx.x * 4 + wid, nw = gridDim.x * 4;
    float* ldsw = (float*)(lds + wid * 16384);
    constexpr int N_ATT = 8 * 512, N_RG = NB * NCH * 8;
    for (int it = gw; it < N_ATT + N_RG; it += nw) {
        if (it < N_ATT) {
            const int i2 = it & 2047, bg = i2 >> 8, q = i2 & 255;
            attn_item(p, l, bg, (it < 2048) ? 511 - q : q, ldsw, lane);
        } else { const int r = it - N_ATT; rgfin_item(p, r / (NCH * 8), (r / 8) % NCH, r & 7, lane); }
    }
}

constexpr int LDS_BYTES = 4 * 17408;
static_assert(LDS_BYTES >= GEMM_LDS, "lds");

template <int phase>
__global__ void __launch_bounds__(256, 2) k_phase(Params p, int l) {
    extern __shared__ __attribute__((aligned(16))) unsigned char lds[];
    const float* xin = (l == 0) ? p.x : p.out;
    if (phase == 0) phase_prologue(p);
    else if (phase == 1) phase_gemm_in(p, l, lds);
    else if (phase == 2) phase_post(p, l, lds);
    else if (phase == 3) phase_attn(p, l, lds);
    else if (phase == 4) phase_gemm_out(p, l, lds, xin, p.out);
    else if (phase == 5) phase_xprep(p, p.out);
}

extern "C" void kernel_launch(void* const* d_in, const int* in_sizes, int n_in, void* d_out, int out_size, void* d_ws, size_t ws_size,
                              hipStream_t stream) {
    static int grid = 0;
    if (grid == 0) {
        if (n_in != 19 || ws_size < WS_END) { fprintf(stderr, "kernel_launch: unexpected n_in %d / ws_size %zu (need %zu)\n", n_in, ws_size, (size_t)WS_END); grid = -1; return; }
        (void)hipFuncSetAttribute((const void*)k_phase<0>, hipFuncAttributeMaxDynamicSharedMemorySize, LDS_BYTES);
        (void)hipFuncSetAttribute((const void*)k_phase<1>, hipFuncAttributeMaxDynamicSharedMemorySize, LDS_BYTES);
        (void)hipFuncSetAttribute((const void*)k_phase<2>, hipFuncAttributeMaxDynamicSharedMemorySize, LDS_BYTES);
        (void)hipFuncSetAttribute((const void*)k_phase<3>, hipFuncAttributeMaxDynamicSharedMemorySize, LDS_BYTES);
        (void)hipFuncSetAttribute((const void*)k_phase<4>, hipFuncAttributeMaxDynamicSharedMemorySize, LDS_BYTES);
        (void)hipFuncSetAttribute((const void*)k_phase<5>, hipFuncAttributeMaxDynamicSharedMemorySize, LDS_BYTES);
        int dev = 0, cus = 0, per_cu = 0;
        (void)hipGetDevice(&dev);
        (void)hipDeviceGetAttribute(&cus, hipDeviceAttributeMultiprocessorCount, dev);
        (void)hipOccupancyMaxActiveBlocksPerMultiprocessor(&per_cu, (const void*)k_phase<3>, 256, LDS_BYTES);
        if (per_cu < 1) per_cu = 1;
        if (per_cu > 2) per_cu = 2;
        grid = cus * per_cu;
    }
    if (grid < 0) return;
    Params p{};
    const float** dst = (const float**)&p;
    for (int i = 0; i < 19; ++i) dst[i] = (const float*)d_in[i];
    p.out = (float*)d_out;
    p.ws = (unsigned char*)d_ws;
    hipLaunchKernelGGL(k_phase<0>, dim3(grid), dim3(256), LDS_BYTES, stream, p, 0);
    for (int l = 0; l < DEPTH; ++l) {
        if (l > 0) hipLaunchKernelGGL(k_phase<5>, dim3(grid), dim3(256), LDS_BYTES, stream, p, l);
        hipLaunchKernelGGL(k_phase<1>, dim3(grid), dim3(256), LDS_BYTES, stream, p, l);
        hipLaunchKernelGGL(k_phase<2>, dim3(grid), dim3(256), LDS_BYTES, stream, p, l);
        hipLaunchKernelGGL(k_phase<3>, dim3(grid), dim3(256), LDS_BYTES, stream, p, l);
        hipLaunchKernelGGL(k_phase<4>, dim3(grid), dim3(256), LDS_BYTES, stream, p, l);
    }
}
```

```cpp
#include <hip/hip_runtime.h>
#include <hip/hip_cooperative_groups.h>
#include <stdint.h>
#include <stdio.h>
namespace cg = cooperative_groups;

typedef unsigned short bf16_t;
typedef short bf16x8 __attribute__((ext_vector_type(8)));
typedef float f32x4 __attribute__((ext_vector_type(4)));
typedef unsigned u32x4 __attribute__((ext_vector_type(4)));
typedef unsigned u32x2 __attribute__((ext_vector_type(2)));

constexpr int NB = 4, SEQ = 8192, NT = NB * SEQ, DM = 1024, DEPTH = 2;
constexpr int NIN = 2840, ZW = 2944;
constexpr int C_RGX = 0, C_RGG = 512, C_Q = 1024, C_KC = 1536, C_VC = 1664, C_KS = 1792, C_VS = 1920, C_KW = 2048, C_VW = 2176,
              C_NG = 2304, C_BG = 2816;
constexpr int NCH = SEQ / 64;
constexpr float EPS = 1e-6f;
constexpr float LOG2E = 1.4426950408889634f;

constexpr size_t AL(size_t x) { return (x + 255) & ~(size_t)255; }
constexpr size_t WS_WTIN = 0;
constexpr size_t WS_WTOUT = WS_WTIN + AL((size_t)DEPTH * ZW * DM * 2);
constexpr size_t WS_ROPE = WS_WTOUT + AL((size_t)DEPTH * DM * DM * 2);
constexpr size_t WS_W1T = WS_ROPE + AL((size_t)SEQ * 16 * 4);
constexpr size_t WS_B1 = WS_W1T + AL((size_t)DEPTH * 2 * 128 * 2048 * 2);
constexpr size_t WS_W2P = WS_B1 + AL((size_t)DEPTH * 2 * 128 * 4);
constexpr size_t WS_RGW = WS_W2P + AL((size_t)DEPTH * 2 * 8192 * 2);
constexpr size_t WS_SP = WS_RGW + AL((size_t)DEPTH * 2 * 8 * 4096 * 2);
constexpr size_t WS_MB = WS_SP + AL((size_t)DEPTH * 512 * 4);
constexpr size_t WS_XB = WS_MB + AL(256);
constexpr size_t WS_RSTD = WS_XB + AL((size_t)NT * DM * 2);
constexpr size_t WS_Z = WS_RSTD + AL((size_t)NT * 4);
constexpr size_t WS_QN = WS_Z + AL((size_t)NT * ZW * 2);
constexpr size_t WS_KS = WS_QN + AL((size_t)NT * 512 * 2);
constexpr size_t WS_KW = WS_KS + AL((size_t)NT * 128 * 2);
constexpr size_t WS_VST = WS_KW + AL((size_t)NT * 128 * 2);
constexpr size_t WS_VWT = WS_VST + AL((size_t)NT * 128 * 2);
constexpr size_t WS_KC = WS_VWT + AL((size_t)NT * 128 * 2);
constexpr size_t WS_VCT = WS_KC + AL((size_t)8 * 512 * 64 * 2);
constexpr size_t WS_HLOC = WS_VCT + AL((size_t)8 * 512 * 64 * 2);
constexpr size_t WS_PC = WS_HLOC + AL((size_t)NT * 512 * 2);
constexpr size_t WS_SUMH = WS_PC + AL((size_t)NT * 512 * 2);
constexpr size_t WS_SUMP = WS_SUMH + AL((size_t)NB * NCH * 512 * 4);
constexpr size_t WS_Y = WS_SUMP + AL((size_t)NB * NCH * 512 * 4);
constexpr size_t WS_BAR = WS_Y + AL((size_t)NT * DM * 2);
constexpr size_t WS_END = WS_BAR + 256;

struct Params {
    const float *x, *norm_g, *w_in, *conv_w, *conv_b, *rg_wr, *rg_br, *rg_wi, *rg_bi, *rg_lam, *q_g, *k_g, *pe_k, *w1_k, *w2_k, *pe_v,
        *w1_v, *w2_v, *w_out;
    float* out;
    unsigned char* ws;
};

__device__ __forceinline__ unsigned pk2(float lo, float hi) {
    unsigned r;
    asm volatile("v_cvt_pk_bf16_f32 %0, %1, %2" : "=v"(r) : "v"(lo), "v"(hi));
    return r;
}
__device__ __forceinline__ bf16_t f2bf(float f) { return (bf16_t)(pk2(f, 0.f) & 0xffffu); }
__device__ __forceinline__ float bf2f(unsigned h) { return __uint_as_float(h << 16); }
__device__ __forceinline__ float bflo(unsigned w) { return __uint_as_float(w << 16); }
__device__ __forceinline__ float bfhi(unsigned w) { return __uint_as_float(w & 0xffff0000u); }
__device__ __forceinline__ float sigmoidf_(float v) { return 1.f / (1.f + __expf(-v)); }
__device__ __forceinline__ float siluf_(float v) { return v / (1.f + __expf(-v)); }
__device__ __forceinline__ bf16x8 as_bf16x8(u32x4 v) { return __builtin_bit_cast(bf16x8, v); }
__device__ __forceinline__ float shf(float v, int src) { return __builtin_bit_cast(float, __builtin_amdgcn_ds_bpermute(src << 2, __builtin_bit_cast(int, v))); }
__device__ __forceinline__ unsigned shu(unsigned v, int src) { return (unsigned)__builtin_amdgcn_ds_bpermute(src << 2, (int)v); }
#define MFMA16(a, b, c) __builtin_amdgcn_mfma_f32_16x16x32_bf16((a), (b), (c), 0, 0, 0)
#define LDS_FENCE() asm volatile("s_waitcnt lgkmcnt(0)" ::: "memory")
struct Ids { int tid, bid; };
__device__ __forceinline__ Ids fresh_ids() {
    Ids i;
    const int lane = __builtin_amdgcn_mbcnt_hi(~0u, __builtin_amdgcn_mbcnt_lo(~0u, 0u));
    int wv = __builtin_amdgcn_readfirstlane(threadIdx.x >> 6);
    i.tid = wv * 64 + lane; i.bid = blockIdx.x;
    asm volatile("" : "+v"(i.tid), "+s"(i.bid));
    return i;
}
__device__ __forceinline__ void grid_barrier(unsigned* cnt, unsigned target) {
    asm volatile("s_waitcnt vmcnt(0)" ::: "memory");
    __syncthreads();
    const Ids ids = fresh_ids();
    if (ids.tid == 0) {
        __builtin_amdgcn_fence(__ATOMIC_RELEASE, "agent");
        asm volatile("s_waitcnt vmcnt(0)" ::: "memory");
        (void)__hip_atomic_fetch_add(cnt, 1u, __ATOMIC_RELAXED, __HIP_MEMORY_SCOPE_AGENT);
        unsigned sp = 0u;
        while (__hip_atomic_load(cnt, __ATOMIC_RELAXED, __HIP_MEMORY_SCOPE_AGENT) < target) { __builtin_amdgcn_s_sleep(1); if (++sp > (1u << 24)) break; }
        __builtin_amdgcn_fence(__ATOMIC_ACQUIRE, "agent");
        asm volatile("s_waitcnt vmcnt(0)" ::: "memory");
    }
    __syncthreads();
}

__device__ __forceinline__ void transpose_items(const float* W, int K, int N, int Npad, const float* kscale, bf16_t* Wt, int gtid, int gthreads) {
    const int total = (K / 8) * Npad;
    for (int it = gtid; it < total; it += gthreads) {
        const int n = it % Npad, kc = it / Npad;
        float v[8];
#pragma unroll
        for (int i = 0; i < 8; ++i) {
            const int k = kc * 8 + i;
            float w = (n < N) ? W[(size_t)k * N + n] : 0.f;
            if (kscale) w *= kscale[k];
            v[i] = w;
        }
        u32x4 o;
        o.x = pk2(v[0], v[1]); o.y = pk2(v[2], v[3]); o.z = pk2(v[4], v[5]); o.w = pk2(v[6], v[7]);
        *(u32x4*)(Wt + (size_t)n * K + kc * 8) = o;
    }
}

__device__ __forceinline__ void xrow_item(const float* xr, bf16_t* xb, float* rstd, int lane) {
    const f32x4* p = (const f32x4*)xr;
    f32x4 v[4];
    float s = 0.f;
#pragma unroll
    for (int j = 0; j < 4; ++j) { v[j] = p[j * 64 + lane]; s += v[j].x * v[j].x + v[j].y * v[j].y + v[j].z * v[j].z + v[j].w * v[j].w; }
#pragma unroll
    for (int o = 1; o < 64; o <<= 1) s += shf(s, lane ^ o);
    u32x2* q = (u32x2*)xb;
#pragma unroll
    for (int j = 0; j < 4; ++j) { u32x2 w; w.x = pk2(v[j].x, v[j].y); w.y = pk2(v[j].z, v[j].w); q[j * 64 + lane] = w; }
    if (lane == 0) *rstd = 1.0f / sqrtf(s * (1.0f / DM) + EPS);
}

__device__ __forceinline__ void phase_xprep(const Params& p, const float* xin) {
    const Ids ids = fresh_ids();
    const int lane = ids.tid & 63, gw = ids.bid * 4 + (ids.tid >> 6), nw = gridDim.x * 4;
    bf16_t* xb = (bf16_t*)(p.ws + WS_XB);
    float* rstd = (float*)(p.ws + WS_RSTD);
    for (int r = gw; r < NT; r += nw) xrow_item(xin + (size_t)r * DM, xb + (size_t)r * DM, rstd + r, lane);
}

__device__ __forceinline__ void phase_prologue(const Params& p) {
    const Ids ids = fresh_ids();
    const int gtid = ids.bid * 256 + ids.tid, gth = gridDim.x * 256;
    for (int l = 0; l < DEPTH; ++l) {
        transpose_items(p.w_in + (size_t)l * DM * NIN, DM, NIN, ZW, p.norm_g + l * DM, (bf16_t*)(p.ws + WS_WTIN) + (size_t)l * ZW * DM, gtid, gth);
        transpose_items(p.w_out + (size_t)l * DM * DM, DM, DM, DM, nullptr, (bf16_t*)(p.ws + WS_WTOUT) + (size_t)l * DM * DM, gtid, gth);
        transpose_items(p.w1_k + (size_t)l * 2048 * 128, 2048, 128, 128, nullptr, (bf16_t*)(p.ws + WS_W1T) + (size_t)(l * 2 + 0) * 128 * 2048, gtid, gth);
        transpose_items(p.w1_v + (size_t)l * 2048 * 128, 2048, 128, 128, nullptr, (bf16_t*)(p.ws + WS_W1T) + (size_t)(l * 2 + 1) * 128 * 2048, gtid, gth);
    }
    float* rope = (float*)(p.ws + WS_ROPE);
    for (int it = gtid; it < SEQ * 8; it += gth) {
        const int pos = it >> 3, i = it & 7;
        const float inv = powf(500000.0f, -(float)i / 8.0f);
        const float ang = (float)pos * inv;
        float sn, cs;
        sincosf(ang, &sn, &cs);
        rope[pos * 16 + i] = cs;
        rope[pos * 16 + 8 + i] = sn;
    }
    float* b1 = (float*)(p.ws + WS_B1);
    for (int it = gtid; it < DEPTH * 2 * 128; it += gth) {
        const int hu = it & 127, kv = (it >> 7) & 1, l = it >> 8;
        const float* pe = (kv ? p.pe_v : p.pe_k) + (size_t)l * 2048;
        const float* w1 = (kv ? p.w1_v : p.w1_k) + (size_t)l * 2048 * 128;
        float s = 0.f;
        for (int k = 0; k < 2048; ++k) s += pe[k] * w1[(size_t)k * 128 + hu];
        b1[it] = s;
    }
    bf16_t* w2p = (bf16_t*)(p.ws + WS_W2P);
    for (int it = gtid; it < DEPTH * 2 * 8192; it += gth) {
        const int jj = it & 7, quad = (it >> 3) & 3, r = (it >> 5) & 15, dt = (it >> 9) & 3, s = (it >> 11) & 3, kv = (it >> 13) & 1, l = it >> 14;
        const int hu = 16 * (2 * s + (jj >> 2)) + 4 * quad + (jj & 3), d = 16 * dt + r;
        const float* w2 = (kv ? p.w2_v : p.w2_k) + (size_t)l * 128 * 64;
        w2p[it] = f2bf(w2[hu * 64 + d]);
    }
    bf16_t* rgw = (bf16_t*)(p.ws + WS_RGW);
    for (int it = gtid; it < DEPTH * 2 * 8 * 4096; it += gth) {
        const int in = it & 63, out = (it >> 6) & 63, n = (it >> 12) & 7, gate = (it >> 15) & 1, l = it >> 16;
        const float* w = (gate ? p.rg_wi : p.rg_wr) + (size_t)l * 8 * 4096 + n * 4096;
        rgw[it] = f2bf(w[in * 64 + out]);
    }
    float* sp = (float*)(p.ws + WS_SP);
    for (int it = gtid; it < DEPTH * 512; it += gth) {
        const float v = -p.rg_lam[it];
        sp[it] = (v > 20.f) ? v : log1pf(expf(v));
    }
    if (gtid < DEPTH * 4) {
        const int l = gtid >> 2, br = gtid & 3;
        float mq = 0.f, mk = 0.f;
        for (int i = 0; i < 64; ++i) { mq = fmaxf(mq, fabsf(p.q_g[l * 64 + i])); if (br < 3) mk = fmaxf(mk, fabsf(p.k_g[(l * 3 + br) * 64 + i])); }
        ((float*)(p.ws + WS_MB))[gtid] = 8.0f * mq * mk * LOG2E * 1.0001f;
    }
    phase_xprep(p, p.x);
}

constexpr int GEMM_LDS = 65536;
template <int EPI>
__device__ __forceinline__ void gemm_tile(const bf16_t* __restrict__ A, const bf16_t* __restrict__ Bt, int K, int row0, int col0,
                                          unsigned char* lds, const float* rstd, bf16_t* zout, const float* xin, float* xout, int tid) {
    const int wid = tid >> 6, lane = tid & 63, wr = wid >> 1, wc = wid & 1, fr = lane & 15, quad = lane >> 4;
    f32x4 acc[4][4];
#pragma unroll
    for (int m = 0; m < 4; ++m)
#pragma unroll
        for (int n = 0; n < 4; ++n) acc[m][n] = (f32x4){0.f, 0.f, 0.f, 0.f};
    const bf16_t* ag[4];
    const bf16_t* bg[4];
    int soff[4];
#pragma unroll
    for (int i = 0; i < 4; ++i) {
        const int id = tid + 256 * i, r = id >> 3, c = id & 7;
        ag[i] = A + (size_t)(row0 + r) * K + c * 8;
        bg[i] = Bt + (size_t)(col0 + r) * K + c * 8;
        soff[i] = r * 128 + ((c ^ (r & 7)) << 4);
    }
    u32x4 ra[4], rb[4];
#pragma unroll
    for (int i = 0; i < 4; ++i) { ra[i] = *(const u32x4*)(ag[i]); rb[i] = *(const u32x4*)(bg[i]); }
    __syncthreads();
#pragma unroll
    for (int i = 0; i < 4; ++i) { *(u32x4*)(lds + soff[i]) = ra[i]; *(u32x4*)(lds + 32768 + soff[i]) = rb[i]; }
    __syncthreads();
    const int nk = K / 64;
    for (int kt = 0; kt < nk; ++kt) {
        const int buf = kt & 1;
        if (kt + 1 < nk) {
#pragma unroll
            for (int i = 0; i < 4; ++i) { ra[i] = *(const u32x4*)(ag[i] + (kt + 1) * 64); rb[i] = *(const u32x4*)(bg[i] + (kt + 1) * 64); }
        }
        const unsigned char* la = lds + buf * 16384;
        const unsigned char* lb = lds + 32768 + buf * 16384;
#pragma unroll
        for (int ks = 0; ks < 2; ++ks) {
            bf16x8 af[4], bf[4];
#pragma unroll
            for (int m = 0; m < 4; ++m) { const int r = wr * 64 + m * 16 + fr; af[m] = *(const bf16x8*)(la + r * 128 + (((ks * 4 + quad) ^ (r & 7)) << 4)); }
#pragma unroll
            for (int n = 0; n < 4; ++n) { const int r = wc * 64 + n * 16 + fr; bf[n] = *(const bf16x8*)(lb + r * 128 + (((ks * 4 + quad) ^ (r & 7)) << 4)); }
#pragma unroll
            for (int m = 0; m < 4; ++m)
#pragma unroll
                for (int n = 0; n < 4; ++n) acc[m][n] = MFMA16(bf[n], af[m], acc[m][n]);
        }
        if (kt + 1 < nk) {
            unsigned char* wa = lds + (buf ^ 1) * 16384;
            unsigned char* wb = lds + 32768 + (buf ^ 1) * 16384;
#pragma unroll
            for (int i = 0; i < 4; ++i) { *(u32x4*)(wa + soff[i]) = ra[i]; *(u32x4*)(wb + soff[i]) = rb[i]; }
        }
        __syncthreads();
    }
#pragma unroll
    for (int m = 0; m < 4; ++m) {
        const int row = row0 + wr * 64 + m * 16 + fr;
        if (EPI == 0) {
            const float rs = rstd[row];
#pragma unroll
            for (int n = 0; n < 4; ++n) {
                const int col = col0 + wc * 64 + n * 16 + 4 * quad;
                u32x2 w; w.x = pk2(acc[m][n].x * rs, acc[m][n].y * rs); w.y = pk2(acc[m][n].z * rs, acc[m][n].w * rs);
                *(u32x2*)(zout + (size_t)row * ZW + col) = w;
            }
        } else {
#pragma unroll
            for (int n = 0; n < 4; ++n) {
                const int col = col0 + wc * 64 + n * 16 + 4 * quad;
                const f32x4 xv = *(const f32x4*)(xin + (size_t)row * DM + col);
                *(f32x4*)(xout + (size_t)row * DM + col) = xv + acc[m][n];
            }
        }
    }
}

__device__ __forceinline__ void phase_gemm_in(const Params& p, int l, unsigned char* lds) {
    const bf16_t* A = (const bf16_t*)(p.ws + WS_XB);
    const bf16_t* Bt = (const bf16_t*)(p.ws + WS_WTIN) + (size_t)l * ZW * DM;
    constexpr int NTN = ZW / 128, NTM = NT / 128;
    const Ids ids = fresh_ids();
    for (int t = ids.bid; t < NTM * NTN; t += gridDim.x) {
        const int tm = t / NTN, tn = t % NTN;
        gemm_tile<0>(A, Bt, DM, tm * 128, tn * 128, lds, (const float*)(p.ws + WS_RSTD), (bf16_t*)(p.ws + WS_Z), nullptr, nullptr, ids.tid);
    }
}
__device__ __forceinline__ void phase_gemm_out(const Params& p, int l, unsigned char* lds, const float* xin, float* xout) {
    const bf16_t* A = (const bf16_t*)(p.ws + WS_Y);
    const bf16_t* Bt = (const bf16_t*)(p.ws + WS_WTOUT) + (size_t)l * DM * DM;
    constexpr int NTN = DM / 128, NTM = NT / 128;
    const Ids ids = fresh_ids();
    for (int t = ids.bid; t < NTM * NTN; t += gridDim.x) {
        const int tm = t / NTN, tn = t % NTN;
        gemm_tile<1>(A, Bt, DM, tm * 128, tn * 128, lds, nullptr, nullptr, xin, xout, ids.tid);
    }
}

__device__ __forceinline__ void qkv_item(const Params& p, int l, int tt, int slot, int lane) {
    const bf16_t* z = (const bf16_t*)(p.ws + WS_Z);
    const int t = tt * 64 + lane, b = t / SEQ, s = t % SEQ;
    int col; const float* gp = nullptr;
    if (slot < 8) { col = C_Q + slot * 64; gp = p.q_g + l * 64; }
    else if (slot < 10) { col = C_KS + (slot - 8) * 64; gp = p.k_g + (l * 3 + 1) * 64; }
    else if (slot < 12) { col = C_KW + (slot - 10) * 64; gp = p.k_g + (l * 3 + 2) * 64; }
    else if (slot < 14) { col = C_VS + (slot - 12) * 64; }
    else { col = C_VW + (slot - 14) * 64; }
    const u32x4* zr = (const u32x4*)(z + (size_t)t * ZW + col);
    u32x4 raw[8];
#pragma unroll
    for (int i = 0; i < 8; ++i) raw[i] = zr[i];
    if (slot < 12) {
        float v[64];
#pragma unroll
        for (int i = 0; i < 8; ++i) {
            v[8 * i + 0] = bflo(raw[i].x); v[8 * i + 1] = bfhi(raw[i].x); v[8 * i + 2] = bflo(raw[i].y); v[8 * i + 3] = bfhi(raw[i].y);
            v[8 * i + 4] = bflo(raw[i].z); v[8 * i + 5] = bfhi(raw[i].z); v[8 * i + 6] = bflo(raw[i].w); v[8 * i + 7] = bfhi(raw[i].w);
        }
        float ss = 0.f;
#pragma unroll
        for (int d = 0; d < 64; ++d) ss += v[d] * v[d];
        const float rinv = 1.0f / sqrtf(ss * (1.0f / 64.0f) + EPS);
#pragma unroll
        for (int d = 0; d < 64; ++d) v[d] = v[d] * rinv * gp[d];
        const f32x4* rp = (const f32x4*)((const float*)(p.ws + WS_ROPE) + s * 16);
        const f32x4 c0 = rp[0], c1 = rp[1], s0 = rp[2], s1 = rp[3];
        const float cs[8] = {c0.x, c0.y, c0.z, c0.w, c1.x, c1.y, c1.z, c1.w};
        const float sn[8] = {s0.x, s0.y, s0.z, s0.w, s1.x, s1.y, s1.z, s1.w};
#pragma unroll
        for (int i = 0; i < 8; ++i) { const float x1 = v[i], x2 = v[8 + i]; v[i] = x1 * cs[i] - x2 * sn[i]; v[8 + i] = x2 * cs[i] + x1 * sn[i]; }
        bf16_t* dst;
        if (slot < 8) dst = (bf16_t*)(p.ws + WS_QN) + (size_t)t * 512 + slot * 64;
        else if (slot < 10) dst = (bf16_t*)(p.ws + WS_KS) + ((size_t)(b * 2 + (slot - 8)) * SEQ + s) * 64;
        else dst = (bf16_t*)(p.ws + WS_KW) + ((size_t)(b * 2 + (slot - 10)) * SEQ + s) * 64;
#pragma unroll
        for (int i = 0; i < 8; ++i) {
            u32x4 o; o.x = pk2(v[8 * i], v[8 * i + 1]); o.y = pk2(v[8 * i + 2], v[8 * i + 3]); o.z = pk2(v[8 * i + 4], v[8 * i + 5]); o.w = pk2(v[8 * i + 6], v[8 * i + 7]);
            ((u32x4*)dst)[i] = o;
        }
    } else {
        bf16_t* dst = (slot < 14) ? (bf16_t*)(p.ws + WS_VST) + ((size_t)(b * 2 + (slot - 12)) * 64) * SEQ + s
                                  : (bf16_t*)(p.ws + WS_VWT) + ((size_t)(b * 2 + (slot - 14)) * 64) * SEQ + s;
#pragma unroll
        for (int i = 0; i < 8; ++i) {
            const unsigned w[4] = {raw[i].x, raw[i].y, raw[i].z, raw[i].w};
#pragma unroll
            for (int k = 0; k < 4; ++k) {
                dst[(size_t)(8 * i + 2 * k) * SEQ] = (bf16_t)(w[k] & 0xffffu);
                dst[(size_t)(8 * i + 2 * k + 1) * SEQ] = (bf16_t)(w[k] >> 16);
            }
        }
    }
}

__device__ __forceinline__ void rg_item(const Params& p, int l, int b, int ch, int n, float* xcf, int lane) {
    const bf16_t* z = (const bf16_t*)(p.ws + WS_Z);
    const int fr = lane & 15, quad = lane >> 4;
    const size_t t0 = (size_t)b * SEQ + (size_t)ch * 64;
    {
        const int c = n * 64 + lane;
        const float w0 = p.conv_w[(l * 4 + 0) * 512 + c], w1 = p.conv_w[(l * 4 + 1) * 512 + c], w2 = p.conv_w[(l * 4 + 2) * 512 + c],
                    w3 = p.conv_w[(l * 4 + 3) * 512 + c], cb = p.conv_b[l * 512 + c];
        const bf16_t* zc = z + t0 * ZW + C_RGX + c;
        float xm3 = 0.f, xm2 = 0.f, xm1 = 0.f;
        if (ch > 0) { xm3 = bf2f(zc[-3 * ZW]); xm2 = bf2f(zc[-2 * ZW]); xm1 = bf2f(zc[-1 * ZW]); }
#pragma unroll 8
        for (int tt = 0; tt < 64; ++tt) {
            const float x0 = bf2f(zc[(size_t)tt * ZW]);
            xcf[tt * 68 + lane] = w0 * xm3 + w1 * xm2 + w2 * xm1 + w3 * x0 + cb;
            xm3 = xm2; xm2 = xm1; xm1 = x0;
        }
    }
    LDS_FENCE();
    bf16x8 af[4][2];
#pragma unroll
    for (int m = 0; m < 4; ++m)
#pragma unroll
        for (int ks = 0; ks < 2; ++ks) {
            const f32x4* src = (const f32x4*)(xcf + (16 * m + fr) * 68 + 32 * ks + 8 * quad);
            const f32x4 a = src[0], c = src[1];
            u32x4 w; w.x = pk2(a.x, a.y); w.y = pk2(a.z, a.w); w.z = pk2(c.x, c.y); w.w = pk2(c.z, c.w);
            af[m][ks] = as_bf16x8(w);
        }
    const bf16_t* wr_ = (const bf16_t*)(p.ws + WS_RGW) + ((size_t)(l * 2 + 0) * 8 + n) * 4096;
    const bf16_t* wi_ = (const bf16_t*)(p.ws + WS_RGW) + ((size_t)(l * 2 + 1) * 8 + n) * 4096;
    bf16_t* hloc = (bf16_t*)(p.ws + WS_HLOC);
    bf16_t* pc = (bf16_t*)(p.ws + WS_PC);
#pragma unroll 1
    for (int nt = 0; nt < 4; ++nt) {
        const int c = n * 64 + 16 * nt + fr;
        f32x4 ar[4], ai[4];
#pragma unroll
        for (int m = 0; m < 4; ++m) { ar[m] = (f32x4){0.f, 0.f, 0.f, 0.f}; ai[m] = (f32x4){0.f, 0.f, 0.f, 0.f}; }
#pragma unroll
        for (int ks = 0; ks < 2; ++ks) {
            const bf16x8 br = *(const bf16x8*)(wr_ + (16 * nt + fr) * 64 + 32 * ks + 8 * quad);
            const bf16x8 bi = *(const bf16x8*)(wi_ + (16 * nt + fr) * 64 + 32 * ks + 8 * quad);
#pragma unroll
            for (int m = 0; m < 4; ++m) { ar[m] = MFMA16(af[m][ks], br, ar[m]); ai[m] = MFMA16(af[m][ks], bi, ai[m]); }
        }
        const float brv = p.rg_br[l * 512 + c], biv = p.rg_bi[l * 512 + c], spv = ((const float*)(p.ws + WS_SP))[l * 512 + c];
        float Am = 1.f, Hm = 0.f;
#pragma unroll
        for (int m = 0; m < 4; ++m) {
            float Pl[4], hl[4];
            float pa = 1.f, ph = 0.f;
#pragma unroll
            for (int j = 0; j < 4; ++j) {
                const float xcv = xcf[(16 * m + 4 * quad + j) * 68 + 16 * nt + fr];
                const float r = sigmoidf_(ar[m][j] + brv), ig = sigmoidf_(ai[m][j] + biv);
                const float la = -8.0f * r * spv;
                const float a = __expf(la);
                const float u = sqrtf(-expm1f(2.0f * la)) * (ig * xcv);
                pa = pa * a; ph = a * ph + u;
                Pl[j] = pa; hl[j] = ph;
            }
            float Ai = pa, Hi = ph;
            {
                const float a1 = shf(Ai, lane - 16), h1 = shf(Hi, lane - 16);
                if (quad >= 1) { Hi = Ai * h1 + Hi; Ai = a1 * Ai; }
                const float a2 = shf(Ai, lane - 32), h2 = shf(Hi, lane - 32);
                if (quad >= 2) { Hi = Ai * h2 + Hi; Ai = a2 * Ai; }
            }
            float Ae = shf(Ai, lane - 16), He = shf(Hi, lane - 16);
            if (quad == 0) { Ae = 1.f; He = 0.f; }
            const float Pin = Am * Ae, Hin = Ae * Hm + He;
#pragma unroll
            for (int j = 0; j < 4; ++j) {
                const size_t t = t0 + 16 * m + 4 * quad + j;
                hloc[t * 512 + c] = f2bf(hl[j] + Pl[j] * Hin);
                pc[t * 512 + c] = f2bf(Pl[j] * Pin);
            }
            const float A3 = shf(Ai, 48 + fr), H3 = shf(Hi, 48 + fr);
            Hm = A3 * Hm + H3; Am = Am * A3;
        }
        if (quad == 0) {
            ((float*)(p.ws + WS_SUMH))[((size_t)b * NCH + ch) * 512 + c] = Hm;
            ((float*)(p.ws + WS_SUMP))[((size_t)b * NCH + ch) * 512 + c] = Am;
        }
    }
    LDS_FENCE();
}

__device__ __forceinline__ void cmp_item(const Params& p, int l, int kv, int bg, int blk32, int lane) {
    const bf16_t* z = (const bf16_t*)(p.ws + WS_Z);
    const int fr = lane & 15, quad = lane >> 4, b = bg >> 1, g = bg & 1;
    const int i0 = blk32 * 32;
    const bf16_t* w1t = (const bf16_t*)(p.ws + WS_W1T) + (size_t)(l * 2 + kv) * 128 * 2048;
    const int colbase = (kv ? C_VC : C_KC) + g * 64;
    f32x4 acc[8][2];
#pragma unroll
    for (int mt = 0; mt < 8; ++mt) { acc[mt][0] = (f32x4){0.f, 0.f, 0.f, 0.f}; acc[mt][1] = (f32x4){0.f, 0.f, 0.f, 0.f}; }
    const bf16_t* arow = w1t + (size_t)fr * 2048 + 8 * quad;
    const int blkA = i0 + fr, blkB = i0 + 16 + fr;
#pragma unroll 2
    for (int kk = 0; kk < 64; ++kk) {
        const int j = kk >> 1, d = 32 * (kk & 1) + 8 * quad;
        int tokA = 16 * blkA + j, tokB = 16 * blkB + j;
        tokA = tokA < SEQ ? tokA : SEQ - 1; tokB = tokB < SEQ ? tokB : SEQ - 1;
        const bf16x8 bA = *(const bf16x8*)(z + ((size_t)b * SEQ + tokA) * ZW + colbase + d);
        const bf16x8 bB = *(const bf16x8*)(z + ((size_t)b * SEQ + tokB) * ZW + colbase + d);
#pragma unroll
        for (int mt = 0; mt < 8; ++mt) {
            const bf16x8 a = *(const bf16x8*)(arow + (size_t)mt * 16 * 2048 + kk * 32);
            acc[mt][0] = MFMA16(a, bA, acc[mt][0]);
            acc[mt][1] = MFMA16(a, bB, acc[mt][1]);
        }
    }
    const float* b1 = (const float*)(p.ws + WS_B1) + (l * 2 + kv) * 128;
    const bf16_t* w2p = (const bf16_t*)(p.ws + WS_W2P) + (size_t)(l * 2 + kv) * 8192;
    f32x4 o[4][2];
#pragma unroll
    for (int dt = 0; dt < 4; ++dt) { o[dt][0] = (f32x4){0.f, 0.f, 0.f, 0.f}; o[dt][1] = (f32x4){0.f, 0.f, 0.f, 0.f}; }
#pragma unroll
    for (int s = 0; s < 4; ++s) {
        bf16x8 hf[2];
#pragma unroll
        for (int ct = 0; ct < 2; ++ct) {
            float h[8];
#pragma unroll
            for (int e = 0; e < 8; ++e) { const int mt = 2 * s + (e >> 2); h[e] = siluf_(acc[mt][ct][e & 3] + b1[16 * mt + 4 * quad + (e & 3)]); }
            u32x4 w; w.x = pk2(h[0], h[1]); w.y = pk2(h[2], h[3]); w.z = pk2(h[4], h[5]); w.w = pk2(h[6], h[7]);
            hf[ct] = as_bf16x8(w);
        }
#pragma unroll
        for (int dt = 0; dt < 4; ++dt) {
            const bf16x8 a = *(const bf16x8*)(w2p + ((((s * 4 + dt) * 16 + fr) * 4 + quad) * 8));
            o[dt][0] = MFMA16(a, hf[0], o[dt][0]);
            o[dt][1] = MFMA16(a, hf[1], o[dt][1]);
        }
    }
#pragma unroll
    for (int ct = 0; ct < 2; ++ct) {
        const int blk = i0 + 16 * ct + fr;
        const bool valid = blk < 511;
        if (kv == 0) {
            float ss = 0.f;
#pragma unroll
            for (int dt = 0; dt < 4; ++dt) ss += o[dt][ct].x * o[dt][ct].x + o[dt][ct].y * o[dt][ct].y + o[dt][ct].z * o[dt][ct].z + o[dt][ct].w * o[dt][ct].w;
            ss += shf(ss, lane ^ 16); ss += shf(ss, lane ^ 32);
            const float rinv = 1.0f / sqrtf(ss * (1.0f / 64.0f) + EPS);
            const float* kg = p.k_g + (l * 3 + 0) * 64;
            float v[4][4];
#pragma unroll
            for (int dt = 0; dt < 4; ++dt)
#pragma unroll
                for (int j = 0; j < 4; ++j) v[dt][j] = o[dt][ct][j] * rinv * kg[16 * dt + 4 * quad + j];
            const int pos = 16 * (valid ? blk : 0) + 31;
            const float* rp = (const float*)(p.ws + WS_ROPE) + pos * 16;
#pragma unroll
            for (int j = 0; j < 4; ++j) {
                const float own = v[0][j], oth = shf(own, lane ^ 32);
                const int i = 4 * (quad & 1) + j;
                const float cs = rp[i], sn = rp[8 + i];
                v[0][j] = (quad < 2) ? (own * cs - oth * sn) : (own * cs + oth * sn);
            }
            bf16_t* dst = (bf16_t*)(p.ws + WS_KC) + ((size_t)bg * 512 + blk) * 64;
#pragma unroll
            for (int dt = 0; dt < 4; ++dt) {
                u32x2 w; w.x = valid ? pk2(v[dt][0], v[dt][1]) : 0u; w.y = valid ? pk2(v[dt][2], v[dt][3]) : 0u;
                *(u32x2*)(dst + 16 * dt + 4 * quad) = w;
            }
        } else {
            bf16_t* dst = (bf16_t*)(p.ws + WS_VCT) + (size_t)bg * 64 * 512 + blk;
#pragma unroll
            for (int dt = 0; dt < 4; ++dt)
#pragma unroll
                for (int j = 0; j < 4; ++j) dst[(size_t)(16 * dt + 4 * quad + j) * 512] = valid ? f2bf(o[dt][ct][j]) : (bf16_t)0;
        }
    }
}

__device__ __forceinline__ void phase_post(const Params& p, int l, unsigned char* lds) {
    const Ids ids = fresh_ids();
    const int wid = ids.tid >> 6, lane = ids.tid & 63, gw = ids.bid * 4 + wid, nw = gridDim.x * 4;
    float* xcf = (float*)(lds + wid * 17408);
    constexpr int N_CMP = 2 * 8 * 16, N_RG = NB * NCH * 8, N_QKV = (NT / 64) * 16;
    for (int it = gw; it < N_CMP + N_RG + N_QKV; it += nw) {
        if (it < N_CMP) { cmp_item(p, l, it & 1, (it >> 1) & 7, it >> 4, lane); }
        else if (it < N_CMP + N_RG) { const int r = it - N_CMP; rg_item(p, l, r / (NCH * 8), (r / 8) % NCH, r & 7, xcf, lane); }
        else { const int r = it - N_CMP - N_RG; qkv_item(p, l, r >> 4, r & 15, lane); }
    }
}

template <bool DO_PV, bool NORM, bool IMP>
__device__ __forceinline__ void attn_step(const bf16_t* __restrict__ Kb, const bf16_t* __restrict__ Vt, int NK, int kb, int fr, int quad,
                                          const bf16x8 (&qf)[4][2], f32x4 (&O)[4][4], float (&lsum)[4], const float (&invl)[4], int lo, int hi,
                                          float sc, float mb, float (&ps)[8]) {
    f32x4 sT[2][4];
#pragma unroll
    for (int T = 0; T < 2; ++T) {
        const int key = kb + (fr >> 2) * 8 + T * 4 + (fr & 3);
        const bf16_t* kp = Kb + (size_t)key * 64 + 8 * quad;
        const bf16x8 k0 = *(const bf16x8*)kp, k1 = *(const bf16x8*)(kp + 32);
#pragma unroll
        for (int h = 0; h < 4; ++h) {
            sT[T][h] = MFMA16(k0, qf[h][0], ((f32x4){0.f, 0.f, 0.f, 0.f}));
            sT[T][h] = MFMA16(k1, qf[h][1], sT[T][h]);
        }
    }
    bool vm[8];
#pragma unroll
    for (int e = 0; e < 8; ++e) { const int k = kb + 8 * quad + e; vm[e] = (k > lo) && (k <= hi); }
    bf16x8 pf[4];
#pragma unroll
    for (int h = 0; h < 4; ++h) {
        float pv[8];
#pragma unroll
        for (int e = 0; e < 8; ++e) {
            float v = __builtin_amdgcn_exp2f(sT[e >> 2][h][e & 3] * sc - mb);
            v = vm[e] ? v : 0.f;
            if (NORM) v *= invl[h]; else lsum[h] += v;
            if (IMP) ps[e] += v;
            pv[e] = v;
        }
        u32x4 w; w.x = pk2(pv[0], pv[1]); w.y = pk2(pv[2], pv[3]); w.z = pk2(pv[4], pv[5]); w.w = pk2(pv[6], pv[7]);
        pf[h] = as_bf16x8(w);
    }
    if (DO_PV) {
#pragma unroll
        for (int dt = 0; dt < 4; ++dt) {
            const bf16x8 vf = *(const bf16x8*)(Vt + (size_t)(16 * dt + fr) * NK + kb + 8 * quad);
#pragma unroll
            for (int h = 0; h < 4; ++h) O[dt][h] = MFMA16(vf, pf[h], O[dt][h]);
        }
    }
}

__device__ __forceinline__ void attn_item(const Params& p, int l, int bg, int qt, float* ldsw, int lane) {
    const bf16_t* z = (const bf16_t*)(p.ws + WS_Z);
    const int fr = lane & 15, quad = lane >> 4, b = bg >> 1, g = bg & 1;
    const int s0 = qt * 16, tq = s0 + fr;
    const size_t trow = (size_t)b * SEQ + tq;
    bf16x8 qf[4][2];
    {
        const bf16_t* qp = (const bf16_t*)(p.ws + WS_QN) + trow * 512 + (4 * g) * 64 + 8 * quad;
#pragma unroll
        for (int h = 0; h < 4; ++h) { qf[h][0] = *(const bf16x8*)(qp + h * 64); qf[h][1] = *(const bf16x8*)(qp + h * 64 + 32); }
    }
    const bf16_t* gatep = z + trow * ZW + C_BG + 12 * g;
#define GATE(h, br) sigmoidf_(bf2f(gatep[(h) * 3 + (br)]))
    const float sc = 0.125f * LOG2E;
    const float* mbp = (const float*)(p.ws + WS_MB) + l * 4;
    const float one4[4] = {1.f, 1.f, 1.f, 1.f};
    f32x4 O[4][4];
    float lsum[4], invl[4], ps[8];
    const bf16_t* kc = (const bf16_t*)(p.ws + WS_KC) + (size_t)bg * 512 * 64;
    const bf16_t* vct = (const bf16_t*)(p.ws + WS_VCT) + (size_t)bg * 64 * 512;
    const int nmax = s0 >> 4;
    const int hi_c = ((fr == 15) ? nmax : nmax - 1) - 1;
    const int nsteps = (nmax + 31) >> 5;
    const float mb_c = mbp[0];
#pragma unroll
    for (int h = 0; h < 4; ++h) lsum[h] = 0.f;
#pragma unroll
    for (int dt = 0; dt < 4; ++dt)
#pragma unroll
        for (int h = 0; h < 4; ++h) O[dt][h] = (f32x4){0.f, 0.f, 0.f, 0.f};
    for (int st = 0; st < nsteps; ++st) attn_step<false, false, false>(kc, vct, 512, st * 32, fr, quad, qf, O, lsum, one4, -1, hi_c, sc, mb_c, ps);
#pragma unroll
    for (int h = 0; h < 4; ++h) {
        float v = lsum[h]; v += shf(v, lane ^ 16); v += shf(v, lane ^ 32);
        invl[h] = v > 0.f ? 1.0f / v : 0.f;
    }
    float co_prev = 0.f;
    for (int st = 0; st < nsteps; ++st) {
#pragma unroll
        for (int e = 0; e < 8; ++e) ps[e] = 0.f;
        attn_step<true, true, true>(kc, vct, 512, st * 32, fr, quad, qf, O, lsum, invl, -1, hi_c, sc, mb_c, ps);
        float X0 = ps[0] + ps[1] + ps[2] + 0.5f * ps[3];
        const float X1 = ps[4] + ps[5] + ps[6] + 0.5f * ps[7] + 0.5f * ps[3];
        const float co = 0.5f * ps[7];
        const float send = (quad == 3) ? co_prev : co;
        X0 += shf(send, (lane + 48) & 63);
        co_prev = co;
        const int j0 = st * 8 + 2 * quad;
        ldsw[j0 * 16 + fr] = X0;
        ldsw[(j0 + 1) * 16 + fr] = X1;
    }
    LDS_FENCE();
    const int bt = s0 >> 6;
    unsigned mymask = 0u;
    if (bt >= 16) {
        unsigned key[32];
#pragma unroll
        for (int i = 0; i < 32; ++i) {
            const int j = 32 * quad + i;
            const unsigned bits = __float_as_uint(ldsw[j * 16 + fr]);
            key[i] = (j >= 1 && j <= bt - 2) ? ((bits & ~127u) | (unsigned)(127 - j)) : 0u;
        }
        for (int it = 0; it < 13; ++it) {
            unsigned m = 0u;
#pragma unroll
            for (int i = 0; i < 32; ++i) m = key[i] > m ? key[i] : m;
            { const unsigned o = shu(m, lane ^ 16); m = o > m ? o : m; }
            { const unsigned o = shu(m, lane ^ 32); m = o > m ? o : m; }
            const int jsel = 127 - (int)(m & 127u);
            if ((jsel >> 5) == quad) mymask |= 1u << (jsel & 31);
#pragma unroll
            for (int i = 0; i < 32; ++i) key[i] = (key[i] == m) ? 0u : key[i];
        }
        if (quad == 0) mymask |= 1u;
        if (((bt - 1) >> 5) == quad) mymask |= 1u << ((bt - 1) & 31);
        if ((bt >> 5) == quad) mymask |= 1u << (bt & 31);
    } else {
        if (quad == 0) mymask = (2u << bt) - 1u;
    }
    LDS_FENCE();
#pragma unroll
    for (int dt = 0; dt < 4; ++dt)
#pragma unroll
        for (int h = 0; h < 4; ++h)
#pragma unroll
            for (int j = 0; j < 4; ++j) ldsw[((dt * 4 + h) * 4 + j) * 64 + lane] = O[dt][h][j];
    {
        const bf16_t* ksb = (const bf16_t*)(p.ws + WS_KS) + (size_t)bg * SEQ * 64;
        const bf16_t* vst = (const bf16_t*)(p.ws + WS_VST) + (size_t)bg * 64 * SEQ;
        const float mb_s = mbp[1];
#pragma unroll
        for (int h = 0; h < 4; ++h) lsum[h] = 0.f;
#pragma unroll
        for (int dt = 0; dt < 4; ++dt)
#pragma unroll
            for (int h = 0; h < 4; ++h) O[dt][h] = (f32x4){0.f, 0.f, 0.f, 0.f};
        unsigned curw = 0u;
        for (int jb = 0; jb <= bt; ++jb) {
            if ((jb & 31) == 0) curw = shu(mymask, fr + 16 * (jb >> 5));
            const bool sel = (curw >> (jb & 31)) & 1u;
            if (__ballot(sel) == 0ull) continue;
            const int hi = sel ? tq : -1;
            attn_step<true, false, false>(ksb, vst, SEQ, jb * 64, fr, quad, qf, O, lsum, one4, -1, hi, sc, mb_s, ps);
            attn_step<true, false, false>(ksb, vst, SEQ, jb * 64 + 32, fr, quad, qf, O, lsum, one4, -1, hi, sc, mb_s, ps);
        }
#pragma unroll
        for (int h = 0; h < 4; ++h) {
            float v = lsum[h]; v += shf(v, lane ^ 16); v += shf(v, lane ^ 32);
            const float coef = v > 0.f ? GATE(h, 1) / v : 0.f;
            const float gc = GATE(h, 0);
#pragma unroll
            for (int dt = 0; dt < 4; ++dt)
#pragma unroll
                for (int j = 0; j < 4; ++j) { const int ix = ((dt * 4 + h) * 4 + j) * 64 + lane; ldsw[ix] = gc * ldsw[ix] + coef * O[dt][h][j]; }
        }
    }
    {
        const bf16_t* kwb = (const bf16_t*)(p.ws + WS_KW) + (size_t)bg * SEQ * 64;
        const bf16_t* vwt = (const bf16_t*)(p.ws + WS_VWT) + (size_t)bg * 64 * SEQ;
        const float mb_w = mbp[2];
#pragma unroll
        for (int h = 0; h < 4; ++h) lsum[h] = 0.f;
#pragma unroll
        for (int dt = 0; dt < 4; ++dt)
#pragma unroll
            for (int h = 0; h < 4; ++h) O[dt][h] = (f32x4){0.f, 0.f, 0.f, 0.f};
        int kstart = s0 - 511; kstart = kstart < 0 ? 0 : kstart; kstart &= ~31;
        for (int kb = kstart; kb <= s0 + 15; kb += 32)
            attn_step<true, false, false>(kwb, vwt, SEQ, kb, fr, quad, qf, O, lsum, one4, tq - 512, tq, sc, mb_w, ps);
        const bf16_t* ng = z + trow * ZW + C_NG + (4 * g) * 64 + 4 * quad;
        bf16_t* yo = (bf16_t*)(p.ws + WS_Y) + trow * DM + 512 + (4 * g) * 64 + 4 * quad;
#pragma unroll
        for (int h = 0; h < 4; ++h) {
            float v = lsum[h]; v += shf(v, lane ^ 16); v += shf(v, lane ^ 32);
            const float coef = v > 0.f ? GATE(h, 2) / v : 0.f;
#pragma unroll
            for (int dt = 0; dt < 4; ++dt) {
                float r[4];
#pragma unroll
                for (int j = 0; j < 4; ++j) r[j] = ldsw[((dt * 4 + h) * 4 + j) * 64 + lane] + coef * O[dt][h][j];
                const u32x2 gw = *(const u32x2*)(ng + h * 64 + 16 * dt);
                r[0] *= siluf_(bflo(gw.x)); r[1] *= siluf_(bfhi(gw.x)); r[2] *= siluf_(bflo(gw.y)); r[3] *= siluf_(bfhi(gw.y));
                u32x2 w; w.x = pk2(r[0], r[1]); w.y = pk2(r[2], r[3]);
                *(u32x2*)(yo + h * 64 + 16 * dt) = w;
            }
        }
    }
    LDS_FENCE();
#undef GATE
}

__device__ __forceinline__ void rgfin_item(const Params& p, int b, int ch, int n, int lane) {
    const bf16_t* z = (const bf16_t*)(p.ws + WS_Z);
    const int c = n * 64 + lane;
    const float* sh = (const float*)(p.ws + WS_SUMH) + (size_t)b * NCH * 512 + c;
    const float* sp = (const float*)(p.ws + WS_SUMP) + (size_t)b * NCH * 512 + c;
    float h = 0.f;
    for (int j = 0; j < ch; ++j) h = sp[(size_t)j * 512] * h + sh[(size_t)j * 512];
    const size_t t0 = (size_t)b * SEQ + (size_t)ch * 64;
    const bf16_t* hl = (const bf16_t*)(p.ws + WS_HLOC) + t0 * 512 + c;
    const bf16_t* pc = (const bf16_t*)(p.ws + WS_PC) + t0 * 512 + c;
    const bf16_t* zg = z + t0 * ZW + C_RGG + c;
    bf16_t* y = (bf16_t*)(p.ws + WS_Y) + t0 * DM + c;
#pragma unroll 8
    for (int tt = 0; tt < 64; ++tt) {
        const float v = bf2f(hl[(size_t)tt * 512]) + bf2f(pc[(size_t)tt * 512]) * h;
        y[(size_t)tt * DM] = f2bf(v * siluf_(bf2f(zg[(size_t)tt * ZW])));
    }
}

__device__ __forceinline__ void phase_attn(const Params& p, int l, unsigned char* lds) {
    const Ids ids = fresh_ids();
    const int wid = ids.tid >> 6, lane = ids.tid & 63, gw = ids.bid * 4 + wid, nw = gridDim.x * 4;
    float* ldsw = (float*)(lds + wid * 16384);
    constexpr int N_ATT = 8 * 512, N_RG = NB * NCH * 8;
    for (int it = gw; it < N_ATT + N_RG; it += nw) {
        if (it < N_ATT) {
            const int i2 = it & 2047, bg = i2 >> 8, q = i2 & 255;
            attn_item(p, l, bg, (it < 2048) ? 511 - q : q, ldsw, lane);
        } else { const int r = it - N_ATT; rgfin_item(p, r / (NCH * 8), (r / 8) % NCH, r & 7, lane); }
    }
}

constexpr int LDS_BYTES = 4 * 17408;
static_assert(LDS_BYTES >= GEMM_LDS, "lds");

__global__ void __launch_bounds__(256, 2) k_mega(Params p) {
    extern __shared__ __attribute__((aligned(16))) unsigned char lds[];
    unsigned* bar = (unsigned*)(p.ws + WS_BAR);
    const unsigned G = gridDim.x;
    unsigned nb = 0u;
    phase_prologue(p);
    grid_barrier(bar, (++nb) * G);
#pragma unroll 1
    for (int l = 0; l < DEPTH; ++l) {
        if (l > 0) { phase_xprep(p, p.out); grid_barrier(bar, (++nb) * G); }
        phase_gemm_in(p, l, lds);
        grid_barrier(bar, (++nb) * G);
        phase_post(p, l, lds);
        grid_barrier(bar, (++nb) * G);
        phase_attn(p, l, lds);
        grid_barrier(bar, (++nb) * G);
        phase_gemm_out(p, l, lds, (l == 0) ? p.x : p.out, p.out);
        if (l + 1 < DEPTH) grid_barrier(bar, (++nb) * G);
    }
}

extern "C" void kernel_launch(void* const* d_in, const int* in_sizes, int n_in, void* d_out, int out_size, void* d_ws, size_t ws_size,
                              hipStream_t stream) {
    static int grid = 0;
    if (grid == 0) {
        if (n_in != 19 || ws_size < WS_END) { fprintf(stderr, "kernel_launch: unexpected n_in %d / ws_size %zu (need %zu)\n", n_in, ws_size, (size_t)WS_END); grid = -1; return; }
        (void)hipFuncSetAttribute((const void*)k_mega, hipFuncAttributeMaxDynamicSharedMemorySize, LDS_BYTES);
        int dev = 0, cus = 0, per_cu = 0;
        (void)hipGetDevice(&dev);
        (void)hipDeviceGetAttribute(&cus, hipDeviceAttributeMultiprocessorCount, dev);
        (void)hipOccupancyMaxActiveBlocksPerMultiprocessor(&per_cu, (const void*)k_mega, 256, LDS_BYTES);
        if (per_cu < 1) { fprintf(stderr, "kernel_launch: occupancy query says %d blocks per CU\n", per_cu); grid = -1; return; }
        if (per_cu > 2) per_cu = 2;
        grid = cus * per_cu;
    }
    if (grid < 0) return;
    Params p{};
    const float** dst = (const float**)&p;
    for (int i = 0; i < 19; ++i) dst[i] = (const float*)d_in[i];
    p.out = (float*)d_out;
    p.ws = (unsigned char*)d_ws;
    (void)hipMemsetAsync((unsigned char*)d_ws + WS_BAR, 0, 256, stream);
    hipLaunchKernelGGL(k_mega, dim3(grid), dim3(256), LDS_BYTES, stream, p);
}
```

```cpp
#include <hip/hip_runtime.h>
#include <stdint.h>
#include <stdio.h>

typedef unsigned short bf16_t;
typedef short bf16x8 __attribute__((ext_vector_type(8)));
typedef float f32x4 __attribute__((ext_vector_type(4)));
typedef unsigned u32x4 __attribute__((ext_vector_type(4)));
typedef unsigned u32x2 __attribute__((ext_vector_type(2)));

constexpr int NB = 4, SEQ = 8192, NT = NB * SEQ, DM = 1024, DEPTH = 2;
constexpr int NIN = 2840, ZW = 3072;
constexpr int NTHR = 512, NWAVE = 8;
constexpr int C_RGX = 0, C_RGG = 512, C_Q = 1024, C_KC = 1536, C_VC = 1664, C_KS = 1792, C_VS = 1920, C_KW = 2048, C_VW = 2176,
              C_NG = 2304, C_BG = 2816;
constexpr int NCH = SEQ / 64;
constexpr float EPS = 1e-6f;
constexpr float LOG2E = 1.4426950408889634f;

constexpr size_t AL(size_t x) { return (x + 255) & ~(size_t)255; }
constexpr size_t WS_WTIN = 0;
constexpr size_t WS_WTOUT = WS_WTIN + AL((size_t)DEPTH * ZW * DM * 2);
constexpr size_t WS_ROPE = WS_WTOUT + AL((size_t)DEPTH * DM * DM * 2);
constexpr size_t WS_W1T = WS_ROPE + AL((size_t)SEQ * 16 * 4);
constexpr size_t WS_B1 = WS_W1T + AL((size_t)DEPTH * 2 * 128 * 2048 * 2);
constexpr size_t WS_W2P = WS_B1 + AL((size_t)DEPTH * 2 * 16 * 128 * 4);
constexpr size_t WS_RGW = WS_W2P + AL((size_t)DEPTH * 2 * 8192 * 2);
constexpr size_t WS_SP = WS_RGW + AL((size_t)DEPTH * 2 * 8 * 4096 * 2);
constexpr size_t WS_MB = WS_SP + AL((size_t)DEPTH * 512 * 4);
constexpr size_t WS_XB = WS_MB + AL(256);
constexpr size_t WS_RSTD = WS_XB + AL((size_t)NT * DM * 2);
constexpr size_t WS_Z = WS_RSTD + AL((size_t)NT * 4);
constexpr size_t WS_QN = WS_Z + AL((size_t)NT * ZW * 2);
constexpr size_t WS_KS = WS_QN + AL((size_t)NT * 512 * 2);
constexpr size_t WS_KW = WS_KS + AL((size_t)NT * 128 * 2);
constexpr size_t WS_VST = WS_KW + AL((size_t)NT * 128 * 2);
constexpr size_t WS_VWT = WS_VST + AL((size_t)NT * 128 * 2);
constexpr size_t WS_KC = WS_VWT + AL((size_t)NT * 128 * 2);
constexpr size_t WS_VCT = WS_KC + AL((size_t)8 * 512 * 64 * 2);
constexpr size_t WS_HLOC = WS_VCT + AL((size_t)8 * 512 * 64 * 2);
constexpr size_t WS_PC = WS_HLOC + AL((size_t)NT * 512 * 2);
constexpr size_t WS_SUMH = WS_PC + AL((size_t)NT * 512 * 2);
constexpr size_t WS_SUMP = WS_SUMH + AL((size_t)NB * NCH * 512 * 4);
constexpr size_t WS_Y = WS_SUMP + AL((size_t)NB * NCH * 512 * 4);
constexpr size_t WS_BAR = WS_Y + AL((size_t)NT * DM * 2);
constexpr size_t WS_ROWP = WS_BAR + 16384;
constexpr size_t WS_KS2 = WS_ROWP + AL((size_t)NT * 16 * 4);
constexpr size_t WS_VST2 = WS_KS2 + AL((size_t)NT * 128 * 2);
constexpr size_t WS_END = WS_VST2 + AL((size_t)NT * 128 * 2);

struct Params {
    const float *x, *norm_g, *w_in, *conv_w, *conv_b, *rg_wr, *rg_br, *rg_wi, *rg_bi, *rg_lam, *q_g, *k_g, *pe_k, *w1_k, *w2_k, *pe_v,
        *w1_v, *w2_v, *w_out;
    float* out;
    unsigned char* ws;
};

typedef float f32x2v_ __attribute__((ext_vector_type(2)));
typedef __bf16 bf16x2v_ __attribute__((ext_vector_type(2)));
__device__ __forceinline__ unsigned pk2(float lo, float hi) {
    const f32x2v_ v = {lo, hi};
    return __builtin_bit_cast(unsigned, __builtin_convertvector(v, bf16x2v_));
}
__device__ __forceinline__ bf16_t f2bf(float f) { return (bf16_t)(pk2(f, 0.f) & 0xffffu); }
__device__ __forceinline__ float bf2f(unsigned h) { return __uint_as_float(h << 16); }
__device__ __forceinline__ float bflo(unsigned w) { return __uint_as_float(w << 16); }
__device__ __forceinline__ float bfhi(unsigned w) { return __uint_as_float(w & 0xffff0000u); }
__device__ __forceinline__ float sigmoidf_(float v) { return __builtin_amdgcn_rcpf(1.f + __expf(-v)); }
__device__ __forceinline__ float siluf_(float v) { return v * __builtin_amdgcn_rcpf(1.f + __expf(-v)); }
__device__ __forceinline__ bf16x8 as_bf16x8(u32x4 v) { return __builtin_bit_cast(bf16x8, v); }
__device__ __forceinline__ float shf(float v, int src) { return __builtin_bit_cast(float, __builtin_amdgcn_ds_bpermute(src << 2, __builtin_bit_cast(int, v))); }
__device__ __forceinline__ unsigned shu(unsigned v, int src) { return (unsigned)__builtin_amdgcn_ds_bpermute(src << 2, (int)v); }
#define MFMA16(a, b, c) __builtin_amdgcn_mfma_f32_16x16x32_bf16((a), (b), (c), 0, 0, 0)
#define LDS_FENCE() asm volatile("s_waitcnt lgkmcnt(0)" ::: "memory")
struct Ids { int tid, bid; };
__device__ __forceinline__ Ids fresh_ids() {
    Ids i;
    const int lane = __builtin_amdgcn_mbcnt_hi(~0u, __builtin_amdgcn_mbcnt_lo(~0u, 0u));
    int wv = __builtin_amdgcn_readfirstlane(threadIdx.x >> 6);
    i.tid = wv * 64 + lane; i.bid = blockIdx.x;
    asm volatile("" : "+v"(i.tid), "+s"(i.bid));
    return i;
}
#define XB_TMO      128
#define XB_XCNT(j)  (256  + 64 * (j))
#define XB_XSUB(j)  (1280 + 64 * (j))
#define XB_XGEN(j)  (2304 + 64 * (j))
#define XB_TOP      3328
#define XB_TOPGEN   3392
#define XCD_BAR_WORDS 3456
#define XB_SPIN_CAP (1u << 20)
__device__ __forceinline__ unsigned xb_ld(unsigned* p) { return __hip_atomic_load(p, __ATOMIC_RELAXED, __HIP_MEMORY_SCOPE_AGENT); }
__device__ __forceinline__ unsigned xb_add(unsigned* p, unsigned v) { return __hip_atomic_fetch_add(p, v, __ATOMIC_RELAXED, __HIP_MEMORY_SCOPE_AGENT); }
__device__ __forceinline__ unsigned xb_xcc_id() { return (unsigned)__builtin_amdgcn_s_getreg((3 << 11) | 20) & 0xFu; }
#define XB_SPIN(cond, bar) do { unsigned _sp = 0; while (cond) { __builtin_amdgcn_s_sleep(1); \
    if ((++_sp & 255u) == 0u) { if (xb_ld(&(bar)[XB_TMO])) break; if (_sp > XB_SPIN_CAP) { atomicAdd(&(bar)[XB_TMO], 1u); break; } } } } while (0)
__device__ __forceinline__ void xcd_barrier_complete(unsigned* bar, unsigned x, unsigned& nloc, unsigned& nx) {
    const unsigned G = gridDim.x;
    unsigned sum, cnt, mine, sp = 0u;
    for (;;) {
        sum = 0u; cnt = 0u; mine = 0u;
#pragma unroll
        for (unsigned j = 0; j < 16; ++j) { const unsigned c = xb_ld(&bar[XB_XCNT(j)]); sum += c; cnt += (c > 0u) ? 1u : 0u; mine = (j == x) ? c : mine; }
        if (sum == G) break;
        __builtin_amdgcn_s_sleep(1);
        if ((++sp & 255u) == 0u) { if (xb_ld(&bar[XB_TMO])) break; if (sp > XB_SPIN_CAP) { atomicAdd(&bar[XB_TMO], 1u); break; } }
    }
    nloc = mine > 0u ? mine : 1u; nx = cnt > 0u ? cnt : 1u;
}
__device__ __forceinline__ void grid_barrier(unsigned* bar, volatile unsigned* st) {
    asm volatile("s_waitcnt vmcnt(0)" ::: "memory");
    __syncthreads();
    const Ids ids = fresh_ids();
    if (ids.tid == 0) {
        const unsigned x = xb_xcc_id();
        __builtin_amdgcn_s_waitcnt(0);
        unsigned nloc = st[0], nx = st[1];
        if (nloc == 0u) { xcd_barrier_complete(bar, x, nloc, nx); st[0] = nloc; st[1] = nx; }
        const unsigned old = xb_add(&bar[XB_XSUB(x)], 1u);
        const unsigned gen = old / nloc;
        if (old + 1u == (gen + 1u) * nloc) {
            __builtin_amdgcn_fence(__ATOMIC_RELEASE, "agent");
            asm volatile("s_waitcnt vmcnt(0)" ::: "memory");
            const unsigned og = xb_add(&bar[XB_TOP], 1u);
            const unsigned tg = og / nx;
            if (og + 1u == (tg + 1u) * nx) xb_add(&bar[XB_TOPGEN], 1u);
            else XB_SPIN(xb_ld(&bar[XB_TOPGEN]) == tg, bar);
            __builtin_amdgcn_fence(__ATOMIC_ACQUIRE, "agent");
            xb_add(&bar[XB_XGEN(x)], 1u);
            asm volatile("s_waitcnt vmcnt(0)" ::: "memory");
        } else {
            XB_SPIN(xb_ld(&bar[XB_XGEN(x)]) == gen, bar);
            __builtin_amdgcn_fence(__ATOMIC_ACQUIRE, "agent");
            asm volatile("s_waitcnt vmcnt(0)" ::: "memory");
        }
    }
    __syncthreads();
}

template <bool FRAG = false>
__device__ __forceinline__ void transpose_tile(const float* W, int K, int N, const float* kscale, bf16_t* Wt, int k0, int n0, float* t, int lane) {
    const int n = n0 + lane;
    float wv[64];
#pragma unroll
    for (int kk = 0; kk < 64; ++kk) wv[kk] = (n < N) ? W[(size_t)(k0 + kk) * N + n] : 0.f;
    __builtin_amdgcn_sched_barrier(0);
    if (kscale) {
        const float ks = kscale[k0 + lane];
#pragma unroll
        for (int kk = 0; kk < 64; ++kk) wv[kk] *= shf(ks, kk);
    }
#pragma unroll
    for (int kk = 0; kk < 64; ++kk) t[kk * 65 + lane] = wv[kk];
    LDS_FENCE();
    const int r = lane >> 3, c8 = lane & 7;
#pragma unroll
    for (int it = 0; it < 8; ++it) {
        const int nn = it * 8 + r;
        const float* src = t + (c8 * 8) * 65 + nn;
        u32x4 o;
        o.x = pk2(src[0], src[65]); o.y = pk2(src[2 * 65], src[3 * 65]); o.z = pk2(src[4 * 65], src[5 * 65]); o.w = pk2(src[6 * 65], src[7 * 65]);
        if (FRAG) { const int n_ = n0 + nn, k_ = k0 + c8 * 8; *(u32x4*)(Wt + ((size_t)(((n_ >> 4) * (K >> 5) + (k_ >> 5)) * 4 + ((k_ >> 3) & 3)) * 16 + (n_ & 15)) * 8) = o; }
        else *(u32x4*)(Wt + (size_t)(n0 + nn) * K + k0 + c8 * 8) = o;
    }
    LDS_FENCE();
}

__device__ __forceinline__ void xrow_item(const float* xr, bf16_t* xb, float* rstd, int lane) {
    const f32x4* p = (const f32x4*)xr;
    f32x4 v[4];
    float s = 0.f;
#pragma unroll
    for (int j = 0; j < 4; ++j) { v[j] = p[j * 64 + lane]; s += v[j].x * v[j].x + v[j].y * v[j].y + v[j].z * v[j].z + v[j].w * v[j].w; }
#pragma unroll
    for (int o = 1; o < 64; o <<= 1) s += shf(s, lane ^ o);
    u32x2* q = (u32x2*)xb;
#pragma unroll
    for (int j = 0; j < 4; ++j) { u32x2 w; w.x = pk2(v[j].x, v[j].y); w.y = pk2(v[j].z, v[j].w); q[j * 64 + lane] = w; }
    if (lane == 0) *rstd = 1.0f / sqrtf(s * (1.0f / DM) + EPS);
}

__device__ __forceinline__ void phase_xprep(const Params& p, const float* xin) {
    const Ids ids = fresh_ids();
    const int lane = ids.tid & 63, gw = ids.bid * NWAVE + (ids.tid >> 6), nw = gridDim.x * NWAVE;
    bf16_t* xb = (bf16_t*)(p.ws + WS_XB);
    float* rstd = (float*)(p.ws + WS_RSTD);
    f32x4 v0[4], v1[4];
    const f32x4 zz = (f32x4){0.f, 0.f, 0.f, 0.f};
#pragma unroll
    for (int j = 0; j < 4; ++j) {
        v0[j] = (gw < NT) ? ((const f32x4*)(xin + (size_t)gw * DM))[j * 64 + lane] : zz;
        v1[j] = (gw + nw < NT) ? ((const f32x4*)(xin + (size_t)(gw + nw) * DM))[j * 64 + lane] : zz;
    }
    for (int r = gw; r < NT; r += nw) {
        f32x4 v2[4];
        const int r2 = r + 2 * nw;
#pragma unroll
        for (int j = 0; j < 4; ++j) v2[j] = (r2 < NT) ? ((const f32x4*)(xin + (size_t)r2 * DM))[j * 64 + lane] : zz;
        __builtin_amdgcn_sched_barrier(0);
        float sacc = 0.f;
#pragma unroll
        for (int j = 0; j < 4; ++j) sacc += v0[j].x * v0[j].x + v0[j].y * v0[j].y + v0[j].z * v0[j].z + v0[j].w * v0[j].w;
#pragma unroll
        for (int o = 1; o < 64; o <<= 1) sacc += shf(sacc, lane ^ o);
        u32x2* q = (u32x2*)(xb + (size_t)r * DM);
#pragma unroll
        for (int j = 0; j < 4; ++j) { u32x2 w; w.x = pk2(v0[j].x, v0[j].y); w.y = pk2(v0[j].z, v0[j].w); q[j * 64 + lane] = w; }
        if (lane == 0) rstd[r] = 1.0f / sqrtf(sacc * (1.0f / DM) + EPS);
        __builtin_amdgcn_sched_barrier(0);
#pragma unroll
        for (int j = 0; j < 4; ++j) { v0[j] = v1[j]; v1[j] = v2[j]; }
    }
}

__device__ __forceinline__ void phase_prologue(const Params& p, unsigned char* lds) {
    const Ids ids = fresh_ids();
    const int gtid = ids.bid * NTHR + ids.tid, gth = gridDim.x * NTHR;
    const int wid = ids.tid >> 6, lane = ids.tid & 63, gw = ids.bid * NWAVE + wid, nw = gridDim.x * NWAVE;
    {
        float* t = (float*)(lds + wid * 17408);
        constexpr int T_IN = 16 * 48, T_OUT = 16 * 16, T_W1 = 32 * 2, T_L = T_IN + T_OUT + 2 * T_W1, N_B1 = DEPTH * 2 * 2 * 16;
        for (int it = gw; it < DEPTH * T_L + N_B1; it += nw) {
            if (it < DEPTH * T_L) {
                const int l = it / T_L; int r = it % T_L;
                if (r < T_IN) { transpose_tile(p.w_in + (size_t)l * DM * NIN, DM, NIN, p.norm_g + l * DM, (bf16_t*)(p.ws + WS_WTIN) + (size_t)l * ZW * DM, (r / 48) * 64, (r % 48) * 64, t, lane); continue; }
                r -= T_IN;
                if (r < T_OUT) { transpose_tile(p.w_out + (size_t)l * DM * DM, DM, DM, nullptr, (bf16_t*)(p.ws + WS_WTOUT) + (size_t)l * DM * DM, (r / 16) * 64, (r % 16) * 64, t, lane); continue; }
                r -= T_OUT;
                const int kv = r / T_W1; r %= T_W1;
                transpose_tile<true>((kv ? p.w1_v : p.w1_k) + (size_t)l * 2048 * 128, 2048, 128, nullptr, (bf16_t*)(p.ws + WS_W1T) + (size_t)(l * 2 + kv) * 128 * 2048, (r / 2) * 64, (r % 2) * 64, t, lane);
            } else {
                const int r = it - DEPTH * T_L, ks = r & 15, hg = (r >> 4) & 1, kv = (r >> 5) & 1, l = r >> 6, hu = hg * 64 + lane;
                const float* pe = (kv ? p.pe_v : p.pe_k) + (size_t)l * 2048 + ks * 128;
                const float* w1 = (kv ? p.w1_v : p.w1_k) + (size_t)l * 2048 * 128 + (size_t)ks * 128 * 128 + hu;
                float sacc = 0.f;
#pragma unroll 32
                for (int k = 0; k < 128; ++k) sacc += pe[k] * w1[(size_t)k * 128];
                ((float*)(p.ws + WS_B1))[((l * 2 + kv) * 16 + ks) * 128 + hu] = sacc;
            }
        }
    }
    float* rope = (float*)(p.ws + WS_ROPE);
    for (int it = gtid; it < SEQ * 8; it += gth) {
        const int pos = it >> 3, i = it & 7;
        const float inv = powf(500000.0f, -(float)i / 8.0f);
        const float ang = (float)pos * inv;
        float sn, cs;
        sincosf(ang, &sn, &cs);
        rope[pos * 16 + i] = cs;
        rope[pos * 16 + 8 + i] = sn;
    }
    bf16_t* w2p = (bf16_t*)(p.ws + WS_W2P);
    for (int it = gtid; it < DEPTH * 2 * 8192; it += gth) {
        const int jj = it & 7, quad = (it >> 3) & 3, r = (it >> 5) & 15, dt = (it >> 9) & 3, s = (it >> 11) & 3, kv = (it >> 13) & 1, l = it >> 14;
        const int hu = 16 * (2 * s + (jj >> 2)) + 4 * quad + (jj & 3), d = 16 * dt + r;
        const float* w2 = (kv ? p.w2_v : p.w2_k) + (size_t)l * 128 * 64;
        w2p[it] = f2bf(w2[hu * 64 + d]);
    }
    bf16_t* rgw = (bf16_t*)(p.ws + WS_RGW);
    for (int it = gtid; it < DEPTH * 2 * 8 * 4096; it += gth) {
        const int in = it & 63, out = (it >> 6) & 63, n = (it >> 12) & 7, gate = (it >> 15) & 1, l = it >> 16;
        const float* w = (gate ? p.rg_wi : p.rg_wr) + (size_t)l * 8 * 4096 + n * 4096;
        rgw[it] = f2bf(w[in * 64 + out]);
    }
    float* sp = (float*)(p.ws + WS_SP);
    for (int it = gtid; it < DEPTH * 512; it += gth) {
        const float v = -p.rg_lam[it];
        sp[it] = (v > 20.f) ? v : log1pf(expf(v));
    }
    if (gw < DEPTH * 4) {
        const int l = gw >> 2, br = gw & 3;
        float mq = fabsf(p.q_g[l * 64 + lane]), mk = (br < 3) ? fabsf(p.k_g[(l * 3 + br) * 64 + lane]) : 0.f;
#pragma unroll
        for (int o = 1; o < 64; o <<= 1) { mq = fmaxf(mq, shf(mq, lane ^ o)); mk = fmaxf(mk, shf(mk, lane ^ o)); }
        if (lane == 0) ((float*)(p.ws + WS_MB))[gw] = 8.0f * mq * mk * LOG2E * 1.0001f;
    }
    phase_xprep(p, p.x);
}

namespace pg8 {
#define PG8_LAS __attribute__((address_space(3)))
constexpr int BM = 256, BK = 64, HALF = 128, HTB = HALF * BK * 2, STAGE_BYTES = 8 * HTB, NXCD = 8, WGM = 8;
__host__ __device__ __forceinline__ int lds_byte(int r, int c) { const int st = (r >> 4) * 2 + (c >> 5), rr = r & 15, cc = c & 31, ob = rr * 64 + cc * 2; return st * 1024 + (ob ^ (((ob >> 9) & 1) << 5)); }
__host__ __device__ __forceinline__ void stage_rc(int b, int& R, int& C) { const int st = b / 1024, sb = b % 1024, swz = sb ^ (((sb >> 9) & 1) << 5); R = (st >> 1) * 16 + swz / 64; C = (st & 1) * 32 + (swz % 64) / 2; }
__host__ __device__ __forceinline__ int perm32(int rho) { const int n = rho >> 4, i = rho & 15; return 8 * (i >> 2) + 4 * n + (i & 3); }
struct Unit { int pm, pn; };
struct Gemm { const bf16_t* A; const bf16_t* Bt; int M, N, K; };
struct StaticOrder {
    int nM, nN, nwg, G, c;
    __host__ __device__ void init(int M, int N, int G_, int c_) { nM = M / BM; nN = N / BM; nwg = nM * nN; G = G_; c = c_; }
    __host__ __device__ bool next(int i, Unit& u) const {
        const long L = (long)i * G + c; if (L >= nwg) return false;
        int wgid = (int)L; { const int q = nwg / NXCD, r = nwg % NXCD, xcd = wgid % NXCD, off = wgid / NXCD; wgid = (xcd < r ? xcd * (q + 1) : r * (q + 1) + (xcd - r) * q) + off; }
        const int nig = WGM * nN, gid = wgid / nig, fm = gid * WGM, gsz = (nM - fm) < WGM ? (nM - fm) : WGM;
        u.pm = fm + ((wgid % nig) % gsz); u.pn = (wgid % nig) / gsz; return true;
    }
    __device__ __forceinline__ void a_ready(const Unit&) const {}
    __device__ __forceinline__ void done(const Unit&) const {}
};
struct EpiZ {
    static constexpr bool PERM = true, AFTER_DRAIN = false;
    bf16_t* O; int ldc; const float* rstd;
    __device__ __forceinline__ void operator()(const f32x4 (&acc)[2][2][4][2], const Unit& u, int wr, int wc, int fr, int fq) const {
        const int row0 = u.pm * BM + wr * 64 + fr, col0 = u.pn * BM + wc * 32 + 8 * fq;
#pragma unroll
        for (int ai = 0; ai < 2; ++ai)
#pragma unroll
            for (int m = 0; m < 4; ++m) {
                const int row = row0 + ai * HALF + m * 16;
                const float rs = rstd[row];
                bf16_t* rowp = O + (size_t)row * ldc + col0;
#pragma unroll
                for (int bj = 0; bj < 2; ++bj) {
                    const f32x4 v0 = acc[ai][bj][m][0] * rs, v1 = acc[ai][bj][m][1] * rs;
                    u32x4 w; w.x = pk2(v0[0], v0[1]); w.y = pk2(v0[2], v0[3]); w.z = pk2(v1[0], v1[1]); w.w = pk2(v1[2], v1[3]);
                    *(u32x4*)(rowp + bj * HALF) = w;
                }
            }
    }
};
template <bool NEXT, bool XBF> struct EpiRes {
    static constexpr bool PERM = false, AFTER_DRAIN = false;
    const float* X; float* C; int ldc; bf16_t* XB; float* rowp;
    __device__ __forceinline__ void operator()(const f32x4 (&acc)[2][2][4][2], const Unit& u, int wr, int wc, int fr, int fq) const {
        const int row0 = u.pm * BM + wr * 64 + fr, col0 = u.pn * BM + wc * 32 + 4 * fq, lane = fq * 16 + fr;
#pragma unroll
        for (int ai = 0; ai < 2; ++ai)
#pragma unroll
            for (int m = 0; m < 4; ++m) {
                const int row = row0 + ai * HALF + m * 16;
                const size_t off = (size_t)row * ldc + col0;
                float ss = 0.f;
#pragma unroll
                for (int bj = 0; bj < 2; ++bj)
#pragma unroll
                    for (int n = 0; n < 2; ++n) {
                        f32x4 xv;
                        if (XBF) { const u32x2 xw = *(const u32x2*)(XB + off + bj * HALF + n * 16); xv = (f32x4){bflo(xw.x), bfhi(xw.x), bflo(xw.y), bfhi(xw.y)}; }
                        else xv = *(const f32x4*)(X + off + bj * HALF + n * 16);
                        const f32x4 v = xv + acc[ai][bj][m][n];
                        if (NEXT) {
                            ss += (v.x * v.x + v.y * v.y) + (v.z * v.z + v.w * v.w);
                            u32x2 w; w.x = pk2(v.x, v.y); w.y = pk2(v.z, v.w);
                            *(u32x2*)(XB + off + bj * HALF + n * 16) = w;
                        } else {
                            *(f32x4*)(C + off + bj * HALF + n * 16) = v;
                        }
                    }
                if (NEXT) {
                    ss += shf(ss, lane ^ 16); ss += shf(ss, lane ^ 32);
                    if (fq == 0) rowp[(size_t)row * 16 + u.pn * 4 + wc] = ss;
                }
            }
    }
};
template <class Epi, class Sched, bool ALIGN_EPI = false, bool SP2 = false>
__device__ __forceinline__ void gemm_phase(PG8_LAS unsigned char* lds, const Gemm g, const Sched& S, const Epi& E, const int tid) {
    const int wid = __builtin_amdgcn_readfirstlane(tid >> 6), lane = tid & 63, wr = wid >> 2, wc = wid & 3, fr = lane & 15, fq = lane >> 4;
    const int K = g.K, nt = K / BK;
    unsigned voffA[2], voffB[2];
#pragma unroll
    for (int i = 0; i < 2; ++i) { int R, C; stage_rc(tid * 16 + i * 8192, R, C); const int Rb = Epi::PERM ? ((R & ~31) + perm32(R & 31)) : R;
        voffA[i] = (unsigned)(R * K + C) * 2u; voffB[i] = (unsigned)(Rb * K + C) * 2u; }
    const size_t kstep = (size_t)(BK * 2);
    const size_t hstep = (size_t)HALF * K * 2;
    const size_t tstep = 2 * hstep;
    const unsigned ldsw = (unsigned)wid * 1024u;
    const int aoff = lds_byte(wr * 64 + fr, fq * 8), boff = lds_byte(wc * 32 + fr, fq * 8);
#define PG8_SA(b, h) (((b) * 2 + (h)) * HTB)
#define PG8_SB(b, h) ((4 + (b) * 2 + (h)) * HTB)
#define PG8_STAGE(bufoff, gbase, voff) do { _Pragma("unroll") for (int _i = 0; _i < 2; ++_i) \
        __builtin_amdgcn_global_load_lds((const unsigned*)((const char*)(gbase) + (voff)[_i]), (PG8_LAS unsigned*)(lds + (bufoff) + ldsw + _i * 8192), 16, 0, 0); } while (0)
#define PG8_LDA(dst, b, h) do { _Pragma("unroll") for (int m = 0; m < 4; ++m) _Pragma("unroll") for (int k = 0; k < 2; ++k) dst[m][k] = *(const PG8_LAS bf16x8*)(lds + PG8_SA(b, h) + aoff + m * 2048 + k * 1024); } while (0)
#define PG8_LDB(dst, b, h) do { _Pragma("unroll") for (int n = 0; n < 2; ++n) _Pragma("unroll") for (int k = 0; k < 2; ++k) dst[n][k] = *(const PG8_LAS bf16x8*)(lds + PG8_SB(b, h) + boff + n * 2048 + k * 1024); } while (0)
#define PG8_MMA(ai, bj, At, Bt) do { __builtin_amdgcn_s_setprio(1); _Pragma("unroll") for (int m = 0; m < 4; ++m) _Pragma("unroll") for (int n = 0; n < 2; ++n) _Pragma("unroll") for (int k = 0; k < 2; ++k) \
        acc[ai][bj][m][n] = __builtin_amdgcn_mfma_f32_16x16x32_bf16(Bt[n][k], At[m][k], acc[ai][bj][m][n], 0, 0, 0); __builtin_amdgcn_s_setprio(0); } while (0)
#define PG8_WAIT_V(n) asm volatile("s_waitcnt vmcnt(" #n ")" ::: "memory")
#define PG8_WAIT_L(n) asm volatile("s_waitcnt lgkmcnt(" #n ")" ::: "memory")
#define PG8_BAR __builtin_amdgcn_s_barrier()
#define PG8_SCHED __builtin_amdgcn_sched_barrier(0)
    Unit cur, nxt; int ui = 0;
    if (!S.next(0, cur)) return;
    f32x4 acc[2][2][4][2];
#pragma unroll
    for (int a = 0; a < 2; ++a)
#pragma unroll
        for (int b = 0; b < 2; ++b)
#pragma unroll
            for (int m = 0; m < 4; ++m)
#pragma unroll
                for (int n = 0; n < 2; ++n) acc[a][b][m][n] = (f32x4){0.f, 0.f, 0.f, 0.f};
    bf16x8 At[4][2], B0[2][2], B1[2][2];
    const char* cA = (const char*)g.A + (size_t)cur.pm * tstep; const char* cB = (const char*)g.Bt + (size_t)cur.pn * tstep;
    S.a_ready(cur);
    if constexpr (SP2) {
        PG8_STAGE(PG8_SB(0, 0), cB, voffB); PG8_STAGE(PG8_SB(0, 1), cB + hstep, voffB); PG8_STAGE(PG8_SA(0, 0), cA, voffA); PG8_STAGE(PG8_SA(0, 1), cA + hstep, voffA);
        if (wr == 1) PG8_BAR;
        PG8_WAIT_V(2); PG8_BAR;
        PG8_STAGE(PG8_SB(1, 0), cB + kstep, voffB); PG8_STAGE(PG8_SA(1, 0), cA + kstep, voffA); PG8_STAGE(PG8_SB(1, 1), cB + hstep + kstep, voffB);
        PG8_WAIT_V(6); PG8_BAR;
    } else {
        PG8_STAGE(PG8_SB(0, 0), cB, voffB); PG8_STAGE(PG8_SA(0, 0), cA, voffA); PG8_STAGE(PG8_SB(0, 1), cB + hstep, voffB); PG8_STAGE(PG8_SA(0, 1), cA + hstep, voffA);
        if (wr == 1) PG8_BAR;
        PG8_WAIT_V(4); PG8_BAR;
        PG8_STAGE(PG8_SB(1, 0), cB + kstep, voffB); PG8_STAGE(PG8_SA(1, 0), cA + kstep, voffA); PG8_STAGE(PG8_SB(1, 1), cB + hstep + kstep, voffB);
        PG8_WAIT_V(6); PG8_BAR;
    }
    for (;;) {
        const bool has_next = S.next(ui + 1, nxt);
        const char* nA = has_next ? (const char*)g.A + (size_t)nxt.pm * tstep : cA; const char* nB = has_next ? (const char*)g.Bt + (size_t)nxt.pn * tstep : cB;
        for (int t = 0; t < nt; t += 2) {
            const bool last = (t == nt - 2);
            const char* a1 = cA + (size_t)(t + 1) * kstep;
            const char* a2 = last ? nA : cA + (size_t)(t + 2) * kstep; const char* b2 = last ? nB : cB + (size_t)(t + 2) * kstep;
            const char* a3 = a2 + kstep; const char* b3 = b2 + kstep;
            if (last && has_next) S.a_ready(nxt);
            if constexpr (SP2) {
            PG8_LDB(B0, 0, 0); PG8_LDB(B1, 0, 1); PG8_SCHED; PG8_LDA(At, 0, 0); PG8_STAGE(PG8_SA(1, 1), a1 + hstep, voffA);
            PG8_WAIT_V(8); PG8_WAIT_L(0); PG8_BAR; PG8_MMA(0, 0, At, B0); PG8_MMA(0, 1, At, B1); PG8_BAR; PG8_SCHED;
            PG8_LDA(At, 0, 1); PG8_STAGE(PG8_SB(0, 0), b2, voffB); PG8_STAGE(PG8_SB(0, 1), b2 + hstep, voffB); PG8_STAGE(PG8_SA(0, 0), a2, voffA);
            PG8_WAIT_V(8); PG8_WAIT_L(0); PG8_BAR; PG8_MMA(1, 0, At, B0); PG8_MMA(1, 1, At, B1); PG8_BAR; PG8_SCHED;
            PG8_LDB(B0, 1, 0); PG8_LDB(B1, 1, 1); PG8_SCHED; PG8_LDA(At, 1, 0); PG8_STAGE(PG8_SA(0, 1), a2 + hstep, voffA);
            PG8_WAIT_V(8); PG8_WAIT_L(0); PG8_BAR; PG8_MMA(0, 0, At, B0); PG8_MMA(0, 1, At, B1); PG8_BAR; PG8_SCHED;
            PG8_LDA(At, 1, 1); PG8_STAGE(PG8_SB(1, 0), b3, voffB); PG8_STAGE(PG8_SB(1, 1), b3 + hstep, voffB); PG8_STAGE(PG8_SA(1, 0), a3, voffA);
            PG8_WAIT_V(8); PG8_WAIT_L(0); PG8_BAR; PG8_MMA(1, 0, At, B0); PG8_MMA(1, 1, At, B1); PG8_BAR; PG8_SCHED;
            } else {
            PG8_LDB(B0, 0, 0); PG8_SCHED; PG8_LDA(At, 0, 0); PG8_STAGE(PG8_SA(1, 1), a1 + hstep, voffA);
            PG8_WAIT_L(8); PG8_BAR; PG8_WAIT_L(0); PG8_MMA(0, 0, At, B0); PG8_BAR; PG8_SCHED;
            PG8_LDB(B1, 0, 1); PG8_STAGE(PG8_SB(0, 0), b2, voffB);
            PG8_BAR; PG8_WAIT_L(0); PG8_MMA(0, 1, At, B1); PG8_BAR;
            PG8_LDA(At, 0, 1); PG8_STAGE(PG8_SA(0, 0), a2, voffA);
            PG8_BAR; PG8_WAIT_L(0); PG8_MMA(1, 0, At, B0); PG8_BAR; PG8_SCHED;
            PG8_STAGE(PG8_SB(0, 1), b2 + hstep, voffB);
            PG8_WAIT_V(6); PG8_BAR; PG8_MMA(1, 1, At, B1); PG8_BAR;
            PG8_LDB(B0, 1, 0); PG8_SCHED; PG8_LDA(At, 1, 0); PG8_STAGE(PG8_SA(0, 1), a2 + hstep, voffA);
            PG8_WAIT_L(8); PG8_BAR; PG8_WAIT_L(0); PG8_MMA(0, 0, At, B0); PG8_BAR; PG8_SCHED;
            PG8_LDB(B1, 1, 1); PG8_STAGE(PG8_SB(1, 0), b3, voffB);
            PG8_BAR; PG8_WAIT_L(0); PG8_MMA(0, 1, At, B1); PG8_BAR;
            PG8_LDA(At, 1, 1); PG8_STAGE(PG8_SA(1, 0), a3, voffA);
            PG8_BAR; PG8_WAIT_L(0); PG8_MMA(1, 0, At, B0); PG8_BAR; PG8_SCHED;
            PG8_STAGE(PG8_SB(1, 1), b3 + hstep, voffB);
            PG8_WAIT_V(6); PG8_BAR; PG8_MMA(1, 1, At, B1); PG8_BAR;
            }
        }
        if constexpr (ALIGN_EPI) { if (wr == 0) PG8_BAR; }
        if constexpr (!Epi::AFTER_DRAIN) { E(acc, cur, wr, wc, fr, fq); S.done(cur); }
        if (!has_next) break;
#pragma unroll
        for (int a = 0; a < 2; ++a)
#pragma unroll
            for (int b = 0; b < 2; ++b)
#pragma unroll
                for (int m = 0; m < 4; ++m)
#pragma unroll
                    for (int n = 0; n < 2; ++n) acc[a][b][m][n] = (f32x4){0.f, 0.f, 0.f, 0.f};
        cur = nxt; cA = nA; cB = nB; ++ui;
        if constexpr (ALIGN_EPI) { if (wr == 1) PG8_BAR; }
    }
    PG8_WAIT_V(0);
    if constexpr (!ALIGN_EPI) { if (wr == 0) PG8_BAR; }
    PG8_BAR;
    if constexpr (Epi::AFTER_DRAIN) { E.fused(acc, cur, wr, wc, fr, fq, lds, wid, lane); S.done(cur); }
#undef PG8_SA
#undef PG8_SB
#undef PG8_STAGE
#undef PG8_LDA
#undef PG8_LDB
#undef PG8_MMA
#undef PG8_WAIT_V
#undef PG8_WAIT_L
#undef PG8_BAR
#undef PG8_SCHED
}
}

__device__ __forceinline__ void phase_gemm_in(const Params& p, int l, unsigned char* lds) {
    const Ids ids = fresh_ids();
    pg8::Gemm g{(const bf16_t*)(p.ws + WS_XB), (const bf16_t*)(p.ws + WS_WTIN) + (size_t)l * ZW * DM, NT, ZW, DM};
    pg8::StaticOrder S; S.init(NT, ZW, gridDim.x, ids.bid);
    if (l > 0) {
        pg8::Unit u;
        bool have = S.next(0, u);
        const f32x4 zz = (f32x4){0.f, 0.f, 0.f, 0.f};
        f32x4 a0 = zz, a1 = zz, a2 = zz, a3 = zz;
        int row = 0;
        if (have && ids.tid < 256) {
            row = u.pm * 256 + ids.tid;
            const f32x4* pp = (const f32x4*)((const float*)(p.ws + WS_ROWP) + (size_t)row * 16);
            a0 = pp[0]; a1 = pp[1]; a2 = pp[2]; a3 = pp[3];
        }
        for (int i = 1; have; ++i) {
            pg8::Unit un;
            const bool hn = S.next(i, un);
            f32x4 n0 = zz, n1 = zz, n2 = zz, n3 = zz;
            int rown = 0;
            if (hn && ids.tid < 256) {
                rown = un.pm * 256 + ids.tid;
                const f32x4* pp = (const f32x4*)((const float*)(p.ws + WS_ROWP) + (size_t)rown * 16);
                n0 = pp[0]; n1 = pp[1]; n2 = pp[2]; n3 = pp[3];
            }
            __builtin_amdgcn_sched_barrier(0);
            if (ids.tid < 256) {
                const float ssum = (((a0.x + a0.y) + (a0.z + a0.w)) + ((a1.x + a1.y) + (a1.z + a1.w))) + (((a2.x + a2.y) + (a2.z + a2.w)) + ((a3.x + a3.y) + (a3.z + a3.w)));
                ((float*)(p.ws + WS_RSTD))[row] = 1.0f / sqrtf(ssum * (1.0f / DM) + EPS);
            }
            a0 = n0; a1 = n1; a2 = n2; a3 = n3; row = rown; have = hn;
        }
        asm volatile("s_waitcnt vmcnt(0)" ::: "memory");
        __syncthreads();
    }
    pg8::EpiZ E{(bf16_t*)(p.ws + WS_Z), ZW, (const float*)(p.ws + WS_RSTD)};
    pg8::gemm_phase<pg8::EpiZ, pg8::StaticOrder, true, true>((PG8_LAS unsigned char*)lds, g, S, E, ids.tid);
}
__device__ __forceinline__ void phase_gemm_out(const Params& p, int l, unsigned char* lds, const float* xin, float* xout) {
    const Ids ids = fresh_ids();
    pg8::Gemm g{(const bf16_t*)(p.ws + WS_Y), (const bf16_t*)(p.ws + WS_WTOUT) + (size_t)l * DM * DM, NT, DM, DM};
    pg8::StaticOrder S; S.init(NT, DM, gridDim.x, ids.bid);
    bf16_t* xb = (bf16_t*)(p.ws + WS_XB); float* rowp = (float*)(p.ws + WS_ROWP);
    if (l + 1 < DEPTH) {
        if (l == 0) { pg8::EpiRes<true, false> E{xin, xout, DM, xb, rowp}; pg8::gemm_phase<pg8::EpiRes<true, false>, pg8::StaticOrder, true, true>((PG8_LAS unsigned char*)lds, g, S, E, ids.tid); }
        else        { pg8::EpiRes<true, true>  E{xin, xout, DM, xb, rowp}; pg8::gemm_phase<pg8::EpiRes<true, true>,  pg8::StaticOrder, true, true>((PG8_LAS unsigned char*)lds, g, S, E, ids.tid); }
    } else {
        if (l == 0) { pg8::EpiRes<false, false> E{xin, xout, DM, xb, rowp}; pg8::gemm_phase<pg8::EpiRes<false, false>, pg8::StaticOrder, true, true>((PG8_LAS unsigned char*)lds, g, S, E, ids.tid); }
        else        { pg8::EpiRes<false, true>  E{xin, xout, DM, xb, rowp}; pg8::gemm_phase<pg8::EpiRes<false, true>,  pg8::StaticOrder, true, true>((PG8_LAS unsigned char*)lds, g, S, E, ids.tid); }
    }
}

__device__ __forceinline__ void qkv_item(const Params& p, int l, int tt, int slot, unsigned char* wlds  , int lane) {
    const bf16_t* z = (const bf16_t*)(p.ws + WS_Z);
    const int t = tt * 64 + lane, b = t / SEQ, s = t % SEQ;
    int col; const float* gp = nullptr;
    if (slot < 8) { col = C_Q + slot * 64; gp = p.q_g + l * 64; }
    else if (slot < 10) { col = C_KS + (slot - 8) * 64; gp = p.k_g + (l * 3 + 1) * 64; }
    else if (slot < 12) { col = C_KW + (slot - 10) * 64; gp = p.k_g + (l * 3 + 2) * 64; }
    else if (slot < 14) { col = C_VS + (slot - 12) * 64; }
    else { col = C_VW + (slot - 14) * 64; }
    const u32x4* zr = (const u32x4*)(z + (size_t)t * ZW + col);
    u32x4 raw[8];
#pragma unroll
    for (int i = 0; i < 8; ++i) raw[i] = zr[i];
    if (slot < 12) {
        float* gl = (float*)(wlds + 9216);
        const float gmine = gp[lane];
        const f32x4* rp = (const f32x4*)((const float*)(p.ws + WS_ROPE) + s * 16);
        const f32x4 c0 = rp[0], c1 = rp[1], s0 = rp[2], s1 = rp[3];
        gl[lane] = gmine;
        LDS_FENCE();
        float ss = 0.f;
#pragma unroll
        for (int i = 0; i < 8; ++i) {
            const unsigned w[4] = {raw[i].x, raw[i].y, raw[i].z, raw[i].w};
#pragma unroll
            for (int k = 0; k < 4; ++k) { const float lo = bflo(w[k]), hi = bfhi(w[k]); ss += lo * lo + hi * hi; }
        }
        const float rinv = (1.0f / sqrtf(ss * (1.0f / 64.0f) + EPS)) * ((slot < 8) ? 0.125f * LOG2E : 1.0f);
        bf16_t* dst;
        if (slot < 8) dst = (bf16_t*)(p.ws + WS_QN) + (size_t)t * 512 + slot * 64;
        else if (slot < 10) dst = (bf16_t*)(p.ws + WS_KS) + ((size_t)(b * 2 + (slot - 8)) * SEQ + s) * 64;
        else dst = (bf16_t*)(p.ws + WS_KW) + ((size_t)(b * 2 + (slot - 10)) * SEQ + s) * 64;
        const bool tiled = (slot == 8 || slot == 9);
        const int kk = s & 63, st = kk >> 5, r = kk & 31, cidx = ((r >> 3) << 2) | (r & 3), T = (r >> 2) & 1;
        bf16_t* tb = (bf16_t*)(p.ws + WS_KS2) + ((size_t)(b * 2 + (slot - 8)) * (SEQ / 64) + (s >> 6)) * 4096;
        auto chunk = [&](int i, float (&v)[8]) {
            const unsigned w[4] = {raw[i].x, raw[i].y, raw[i].z, raw[i].w};
            const f32x4 g0 = *(const f32x4*)(gl + 8 * i), g1 = *(const f32x4*)(gl + 8 * i + 4);
            v[0] = bflo(w[0]) * rinv * g0.x; v[1] = bfhi(w[0]) * rinv * g0.y; v[2] = bflo(w[1]) * rinv * g0.z; v[3] = bfhi(w[1]) * rinv * g0.w;
            v[4] = bflo(w[2]) * rinv * g1.x; v[5] = bfhi(w[2]) * rinv * g1.y; v[6] = bflo(w[3]) * rinv * g1.z; v[7] = bfhi(w[3]) * rinv * g1.w;
        };
        auto emit = [&](int i, const float (&v)[8]) {
            u32x4 o; o.x = pk2(v[0], v[1]); o.y = pk2(v[2], v[3]); o.z = pk2(v[4], v[5]); o.w = pk2(v[6], v[7]);
            ((u32x4*)dst)[i] = o;
            if (tiled) *(u32x4*)(tb + ((((st * 2 + T) * 2 + (i >> 2)) * 64 + (i & 3) * 16 + cidx) * 8)) = o;
        };
        {
            float v0[8], v1[8];
            chunk(0, v0); chunk(1, v1);
            const float cs[8] = {c0.x, c0.y, c0.z, c0.w, c1.x, c1.y, c1.z, c1.w};
            const float sn[8] = {s0.x, s0.y, s0.z, s0.w, s1.x, s1.y, s1.z, s1.w};
#pragma unroll
            for (int i = 0; i < 8; ++i) { const float x1 = v0[i], x2 = v1[i]; v0[i] = x1 * cs[i] - x2 * sn[i]; v1[i] = x2 * cs[i] + x1 * sn[i]; }
            emit(0, v0); emit(1, v1);
        }
#pragma unroll
        for (int i = 2; i < 8; ++i) { float v[8]; chunk(i, v); emit(i, v); }
    } else {
#pragma unroll
        for (int i = 0; i < 8; ++i) *(u32x4*)(wlds + lane * 144 + i * 16) = raw[i];
        LDS_FENCE();
        bf16_t* dstb = (slot < 14) ? (bf16_t*)(p.ws + WS_VST) + ((size_t)(b * 2 + (slot - 12)) * 64) * SEQ
                                   : (bf16_t*)(p.ws + WS_VWT) + ((size_t)(b * 2 + (slot - 14)) * 64) * SEQ;
        const int dr = lane >> 3, c8 = lane & 7, sbase = (tt * 64) % SEQ;
#pragma unroll
        for (int pd = 0; pd < 8; ++pd) {
            const int d = 8 * pd + dr;
            unsigned e[8];
#pragma unroll
            for (int k = 0; k < 8; ++k) e[k] = *(const unsigned short*)(wlds + (8 * c8 + k) * 144 + d * 2);
            u32x4 o; o.x = e[0] | (e[1] << 16); o.y = e[2] | (e[3] << 16); o.z = e[4] | (e[5] << 16); o.w = e[6] | (e[7] << 16);
            *(u32x4*)(dstb + (size_t)d * SEQ + sbase + 8 * c8) = o;
            if (slot < 14) *(u32x4*)((bf16_t*)(p.ws + WS_VST2) + ((size_t)(b * 2 + (slot - 12)) * (SEQ / 64) + (sbase >> 6)) * 4096 + (((c8 >> 2) * 4 + (d >> 4)) * 64 + (c8 & 3) * 16 + (d & 15)) * 8) = o;
        }
        LDS_FENCE();
    }
}

__device__ __forceinline__ void rg_item(const Params& p, int l, int b, int ch, int n, float* xcf, int lane) {
    const bf16_t* z = (const bf16_t*)(p.ws + WS_Z);
    const int fr = lane & 15, quad = lane >> 4;
    const size_t t0 = (size_t)b * SEQ + (size_t)ch * 64;
    {
        const int r = lane >> 3, c8 = lane & 7, cc = n * 64 + c8 * 8;
        float w[4][8], cb[8];
#pragma unroll
        for (int k = 0; k < 4; ++k) {
            const f32x4 a0 = *(const f32x4*)(p.conv_w + (l * 4 + k) * 512 + cc), a1 = *(const f32x4*)(p.conv_w + (l * 4 + k) * 512 + cc + 4);
            w[k][0] = a0.x; w[k][1] = a0.y; w[k][2] = a0.z; w[k][3] = a0.w; w[k][4] = a1.x; w[k][5] = a1.y; w[k][6] = a1.z; w[k][7] = a1.w;
        }
        { const f32x4 a0 = *(const f32x4*)(p.conv_b + l * 512 + cc), a1 = *(const f32x4*)(p.conv_b + l * 512 + cc + 4);
          cb[0] = a0.x; cb[1] = a0.y; cb[2] = a0.z; cb[3] = a0.w; cb[4] = a1.x; cb[5] = a1.y; cb[6] = a1.z; cb[7] = a1.w; }
        const bf16_t* zc = z + t0 * ZW + C_RGX + cc;
        u32x4 xr[11];
#pragma unroll
        for (int k = 0; k < 11; ++k) {
            const int ts = r * 8 - 3 + k;
            const bool ok = (ts >= 0) || (ch > 0);
            xr[k] = ok ? *(const u32x4*)(zc + (ptrdiff_t)ts * ZW) : (u32x4){0u, 0u, 0u, 0u};
        }
        float xf[4][8];
#pragma unroll
        for (int k = 0; k < 3; ++k) {
            const unsigned ww[4] = {xr[k].x, xr[k].y, xr[k].z, xr[k].w};
#pragma unroll
            for (int q = 0; q < 4; ++q) { xf[k][2 * q] = bflo(ww[q]); xf[k][2 * q + 1] = bfhi(ww[q]); }
        }
#pragma unroll
        for (int i = 0; i < 8; ++i) {
            { const unsigned ww[4] = {xr[i + 3].x, xr[i + 3].y, xr[i + 3].z, xr[i + 3].w};
#pragma unroll
              for (int q = 0; q < 4; ++q) { xf[(i + 3) & 3][2 * q] = bflo(ww[q]); xf[(i + 3) & 3][2 * q + 1] = bfhi(ww[q]); } }
            float o[8];
#pragma unroll
            for (int e = 0; e < 8; ++e) o[e] = cb[e];
#pragma unroll
            for (int k = 0; k < 4; ++k)
#pragma unroll
                for (int e = 0; e < 8; ++e) o[e] += w[k][e] * xf[(i + k) & 3][e];
            f32x4* dst = (f32x4*)(xcf + (r * 8 + i) * 68 + c8 * 8);
            dst[0] = (f32x4){o[0], o[1], o[2], o[3]}; dst[1] = (f32x4){o[4], o[5], o[6], o[7]};
        }
    }
    LDS_FENCE();
    bf16x8 af[4][2];
#pragma unroll
    for (int m = 0; m < 4; ++m)
#pragma unroll
        for (int ks = 0; ks < 2; ++ks) {
            const f32x4* src = (const f32x4*)(xcf + (16 * m + fr) * 68 + 32 * ks + 8 * quad);
            const f32x4 a = src[0], c = src[1];
            u32x4 w; w.x = pk2(a.x, a.y); w.y = pk2(a.z, a.w); w.z = pk2(c.x, c.y); w.w = pk2(c.z, c.w);
            af[m][ks] = as_bf16x8(w);
        }
    const bf16_t* wr_ = (const bf16_t*)(p.ws + WS_RGW) + ((size_t)(l * 2 + 0) * 8 + n) * 4096;
    const bf16_t* wi_ = (const bf16_t*)(p.ws + WS_RGW) + ((size_t)(l * 2 + 1) * 8 + n) * 4096;
    bf16x8 brC[2], biC[2]; float brvC, bivC, spvC;
    auto ldw = [&](int nt, bf16x8 (&br)[2], bf16x8 (&bi)[2], float& brv, float& biv, float& spv) {
        const int c = n * 64 + 16 * nt + fr;
#pragma unroll
        for (int ks = 0; ks < 2; ++ks) {
            br[ks] = *(const bf16x8*)(wr_ + (16 * nt + fr) * 64 + 32 * ks + 8 * quad);
            bi[ks] = *(const bf16x8*)(wi_ + (16 * nt + fr) * 64 + 32 * ks + 8 * quad);
        }
        brv = p.rg_br[l * 512 + c]; biv = p.rg_bi[l * 512 + c]; spv = ((const float*)(p.ws + WS_SP))[l * 512 + c];
    };
    ldw(0, brC, biC, brvC, bivC, spvC);
#pragma unroll 1
    for (int nt = 0; nt < 4; ++nt) {
        const int c = n * 64 + 16 * nt + fr;
        bf16x8 brN[2], biN[2]; float brvN, bivN, spvN;
        ldw(nt < 3 ? nt + 1 : 3, brN, biN, brvN, bivN, spvN);
        __builtin_amdgcn_sched_barrier(0);
        f32x4 ar[4], ai[4];
#pragma unroll
        for (int m = 0; m < 4; ++m) { ar[m] = (f32x4){0.f, 0.f, 0.f, 0.f}; ai[m] = (f32x4){0.f, 0.f, 0.f, 0.f}; }
#pragma unroll
        for (int ks = 0; ks < 2; ++ks) {
#pragma unroll
            for (int m = 0; m < 4; ++m) { ar[m] = MFMA16(af[m][ks], brC[ks], ar[m]); ai[m] = MFMA16(af[m][ks], biC[ks], ai[m]); }
        }
        const float brv = brvC, biv = bivC, spv = spvC;
        float Am = 1.f, Hm = 0.f;
#pragma unroll
        for (int m = 0; m < 4; ++m) {
            float Pl[4], hl[4];
            float pa = 1.f, ph = 0.f;
#pragma unroll
            for (int j = 0; j < 4; ++j) {
                const float xcv = xcf[(16 * m + 4 * quad + j) * 68 + 16 * nt + fr];
                const float r = sigmoidf_(ar[m][j] + brv), ig = sigmoidf_(ai[m][j] + biv);
                const float la = -8.0f * r * spv;
                const float a = __expf(la);
                const float em = 1.0f - a * a;
                const float u = __builtin_amdgcn_sqrtf(em) * (ig * xcv);
                pa = pa * a; ph = a * ph + u;
                Pl[j] = pa; hl[j] = ph;
            }
            float Ai = pa, Hi = ph;
            {
                const float a1 = shf(Ai, lane - 16), h1 = shf(Hi, lane - 16);
                if (quad >= 1) { Hi = Ai * h1 + Hi; Ai = a1 * Ai; }
                const float a2 = shf(Ai, lane - 32), h2 = shf(Hi, lane - 32);
                if (quad >= 2) { Hi = Ai * h2 + Hi; Ai = a2 * Ai; }
            }
            float Ae = shf(Ai, lane - 16), He = shf(Hi, lane - 16);
            if (quad == 0) { Ae = 1.f; He = 0.f; }
            const float Pin = Am * Ae, Hin = Ae * Hm + He;
#pragma unroll
            for (int j = 0; j < 4; ++j)
                ((unsigned*)xcf)[(16 * m + 4 * quad + j) * 68 + 16 * nt + fr] = pk2(hl[j] + Pl[j] * Hin, Pl[j] * Pin);
            const float A3 = shf(Ai, 48 + fr), H3 = shf(Hi, 48 + fr);
            Hm = A3 * Hm + H3; Am = Am * A3;
        }
        if (quad == 0) {
            ((float*)(p.ws + WS_SUMH))[((size_t)b * NCH + ch) * 512 + c] = Hm;
            ((float*)(p.ws + WS_SUMP))[((size_t)b * NCH + ch) * 512 + c] = Am;
        }
        brC[0] = brN[0]; brC[1] = brN[1]; biC[0] = biN[0]; biC[1] = biN[1]; brvC = brvN; bivC = bivN; spvC = spvN;
    }
    LDS_FENCE();
    {
        const int r = lane >> 3, c8 = lane & 7, cc = n * 64 + c8 * 8;
        bf16_t* hloc = (bf16_t*)(p.ws + WS_HLOC) + (t0 + r) * 512 + cc;
        bf16_t* pc = (bf16_t*)(p.ws + WS_PC) + (t0 + r) * 512 + cc;
#pragma unroll
        for (int it = 0; it < 8; ++it) {
            const u32x4* src = (const u32x4*)(xcf + (it * 8 + r) * 68 + c8 * 8);
            const u32x4 v0 = src[0], v1 = src[1];
            u32x4 hh, pp;
            hh.x = (v0.x & 0xffffu) | (v0.y << 16); hh.y = (v0.z & 0xffffu) | (v0.w << 16); hh.z = (v1.x & 0xffffu) | (v1.y << 16); hh.w = (v1.z & 0xffffu) | (v1.w << 16);
            pp.x = (v0.x >> 16) | (v0.y & 0xffff0000u); pp.y = (v0.z >> 16) | (v0.w & 0xffff0000u); pp.z = (v1.x >> 16) | (v1.y & 0xffff0000u); pp.w = (v1.z >> 16) | (v1.w & 0xffff0000u);
            *(u32x4*)(hloc + (size_t)it * 8 * 512) = hh;
            *(u32x4*)(pc + (size_t)it * 8 * 512) = pp;
        }
    }
    LDS_FENCE();
}

__device__ __forceinline__ void cmp_block_item(const Params& p, int l, int kv, int bg, int blk32, unsigned char* lds, int tid) {
    const bf16_t* z = (const bf16_t*)(p.ws + WS_Z);
    const int wid = __builtin_amdgcn_readfirstlane(tid >> 6), lane = tid & 63, fr = lane & 15, quad = lane >> 4, b = bg >> 1, g = bg & 1;
    const int i0 = blk32 * 32;
    const bf16_t* w1t = (const bf16_t*)(p.ws + WS_W1T) + (size_t)(l * 2 + kv) * 128 * 2048;
    const int colbase = (kv ? C_VC : C_KC) + g * 64;
    f32x4 acc[8][2];
#pragma unroll
    for (int mt = 0; mt < 8; ++mt) { acc[mt][0] = (f32x4){0.f, 0.f, 0.f, 0.f}; acc[mt][1] = (f32x4){0.f, 0.f, 0.f, 0.f}; }
    const bf16_t* arow = w1t + lane * 8;
    const int blkA = i0 + fr, blkB = i0 + 16 + fr;
    auto ldstep = [&](int kq, bf16x8 (&af)[8], bf16x8 (&bf)[2]) {
        const int kk = wid * 8 + kq;
        const int j = kk >> 1, d = 32 * (kk & 1) + 8 * quad;
        int tokA = 16 * blkA + j, tokB = 16 * blkB + j;
        tokA = tokA < SEQ ? tokA : SEQ - 1; tokB = tokB < SEQ ? tokB : SEQ - 1;
        bf[0] = *(const bf16x8*)(z + ((size_t)b * SEQ + tokA) * ZW + colbase + d);
        bf[1] = *(const bf16x8*)(z + ((size_t)b * SEQ + tokB) * ZW + colbase + d);
#pragma unroll
        for (int mt = 0; mt < 8; ++mt) af[mt] = *(const bf16x8*)(arow + (size_t)(mt * 64 + kk) * 512);
    };
    {
        bf16x8 aC[8], bC[2], aN[8], bN[2];
        ldstep(0, aC, bC);
#pragma unroll
        for (int kq = 0; kq < 8; ++kq) {
            if (kq + 1 < 8) ldstep(kq + 1, aN, bN);
            __builtin_amdgcn_sched_barrier(0);
#pragma unroll
            for (int mt = 0; mt < 8; ++mt) {
                acc[mt][0] = MFMA16(aC[mt], bC[0], acc[mt][0]);
                acc[mt][1] = MFMA16(aC[mt], bC[1], acc[mt][1]);
            }
            __builtin_amdgcn_sched_barrier(0);
#pragma unroll
            for (int mt = 0; mt < 8; ++mt) aC[mt] = aN[mt];
            bC[0] = bN[0]; bC[1] = bN[1];
        }
    }
    __syncthreads();
    f32x4* red = (f32x4*)lds;
#pragma unroll
    for (int mt = 0; mt < 8; ++mt) { red[((wid * 8 + mt) * 2 + 0) * 64 + lane] = acc[mt][0]; red[((wid * 8 + mt) * 2 + 1) * 64 + lane] = acc[mt][1]; }
    __syncthreads();
    {
        const float* b1p = (const float*)(p.ws + WS_B1) + (size_t)(l * 2 + kv) * 16 * 128 + 16 * wid + 4 * quad;
        float b1[4] = {0.f, 0.f, 0.f, 0.f};
#pragma unroll
        for (int ks = 0; ks < 16; ++ks) { const f32x4 v = *(const f32x4*)(b1p + ks * 128); b1[0] += v.x; b1[1] += v.y; b1[2] += v.z; b1[3] += v.w; }
        unsigned char* hid = lds + 131072;
#pragma unroll
        for (int ct = 0; ct < 2; ++ct) {
            f32x4 sum = red[((0 * 8 + wid) * 2 + ct) * 64 + lane];
#pragma unroll
            for (int w2 = 1; w2 < 8; ++w2) sum += red[((w2 * 8 + wid) * 2 + ct) * 64 + lane];
            u32x2 w; w.x = pk2(siluf_(sum.x + b1[0]), siluf_(sum.y + b1[1])); w.y = pk2(siluf_(sum.z + b1[2]), siluf_(sum.w + b1[3]));
            *(u32x2*)(hid + ((((ct * 4 + (wid >> 1)) * 16 + fr) * 4 + quad) * 16) + (wid & 1) * 8) = w;
        }
    }
    __syncthreads();
    const int ct = wid & 1, dt = wid >> 1;
    f32x4 o = (f32x4){0.f, 0.f, 0.f, 0.f};
    {
        const bf16_t* w2p = (const bf16_t*)(p.ws + WS_W2P) + (size_t)(l * 2 + kv) * 8192;
        const unsigned char* hid = lds + 131072;
#pragma unroll
        for (int s = 0; s < 4; ++s) {
            const bf16x8 a = *(const bf16x8*)(w2p + ((((s * 4 + dt) * 16 + fr) * 4 + quad) * 8));
            const bf16x8 hf = *(const bf16x8*)(hid + ((((ct * 4 + s) * 16 + fr) * 4 + quad) * 16));
            o = MFMA16(a, hf, o);
        }
    }
    float* ssb = (float*)lds;
    {
        float ss = o.x * o.x + o.y * o.y + o.z * o.z + o.w * o.w;
        ss += shf(ss, lane ^ 16); ss += shf(ss, lane ^ 32);
        if (quad == 0) ssb[(ct * 4 + dt) * 16 + fr] = ss;
    }
    __syncthreads();
    const int blk = i0 + 16 * ct + fr;
    const bool valid = blk < 511;
    if (kv == 0) {
        const float ss = ssb[(ct * 4 + 0) * 16 + fr] + ssb[(ct * 4 + 1) * 16 + fr] + ssb[(ct * 4 + 2) * 16 + fr] + ssb[(ct * 4 + 3) * 16 + fr];
        const float rinv = 1.0f / sqrtf(ss * (1.0f / 64.0f) + EPS);
        const float* kg = p.k_g + (l * 3 + 0) * 64 + 16 * dt + 4 * quad;
        float v[4] = {o.x * rinv * kg[0], o.y * rinv * kg[1], o.z * rinv * kg[2], o.w * rinv * kg[3]};
        if (dt == 0) {
            const int pos = 16 * (valid ? blk : 0) + 31;
            const float* rp = (const float*)(p.ws + WS_ROPE) + pos * 16;
#pragma unroll
            for (int j = 0; j < 4; ++j) {
                const float own = v[j], oth = shf(own, lane ^ 32);
                const int i = 4 * (quad & 1) + j;
                const float cs = rp[i], sn = rp[8 + i];
                v[j] = (quad < 2) ? (own * cs - oth * sn) : (own * cs + oth * sn);
            }
        }
        u32x2 w; w.x = valid ? pk2(v[0], v[1]) : 0u; w.y = valid ? pk2(v[2], v[3]) : 0u;
        *(u32x2*)((bf16_t*)(p.ws + WS_KC) + ((size_t)bg * 512 + blk) * 64 + 16 * dt + 4 * quad) = w;
    } else {
        bf16_t* dst = (bf16_t*)(p.ws + WS_VCT) + ((size_t)bg * 64 + 16 * dt + 4 * quad) * 512 + blk;
#pragma unroll
        for (int j = 0; j < 4; ++j) dst[(size_t)j * 512] = valid ? f2bf(o[j]) : (bf16_t)0;
    }
}

__device__ __forceinline__ void phase_post(const Params& p, int l, unsigned char* lds) {
    const Ids ids = fresh_ids();
    const int wid = ids.tid >> 6, lane = ids.tid & 63, gw = ids.bid * NWAVE + wid, nw = gridDim.x * NWAVE;
    constexpr int N_CMP = 2 * 8 * 16, N_RG = NB * NCH * 8, N_QKV = (NT / 64) * 16;
    for (int it = ids.bid; it < N_CMP; it += gridDim.x) cmp_block_item(p, l, it & 1, (it >> 1) & 7, it >> 4, lds, ids.tid);
    __syncthreads();
    float* xcf = (float*)(lds + wid * 17408);
    for (int it = gw; it < N_RG + N_QKV; it += nw) {
        if (it < N_RG) { rg_item(p, l, it / (NCH * 8), (it / 8) % NCH, it & 7, xcf, lane); }
        else { const int r = it - N_RG; qkv_item(p, l, r >> 4, r & 15, (unsigned char*)xcf, lane); }
    }
}

constexpr int AT_WAVE_OFF = 66560, AT_WAVE_STRIDE = 4352, NCG = 2;
constexpr int AT_OACC = 0, AT_QS = AT_WAVE_OFF + 8 * AT_WAVE_STRIDE, AT_LACC = AT_QS + 32768, AT_SELM = AT_LACC + 1024, AT_QUEUE = AT_SELM + 1024, AT_END = AT_QUEUE + 16;
__device__ __forceinline__ int kswz(int row) { return ((row >> 1) & 1) | (((row >> 3) & 3) << 1); }

struct AttnCtx {
    int c, quad, lane, wid, tid;
    int tq0;
    int kb0, kb1, vb0, vb1;
    int ksrc, vsrc, vrow;
    bf16x8 qf[NCG][2];
};

#define AT_LAS __attribute__((address_space(3)))
__device__ __forceinline__ void stage_issue(const AttnCtx& a, AT_LAS unsigned char* ldsb, int bufoff, const bf16_t* Kb, const bf16_t* Vt, int NK, int kb) {
    const int wv = __builtin_amdgcn_readfirstlane(a.wid);
    __builtin_amdgcn_global_load_lds((const unsigned*)(Kb + (size_t)kb * 64 + a.ksrc), (AT_LAS unsigned*)(ldsb + bufoff + wv * 1024), 16, 0, 0);
    __builtin_amdgcn_global_load_lds((const unsigned*)(Vt + (size_t)a.vrow * NK + kb + a.vsrc), (AT_LAS unsigned*)(ldsb + bufoff + 8192 + wv * 1024), 16, 0, 0);
}
__device__ __forceinline__ void stage_wait_barrier(int rem) {
    if (rem >= 2) asm volatile("s_waitcnt vmcnt(4)" ::: "memory");
    else if (rem == 1) asm volatile("s_waitcnt vmcnt(2)" ::: "memory");
    else asm volatile("s_waitcnt vmcnt(0)" ::: "memory");
    asm volatile("s_waitcnt lgkmcnt(0)" ::: "memory");
    __builtin_amdgcn_s_barrier();
    asm volatile("" ::: "memory");
}
template <class KBF, class BODY, class NEXT>
__device__ __forceinline__ int tile_stream(const AttnCtx& a, unsigned char* lds, int nt, const bf16_t* Ksrc, const bf16_t* Vsrc, int NK, KBF kbf, BODY body,
                                           int base, bool primed, NEXT next) {
    AT_LAS unsigned char* ldsb = (AT_LAS unsigned char*)lds;
    if (!primed) {
        asm volatile("s_waitcnt lgkmcnt(0)" ::: "memory"); __builtin_amdgcn_s_barrier(); asm volatile("" ::: "memory");
        if (nt > 0) stage_issue(a, ldsb, (base & 1) * 32768, Ksrc, Vsrc, NK, kbf(0));
        if (nt > 1) stage_issue(a, ldsb, (base & 1) * 32768 + 16384, Ksrc, Vsrc, NK, kbf(1));
    }
    const int np = (nt + 1) >> 1;
    for (int P = 0; P < np; ++P) {
        stage_wait_barrier(0);
        const int nb = 2 * P + 2, sb = ((P + 1 + base) & 1) * 32768;
        if (nb < nt) stage_issue(a, ldsb, sb, Ksrc, Vsrc, NK, kbf(nb));
        if (nb + 1 < nt) stage_issue(a, ldsb, sb + 16384, Ksrc, Vsrc, NK, kbf(nb + 1));
        if (P + 1 == np) next(sb);
#pragma unroll 1
        for (int h = 0; h < 2; ++h) {
            const int i = 2 * P + h;
            if (i < nt) body(lds + ((P + base) & 1) * 32768 + h * 16384, i);
        }
    }
    return (base + np) & 1;
}
template <class KBF, class BODY>
__device__ __forceinline__ void tile_stream(const AttnCtx& a, unsigned char* lds, int nt, const bf16_t* Ksrc, const bf16_t* Vsrc, int NK, KBF kbf, BODY body) {
    (void)tile_stream(a, lds, nt, Ksrc, Vsrc, NK, kbf, body, 0, false, [](int) {});
}

template <bool DO_PV, bool IMP, int MM>
__device__ __forceinline__ void tile_step(const AttnCtx& a, const unsigned char* buf, int st, int kabs  ,
                                          unsigned act  , f32x4 (&O)[4][NCG], f32x4 (&L)[NCG],
                                          unsigned selbits  , float mb, float (&imp3)[NCG][3]) {
    bf16x8 kf[2][2];
#pragma unroll
    for (int T = 0; T < 2; ++T) {
        kf[T][0] = *(const bf16x8*)(buf + a.kb0 + st * 4096 + T * 512);
        kf[T][1] = *(const bf16x8*)(buf + a.kb1 + st * 4096 + T * 512);
    }
    bf16x8 vf[4];
    if (DO_PV) {
#pragma unroll
        for (int dt = 0; dt < 4; ++dt) vf[dt] = *(const bf16x8*)(buf + (st ? a.vb1 : a.vb0) + dt * 2048);
    }
    const int k0 = kabs + 8 * a.quad;
    const bf16x8 ones = {(short)0x3F80, (short)0x3F80, (short)0x3F80, (short)0x3F80, (short)0x3F80, (short)0x3F80, (short)0x3F80, (short)0x3F80};
#pragma unroll
    for (int cg = 0; cg < NCG; ++cg) {
        if (!((act >> cg) & 1u)) continue;
        const f32x4 c0 = (f32x4){-mb, -mb, -mb, -mb};
        f32x4 s0 = MFMA16(kf[0][0], a.qf[cg][0], c0);
        f32x4 s1 = MFMA16(kf[1][0], a.qf[cg][0], c0);
        s0 = MFMA16(kf[0][1], a.qf[cg][1], s0);
        s1 = MFMA16(kf[1][1], a.qf[cg][1], s1);
        const int tq = a.tq0 + 4 * cg;
        int hi = tq, lo = -1;
        if (MM == 1) lo = tq - 512;
        if (MM == 4) hi = ((tq + 1) >> 4) - 2;
        const bool sel = (selbits >> cg) & 1u;
        float pv[8];
#pragma unroll
        for (int e = 0; e < 8; ++e) {
            float v = __builtin_amdgcn_exp2f((e < 4) ? s0[e & 3] : s1[e & 3]);
            if (MM == 1) { const int k = k0 + e; v = (k > lo && k <= hi) ? v : 0.f; }
            if (MM == 3 || MM == 4) { const int k = k0 + e; v = (k <= hi) ? v : 0.f; }
            if (MM == 2) v = sel ? v : 0.f;
            pv[e] = v;
        }
        if (IMP) {
            imp3[cg][0] = pv[0] + pv[1] + pv[2] + 0.5f * pv[3];
            imp3[cg][1] = pv[4] + pv[5] + pv[6] + 0.5f * pv[7] + 0.5f * pv[3];
            imp3[cg][2] = 0.5f * pv[7];
        }
        u32x4 w; w.x = pk2(pv[0], pv[1]); w.y = pk2(pv[2], pv[3]); w.z = pk2(pv[4], pv[5]); w.w = pk2(pv[6], pv[7]);
        const bf16x8 pf = as_bf16x8(w);
        L[cg] = MFMA16(ones, pf, L[cg]);
        if (DO_PV) {
#pragma unroll
            for (int dt = 0; dt < 4; ++dt) O[dt][cg] = MFMA16(vf[dt], pf, O[dt][cg]);
        }
    }
}

template <bool DO_PV, bool IMP, int MM, int CGM>
__device__ __forceinline__ void tile_compute(const AttnCtx& a, const bf16x8 (&kf)[2][2][2], const bf16x8 (&vf)[2][4], int kabs  ,
                                             f32x4 (&O)[4][NCG], f32x4 (&L)[NCG], unsigned selbits, float mb, float (&imp3)[2][NCG][3]) {
    const bf16x8 ones = {(short)0x3F80, (short)0x3F80, (short)0x3F80, (short)0x3F80, (short)0x3F80, (short)0x3F80, (short)0x3F80, (short)0x3F80};
    const f32x4 c0 = (f32x4){-mb, -mb, -mb, -mb};
    f32x4 sc[2][NCG][2];
#pragma unroll
    for (int st = 0; st < 2; ++st)
#pragma unroll
        for (int cg = 0; cg < NCG; ++cg) {
            if (!((CGM >> cg) & 1)) continue;
            sc[st][cg][0] = MFMA16(kf[st][0][0], a.qf[cg][0], c0);
            sc[st][cg][1] = MFMA16(kf[st][1][0], a.qf[cg][0], c0);
        }
#pragma unroll
    for (int st = 0; st < 2; ++st)
#pragma unroll
        for (int cg = 0; cg < NCG; ++cg) {
            if (!((CGM >> cg) & 1)) continue;
            sc[st][cg][0] = MFMA16(kf[st][0][1], a.qf[cg][1], sc[st][cg][0]);
            sc[st][cg][1] = MFMA16(kf[st][1][1], a.qf[cg][1], sc[st][cg][1]);
        }
    bf16x8 pf[2][NCG];
#pragma unroll
    for (int st = 0; st < 2; ++st)
#pragma unroll
        for (int cg = 0; cg < NCG; ++cg) {
            if (!((CGM >> cg) & 1)) continue;
            const int k0 = kabs + 32 * st + 8 * a.quad;
            const int tq = a.tq0 + 4 * cg;
            int hi = tq, lo = -1;
            if (MM == 1) lo = tq - 512;
            if (MM == 4) hi = ((tq + 1) >> 4) - 2;
            const bool sel = (selbits >> cg) & 1u;
            float pv[8];
#pragma unroll
            for (int e = 0; e < 8; ++e) {
                float v = __builtin_amdgcn_exp2f(sc[st][cg][e >> 2][e & 3]);
                if (MM == 1) { const int k = k0 + e; v = (k > lo && k <= hi) ? v : 0.f; }
                if (MM == 3 || MM == 4) { const int k = k0 + e; v = (k <= hi) ? v : 0.f; }
                if (MM == 2) v = sel ? v : 0.f;
                pv[e] = v;
            }
            if (IMP) {
                imp3[st][cg][0] = pv[0] + pv[1] + pv[2] + 0.5f * pv[3];
                imp3[st][cg][1] = pv[4] + pv[5] + pv[6] + 0.5f * pv[7] + 0.5f * pv[3];
                imp3[st][cg][2] = 0.5f * pv[7];
            }
            u32x4 w; w.x = pk2(pv[0], pv[1]); w.y = pk2(pv[2], pv[3]); w.z = pk2(pv[4], pv[5]); w.w = pk2(pv[6], pv[7]);
            pf[st][cg] = as_bf16x8(w);
        }
#pragma unroll
    for (int st = 0; st < 2; ++st)
#pragma unroll
        for (int cg = 0; cg < NCG; ++cg) {
            if (!((CGM >> cg) & 1)) continue;
            L[cg] = MFMA16(ones, pf[st][cg], L[cg]);
            if (DO_PV) {
#pragma unroll
                for (int dt = 0; dt < 4; ++dt) O[dt][cg] = MFMA16(vf[st][dt], pf[st][cg], O[dt][cg]);
            }
        }
}

template <bool DO_PV, bool IMP, int MM, int CGM>
__device__ __forceinline__ void tile_full(const AttnCtx& a, const unsigned char* buf, int kabs, f32x4 (&O)[4][NCG], f32x4 (&L)[NCG], unsigned selbits, float mb,
                                          float (&imp3)[2][NCG][3]) {
    bf16x8 kf[2][2][2], vf[2][4];
#pragma unroll
    for (int st = 0; st < 2; ++st)
#pragma unroll
        for (int T = 0; T < 2; ++T) {
            kf[st][T][0] = *(const bf16x8*)(buf + a.kb0 + st * 4096 + T * 512);
            kf[st][T][1] = *(const bf16x8*)(buf + a.kb1 + st * 4096 + T * 512);
        }
    if (DO_PV) {
#pragma unroll
        for (int dt = 0; dt < 4; ++dt) { vf[0][dt] = *(const bf16x8*)(buf + a.vb0 + dt * 2048); vf[1][dt] = *(const bf16x8*)(buf + a.vb1 + dt * 2048); }
    }
    tile_compute<DO_PV, IMP, MM, CGM>(a, kf, vf, kabs, O, L, selbits, mb, imp3);
}
__device__ __forceinline__ void frags_tiled(const AttnCtx& a, const bf16_t* Kt, const bf16_t* Vtt, int tile, bf16x8 (&kf)[2][2][2], bf16x8 (&vf)[2][4]) {
    const bf16_t* kp = Kt + (size_t)tile * 4096 + a.lane * 8;
    const bf16_t* vp = Vtt + (size_t)tile * 4096 + a.lane * 8;
#pragma unroll
    for (int st = 0; st < 2; ++st) {
#pragma unroll
        for (int T = 0; T < 2; ++T) { kf[st][T][0] = *(const bf16x8*)(kp + ((st * 2 + T) * 2 + 0) * 512); kf[st][T][1] = *(const bf16x8*)(kp + ((st * 2 + T) * 2 + 1) * 512); }
#pragma unroll
        for (int dt = 0; dt < 4; ++dt) vf[st][dt] = *(const bf16x8*)(vp + (st * 4 + dt) * 512);
    }
}
__device__ __forceinline__ void frags_global(const AttnCtx& a, const bf16_t* Kb, const bf16_t* Vt, int kb, bf16x8 (&kf)[2][2][2], bf16x8 (&vf)[2][4]) {
#pragma unroll
    for (int st = 0; st < 2; ++st) {
#pragma unroll
        for (int T = 0; T < 2; ++T) {
            const bf16_t* kp = Kb + (size_t)(kb + 32 * st + (a.c >> 2) * 8 + T * 4 + (a.c & 3)) * 64 + 8 * a.quad;
            kf[st][T][0] = *(const bf16x8*)kp; kf[st][T][1] = *(const bf16x8*)(kp + 32);
        }
#pragma unroll
        for (int dt = 0; dt < 4; ++dt) vf[st][dt] = *(const bf16x8*)(Vt + (size_t)(16 * dt + a.c) * SEQ + kb + 32 * st + 8 * a.quad);
    }
}

typedef __fp16 h2v_ __attribute__((ext_vector_type(2)));
__device__ __forceinline__ unsigned pkh2(float lo, float hi) { return __builtin_bit_cast(unsigned, __builtin_amdgcn_cvt_pkrtz(lo, hi)); }
__device__ __forceinline__ float h2lo(unsigned u) { return (float)__builtin_bit_cast(h2v_, u)[0]; }
__device__ __forceinline__ float h2hi(unsigned u) { return (float)__builtin_bit_cast(h2v_, u)[1]; }
__device__ __forceinline__ float dpp_swap1(float v) {
    return __builtin_bit_cast(float, __builtin_amdgcn_mov_dpp(__builtin_bit_cast(int, v), 0xB1, 0xF, 0xF, true));
}
__device__ __forceinline__ float dpp_quad_sum(float v) {
    int x = __builtin_bit_cast(int, v);
    float t = v + __builtin_bit_cast(float, __builtin_amdgcn_mov_dpp(x, 0xB1, 0xF, 0xF, true));
    x = __builtin_bit_cast(int, t);
    return t + __builtin_bit_cast(float, __builtin_amdgcn_mov_dpp(x, 0x4E, 0xF, 0xF, true));
}

__device__ __forceinline__ void attn_block_item(const Params& p, int l, int bg, int qi, unsigned char* lds, int tid, bool primed_c, bool prime_next, int& sbase) {
    asm volatile("" : "+v"(tid));
    const bf16_t* z = (const bf16_t*)(p.ws + WS_Z);
    AttnCtx a;
    a.tid = tid; a.wid = tid >> 6; a.lane = tid & 63; a.c = a.lane & 15; a.quad = a.lane >> 4;
    const int b = bg >> 1, g = bg & 1, s0 = qi * 64, sw = s0 + 8 * a.wid, hd = a.c & 3;
    float* wl = (float*)(lds + AT_WAVE_OFF + a.wid * AT_WAVE_STRIDE);
    unsigned short* selm = (unsigned short*)(lds + AT_SELM) + a.wid * 64;
    a.tq0 = sw + (a.c >> 2);
    {
        const int swc = ((a.c >> 1) & 1) | ((a.c >> 2) << 1);
        const int rowb = (a.c >> 2) * 1024 + (a.c & 3) * 128;
        a.kb0 = rowb + ((a.quad ^ swc) << 4); a.kb1 = rowb + (((4 + a.quad) ^ swc) << 4);
        const int swv = (a.c >> 1) & 7;
        a.vb0 = 8192 + a.c * 128 + ((a.quad ^ swv) << 4); a.vb1 = 8192 + a.c * 128 + (((4 + a.quad) ^ swv) << 4);
        const int row = tid >> 3, cp = tid & 7;
        a.ksrc = row * 64 + ((cp ^ kswz(row)) << 3); a.vrow = row; a.vsrc = (cp ^ ((row >> 1) & 7)) << 3;
        asm volatile("" : "+v"(a.kb0), "+v"(a.kb1), "+v"(a.vb0), "+v"(a.vb1), "+v"(a.ksrc), "+v"(a.vsrc));
    }
#define TROW(cg) ((size_t)b * SEQ + (size_t)(a.tq0 + 4 * (cg)))
#pragma unroll
    for (int cg = 0; cg < NCG; ++cg) {
        const bf16_t* qp = (const bf16_t*)(p.ws + WS_QN) + TROW(cg) * 512 + (4 * g + hd) * 64 + 8 * a.quad;
        a.qf[cg][0] = *(const bf16x8*)qp; a.qf[cg][1] = *(const bf16x8*)(qp + 32);
    }
    float gv[NCG];
#pragma unroll
    for (int cg = 0; cg < NCG; ++cg) gv[cg] = sigmoidf_(bf2f(z[TROW(cg) * ZW + C_BG + 12 * g + 3 * hd + (a.quad < 2 ? a.quad : 2)]));
#define GATE(cg, br) shf(gv[cg], a.c + 16 * (br))
    const float* mbp = (const float*)(p.ws + WS_MB) + l * 4;
    f32x4 O[4][NCG], L[NCG];
    float invl[NCG], imp3[2][NCG][3];
    AT_LAS unsigned char* ldsb = (AT_LAS unsigned char*)lds;
#define ZERO_ACC() { _Pragma("unroll") for (int h_ = 0; h_ < NCG; ++h_) L[h_] = (f32x4){0.f, 0.f, 0.f, 0.f}; \
                     _Pragma("unroll") for (int dt_ = 0; dt_ < 4; ++dt_) _Pragma("unroll") for (int h_ = 0; h_ < NCG; ++h_) O[dt_][h_] = (f32x4){0.f, 0.f, 0.f, 0.f}; }
    {
        const bf16_t* kc = (const bf16_t*)(p.ws + WS_KC) + (size_t)bg * 512 * 64;
        const bf16_t* vct = (const bf16_t*)(p.ws + WS_VCT) + (size_t)bg * 64 * 512;
        const int nmax_b = ((s0 + 64) >> 4) - 1;
        const int nct = (nmax_b + 63) >> 6;
        const int nmax_w = ((sw + 8) >> 4) - 1;
        const int nmin_w = ((sw + 1) >> 4) - 1;
        const float mb_c = mbp[0];
        const float isc = __builtin_amdgcn_exp2f(fminf(floorf(mb_c) - 2.0f, 100.0f));
        unsigned* rawp = (unsigned*)((hd < 2) ? (unsigned char*)wl : lds + AT_QS + a.wid * 4096);
        ZERO_ACC();
        float co_prev[NCG] = {0.f, 0.f};
        (void)tile_stream(a, lds, nct, kc, vct, 512, [](int i) { return i * 64; }, [&](const unsigned char* buf, int i_) {
            const int kb = i_ * 64;
            if (kb < nmax_w) {
                if (kb + 63 >= nmin_w) tile_full<true, true, 4, 3>(a, buf, kb, O, L, 0u, mb_c, imp3);
                else tile_full<true, true, 0, 3>(a, buf, kb, O, L, 0u, mb_c, imp3);
#pragma unroll
                for (int st = 0; st < 2; ++st) {
                    const int j0 = ((kb + 32 * st) >> 2) + 2 * a.quad;
#pragma unroll
                    for (int cg = 0; cg < NCG; ++cg) {
                        float X0 = imp3[st][cg][0], X1 = imp3[st][cg][1];
                        const float co = imp3[st][cg][2];
                        const float send = (a.quad == 3) ? co_prev[cg] : co;
                        X0 += shf(send, (a.lane + 48) & 63);
                        co_prev[cg] = co;
                        X0 *= isc; X1 *= isc;
                        const float Y0 = dpp_swap1(X0), Y1 = dpp_swap1(X1);
                        if (!(hd & 1)) { const int q = 4 * cg + (a.c >> 2); rawp[j0 * 8 + q] = pkh2(X0, Y0); rawp[(j0 + 1) * 8 + q] = pkh2(X1, Y1); }
                    }
                }
            }
        }, sbase, primed_c, [](int) {});
#pragma unroll
        for (int cg = 0; cg < NCG; ++cg) {
            invl[cg] = L[cg].x > 0.f ? 1.0f / L[cg].x : 0.f;
            if (a.quad == 0) wl[1024 + (4 * cg + (a.c >> 2)) * 4 + hd] = invl[cg];
        }
    }
    LDS_FENCE();
    const int bt = s0 >> 6;
    {
        const int q = a.lane & 7, part = a.lane >> 3;
        unsigned mymask = 0u;
        if (bt >= 16) {
            unsigned key[16];
            const unsigned* r01 = (const unsigned*)wl + (16 * part) * 8 + q;
            const unsigned* r23 = (const unsigned*)(lds + AT_QS + a.wid * 4096) + (16 * part) * 8 + q;
            const f32x4 il = *(const f32x4*)(wl + 1024 + q * 4);
            const int ilo = 1 - 16 * part, ihi = bt - 2 - 16 * part, jrev = 127 - 16 * part;
#pragma unroll
            for (int i = 0; i < 16; ++i) {
                const unsigned u0 = r01[i * 8], u1 = r23[i * 8];
                const unsigned bits = __float_as_uint((h2lo(u0) * il.x + h2hi(u0) * il.y) + (h2lo(u1) * il.z + h2hi(u1) * il.w));
                key[i] = (i >= ilo && i <= ihi) ? ((bits & ~127u) | (unsigned)(jrev - i)) : 0u;
            }
            for (int it = 0; it < 13; ++it) {
                unsigned m = 0u;
#pragma unroll
                for (int i = 0; i < 16; ++i) m = key[i] > m ? key[i] : m;
                { const unsigned o = (unsigned)__builtin_amdgcn_update_dpp(0, (int)m, 0x128, 0xF, 0xF, false); m = o > m ? o : m; }
                { const auto r = __builtin_amdgcn_permlane16_swap(m, m, false, false); m = r[0] > r[1] ? r[0] : r[1]; }
                { const auto r = __builtin_amdgcn_permlane32_swap(m, m, false, false); m = r[0] > r[1] ? r[0] : r[1]; }
                const int jsel = 127 - (int)(m & 127u);
                if ((jsel >> 4) == part) mymask |= 1u << (jsel & 15);
#pragma unroll
                for (int i = 0; i < 16; ++i) key[i] = (key[i] == m) ? 0u : key[i];
            }
            if (part == 0) mymask |= 1u;
            if (((bt - 1) >> 4) == part) mymask |= 1u << ((bt - 1) & 15);
            if ((bt >> 4) == part) mymask |= 1u << (bt & 15);
        } else {
            if (part == 0) mymask = (2u << bt) - 1u;
        }
        selm[q * 8 + part] = (unsigned short)mymask;
    }
    LDS_FENCE();
#define PARK_ADDR(cg, dt) ((unsigned char*)wl + (16 * (cg) + a.c) * 128 + (((4 * (dt) + a.quad) ^ (((16 * (cg) + a.c) >> 1) & 7)) << 3))
#pragma unroll
    for (int cg = 0; cg < NCG; ++cg) {
        const float gc = GATE(cg, 0) * invl[cg];
#pragma unroll
        for (int dt = 0; dt < 4; ++dt) {
            u32x2 w; w.x = pk2(gc * O[dt][cg].x, gc * O[dt][cg].y); w.y = pk2(gc * O[dt][cg].z, gc * O[dt][cg].w);
            *(u32x2*)PARK_ADDR(cg, dt) = w;
        }
    }
    const bf16_t* kwb = (const bf16_t*)(p.ws + WS_KW) + (size_t)bg * SEQ * 64;
    const bf16_t* vwt = (const bf16_t*)(p.ws + WS_VWT) + (size_t)bg * 64 * SEQ;
    int t0w = s0 - 511; t0w = t0w < 0 ? 0 : t0w; t0w >>= 6;
    const int t1w = (s0 + 63) >> 6;
    auto prime_window = [&](int sb) {
        stage_issue(a, ldsb, sb, kwb, vwt, SEQ, t0w * 64);
        if (t1w > t0w) stage_issue(a, ldsb, sb + 16384, kwb, vwt, SEQ, (t0w + 1) * 64);
    };
    int wbase = 0;
    {
        const bf16_t* ksb = (const bf16_t*)(p.ws + WS_KS) + (size_t)bg * SEQ * 64;
        const bf16_t* vst = (const bf16_t*)(p.ws + WS_VST) + (size_t)bg * 64 * SEQ;
        const float mb_s = mbp[1];
        const bf16_t* ks2 = (const bf16_t*)(p.ws + WS_KS2) + (size_t)bg * SEQ * 64;
        const bf16_t* vs2 = (const bf16_t*)(p.ws + WS_VST2) + (size_t)bg * 64 * SEQ;
        if (bt < 16) {
            ZERO_ACC();
            wbase = tile_stream(a, lds, bt + 1, ksb, vst, SEQ, [](int i) { return i * 64; }, [&](const unsigned char* buf, int i_) {
                if (i_ == bt) tile_full<true, false, 3, 3>(a, buf, i_ * 64, O, L, 3u, mb_s, imp3);
                else tile_full<true, false, 0, 3>(a, buf, i_ * 64, O, L, 3u, mb_s, imp3);
            }, 0, false, prime_window);
        } else {
            const int wv = __builtin_amdgcn_readfirstlane(a.wid);
            asm volatile("s_waitcnt lgkmcnt(0)" ::: "memory"); __builtin_amdgcn_s_barrier(); asm volatile("" ::: "memory");
#pragma unroll
            for (int cg = 0; cg < NCG; ++cg) {
                const int row = (8 * wv + 4 * cg + (a.c >> 2)) * 4 + hd, qs = ((row >> 1) & 1) | (((row >> 2) & 3) << 1);
                *(bf16x8*)(lds + AT_QS + row * 128 + (((0 + a.quad) ^ qs) << 4)) = a.qf[cg][0];
                *(bf16x8*)(lds + AT_QS + row * 128 + (((4 + a.quad) ^ qs) << 4)) = a.qf[cg][1];
            }
            { u32x4 zz = (u32x4){0u, 0u, 0u, 0u}; asm volatile("" : "+v"(zz));
              for (int i = tid; i < (256 * 65 * 4) / 16; i += NTHR) *(u32x4*)(lds + AT_OACC + i * 16) = zz; }
            if (tid < 256) ((float*)(lds + AT_LACC))[tid] = 0.f;
            if (tid == 0) *(unsigned*)(lds + AT_QUEUE) = 1u;
            asm volatile("s_waitcnt lgkmcnt(0)" ::: "memory"); __builtin_amdgcn_s_barrier(); asm volatile("" ::: "memory");
            {
                const u32x4 mq = *(const u32x4*)(lds + AT_SELM + a.lane * 16);
                const bf16x8 ones = {(short)0x3F00, (short)0x3F00, (short)0x3F00, (short)0x3F00, (short)0x3F00, (short)0x3F00, (short)0x3F00, (short)0x3F00};
                const float cb = 22.0f - mb_s;
                const f32x4 c0 = (f32x4){cb, cb, cb, cb};
                float* oacc = (float*)(lds + AT_OACC);
                float* lacc = (float*)(lds + AT_LACC);
                unsigned* queue = (unsigned*)(lds + AT_QUEUE);
                auto next_blk = [&](unsigned long long& qm) -> int {
                    for (;;) {
                        int j = 0;
                        if (a.lane == 0) j = (int)__hip_atomic_fetch_add(queue, 1u, __ATOMIC_RELAXED, __HIP_MEMORY_SCOPE_WORKGROUP);
                        j = __builtin_amdgcn_readfirstlane(j);
                        if (j > bt - 2) { qm = 0ull; return -1; }
                        const unsigned wsel = (j < 32) ? mq.x : (j < 64) ? mq.y : (j < 96) ? mq.z : mq.w;
                        qm = __ballot((wsel >> (j & 31)) & 1u);
                        if (qm != 0ull) return j;
                    }
                };
                auto groups = [&](const bf16x8 (&kf)[2][2][2], const bf16x8 (&vf)[2][4], unsigned long long qm) {
#pragma unroll 1
                    while (qm != 0ull) {
                        const int q0 = __builtin_ctzll(qm); qm &= qm - 1ull;
                        int q1 = -1, q2 = -1, q3 = -1;
                        if (qm != 0ull) { q1 = __builtin_ctzll(qm); qm &= qm - 1ull; }
                        if (qm != 0ull) { q2 = __builtin_ctzll(qm); qm &= qm - 1ull; }
                        if (qm != 0ull) { q3 = __builtin_ctzll(qm); qm &= qm - 1ull; }
                        const int qi = a.c >> 2;
                        int myq = (qi == 0) ? q0 : (qi == 1) ? q1 : (qi == 2) ? q2 : q3;
                        const bool valid = myq >= 0;
                        myq = valid ? myq : q0;
                        const int row = myq * 4 + hd, qs = ((row >> 1) & 1) | (((row >> 2) & 3) << 1);
                        const unsigned char* qrow = lds + AT_QS + row * 128;
                        const bf16x8 qa = *(const bf16x8*)(qrow + (((0 + a.quad) ^ qs) << 4)), qb = *(const bf16x8*)(qrow + (((4 + a.quad) ^ qs) << 4));
                        f32x4 sa[2][2];
#pragma unroll
                        for (int st = 0; st < 2; ++st)
#pragma unroll
                            for (int T = 0; T < 2; ++T) sa[st][T] = MFMA16(kf[st][T][0], qa, c0);
#pragma unroll
                        for (int st = 0; st < 2; ++st)
#pragma unroll
                            for (int T = 0; T < 2; ++T) sa[st][T] = MFMA16(kf[st][T][1], qb, sa[st][T]);
                        bf16x8 pf[2];
#pragma unroll
                        for (int st = 0; st < 2; ++st) {
                            float pv[8];
#pragma unroll
                            for (int e = 0; e < 8; ++e) pv[e] = __builtin_amdgcn_exp2f(sa[st][e >> 2][e & 3]);
                            u32x4 w; w.x = pk2(pv[0], pv[1]); w.y = pk2(pv[2], pv[3]); w.z = pk2(pv[4], pv[5]); w.w = pk2(pv[6], pv[7]);
                            pf[st] = as_bf16x8(w);
                        }
                        f32x4 Lc = MFMA16(ones, pf[0], ((f32x4){0.f, 0.f, 0.f, 0.f}));
                        Lc = MFMA16(ones, pf[1], Lc);
                        f32x4 Oc[4];
#pragma unroll
                        for (int dt = 0; dt < 4; ++dt) { Oc[dt] = MFMA16(vf[0][dt], pf[0], ((f32x4){0.f, 0.f, 0.f, 0.f})); Oc[dt] = MFMA16(vf[1][dt], pf[1], Oc[dt]); }
                        if (valid) {
                            float* ob = oacc + row * 65 + 4 * a.quad;
#pragma unroll
                            for (int dt = 0; dt < 4; ++dt)
#pragma unroll
                                for (int e = 0; e < 4; ++e) (void)__hip_atomic_fetch_add((int*)(ob + 16 * dt + e), (int)Oc[dt][e], __ATOMIC_RELAXED, __HIP_MEMORY_SCOPE_WORKGROUP);
                            if (a.quad == 0) (void)__hip_atomic_fetch_add((int*)(lacc + row), (int)Lc.x, __ATOMIC_RELAXED, __HIP_MEMORY_SCOPE_WORKGROUP);
                        }
                    }
                };
                bf16x8 kfA[2][2][2], vfA[2][4], kfB[2][2][2], vfB[2][4];
                unsigned long long qmA = 0ull, qmB = 0ull;
                int jA = next_blk(qmA);
                if (jA >= 0) frags_tiled(a, ks2, vs2, jA, kfA, vfA);
#pragma unroll 1
                while (jA >= 0) {
                    const int jB = next_blk(qmB);
                    if (jB >= 0) frags_tiled(a, ks2, vs2, jB, kfB, vfB);
                    groups(kfA, vfA, qmA);
                    if (jB < 0) break;
                    jA = next_blk(qmA);
                    if (jA >= 0) frags_tiled(a, ks2, vs2, jA, kfA, vfA);
                    groups(kfB, vfB, qmB);
                }
            }
            asm volatile("s_waitcnt lgkmcnt(0)" ::: "memory"); __builtin_amdgcn_s_barrier(); asm volatile("" ::: "memory");
            asm volatile("" : "+v"(a.tq0));
#pragma unroll
            for (int cg = 0; cg < NCG; ++cg) {
                const int row = (8 * wv + 4 * cg + (a.c >> 2)) * 4 + hd;
                { const int qs = ((row >> 1) & 1) | (((row >> 2) & 3) << 1);
                  a.qf[cg][0] = *(const bf16x8*)(lds + AT_QS + row * 128 + (((0 + a.quad) ^ qs) << 4));
                  a.qf[cg][1] = *(const bf16x8*)(lds + AT_QS + row * 128 + (((4 + a.quad) ^ qs) << 4)); }
                const int* ob = (const int*)(lds + AT_OACC) + row * 65 + 4 * a.quad;
                const float lv = (float)((const int*)(lds + AT_LACC))[row] * (1.0f / 2097152.0f);
                L[cg] = (f32x4){lv, lv, lv, lv};
#pragma unroll
                for (int dt = 0; dt < 4; ++dt)
#pragma unroll
                    for (int e = 0; e < 4; ++e) O[dt][cg][e] = (float)ob[16 * dt + e] * (1.0f / 4194304.0f);
            }
            wbase = tile_stream(a, lds, 3, ksb, vst, SEQ, [bt](int i) { return ((i == 0) ? 0 : bt - 2 + i) * 64; }, [&](const unsigned char* buf, int i_) {
                if (i_ == 2) tile_full<true, false, 3, 3>(a, buf, bt * 64, O, L, 3u, mb_s, imp3);
                else tile_full<true, false, 0, 3>(a, buf, ((i_ == 0) ? 0 : bt - 1) * 64, O, L, 3u, mb_s, imp3);
            }, 0, false, prime_window);
        }
#pragma unroll
        for (int cg = 0; cg < NCG; ++cg) {
            const float coef = L[cg].x > 0.f ? GATE(cg, 1) / L[cg].x : 0.f;
#pragma unroll
            for (int dt = 0; dt < 4; ++dt) {
                u32x2* pa = (u32x2*)PARK_ADDR(cg, dt);
                const u32x2 o = *pa;
                u32x2 w;
                w.x = pk2(bflo(o.x) + coef * O[dt][cg].x, bfhi(o.x) + coef * O[dt][cg].y);
                w.y = pk2(bflo(o.y) + coef * O[dt][cg].z, bfhi(o.y) + coef * O[dt][cg].w);
                *pa = w;
            }
        }
    }
    {
        const float mb_w = mbp[2];
        ZERO_ACC();
        {
            const int wv = __builtin_amdgcn_readfirstlane(a.wid);
#pragma unroll
            for (int i = 0; i < 4; ++i) {
                const int r = i * 8 + (a.lane >> 3), ch = a.lane & 7;
                const bf16_t* src = z + ((size_t)b * SEQ + sw + (r >> 2)) * ZW + C_NG + (4 * g + (r & 3)) * 64 + ((ch ^ (r & 7)) << 3);
                __builtin_amdgcn_global_load_lds((const unsigned*)src, (AT_LAS unsigned*)(ldsb + AT_QS + wv * 4096 + i * 1024), 16, 0, 0);
            }
        }
        sbase = tile_stream(a, lds, t1w - t0w + 1, kwb, vwt, SEQ, [t0w](int i) { return (t0w + i) * 64; }, [&](const unsigned char* buf, int i_) {
            const int kb = (t0w + i_) * 64;
            if (kb + 63 > sw - 512 && kb <= sw + 7) {
                if ((kb > sw + 7 - 512) && (kb + 63 <= sw)) tile_full<true, false, 0, 3>(a, buf, kb, O, L, 0u, mb_w, imp3);
                else tile_full<true, false, 1, 3>(a, buf, kb, O, L, 0u, mb_w, imp3);
            }
        }, wbase, true, [&](int sb) {
            if (prime_next) {
                const bf16_t* kc = (const bf16_t*)(p.ws + WS_KC) + (size_t)bg * 512 * 64;
                const bf16_t* vct = (const bf16_t*)(p.ws + WS_VCT) + (size_t)bg * 64 * 512;
                stage_issue(a, ldsb, sb, kc, vct, 512, 0);
                stage_issue(a, ldsb, sb + 16384, kc, vct, 512, 64);
            }
        });
        u32x2 gwv[NCG][4];
        asm volatile("" ::: "memory");
#pragma unroll
        for (int cg = 0; cg < NCG; ++cg) {
            const int row = (4 * cg + (a.c >> 2)) * 4 + hd;
            const unsigned char* ngl = lds + AT_QS + a.wid * 4096 + row * 128 + (a.quad & 1) * 8;
#pragma unroll
            for (int dt = 0; dt < 4; ++dt) gwv[cg][dt] = *(const u32x2*)(ngl + (((2 * dt + (a.quad >> 1)) ^ (row & 7)) << 4));
        }
#pragma unroll
        for (int cg = 0; cg < NCG; ++cg) {
            const float coef = L[cg].x > 0.f ? GATE(cg, 2) / L[cg].x : 0.f;
            bf16_t* yo = (bf16_t*)(p.ws + WS_Y) + TROW(cg) * DM + 512 + (4 * g + hd) * 64 + 4 * a.quad;
#pragma unroll
            for (int dt = 0; dt < 4; ++dt) {
                const u32x2 o = *(const u32x2*)PARK_ADDR(cg, dt);
                const u32x2 gw = gwv[cg][dt];
                float r0 = bflo(o.x) + coef * O[dt][cg].x, r1 = bfhi(o.x) + coef * O[dt][cg].y, r2 = bflo(o.y) + coef * O[dt][cg].z, r3 = bfhi(o.y) + coef * O[dt][cg].w;
                r0 *= siluf_(bflo(gw.x)); r1 *= siluf_(bfhi(gw.x)); r2 *= siluf_(bflo(gw.y)); r3 *= siluf_(bfhi(gw.y));
                u32x2 w; w.x = pk2(r0, r1); w.y = pk2(r2, r3);
                *(u32x2*)(yo + 16 * dt) = w;
            }
        }
    }
    LDS_FENCE();
#undef GATE
#undef TROW
#undef ZERO_ACC
#undef PARK_ADDR
}

__device__ __forceinline__ void rgfin_item(const Params& p, int b, int ch, int n, float* wsc  , int lane) {
    const bf16_t* z = (const bf16_t*)(p.ws + WS_Z);
    {
        const int c = n * 64 + lane;
        const float* sh = (const float*)(p.ws + WS_SUMH) + (size_t)b * NCH * 512 + c;
        const float* sp = (const float*)(p.ws + WS_SUMP) + (size_t)b * NCH * 512 + c;
        float h = 0.f;
        int j = 0;
        for (; j + 32 <= ch; j += 32) {
            float pv[32], hv[32];
#pragma unroll
            for (int u = 0; u < 32; ++u) { pv[u] = sp[(size_t)(j + u) * 512]; hv[u] = sh[(size_t)(j + u) * 512]; }
#pragma unroll
            for (int u = 0; u < 32; ++u) h = pv[u] * h + hv[u];
        }
        {
            float pv[32], hv[32];
#pragma unroll
            for (int u = 0; u < 32; ++u) { const bool ok = j + u < ch; pv[u] = ok ? sp[(size_t)(j + u) * 512] : 1.f; hv[u] = ok ? sh[(size_t)(j + u) * 512] : 0.f; }
#pragma unroll
            for (int u = 0; u < 32; ++u) h = pv[u] * h + hv[u];
        }
        wsc[lane] = h;
    }
    LDS_FENCE();
    const int r = lane >> 3, c8 = lane & 7;
    float cr[8];
    { const f32x4 c0 = *(const f32x4*)(wsc + c8 * 8), c1 = *(const f32x4*)(wsc + c8 * 8 + 4); cr[0] = c0.x; cr[1] = c0.y; cr[2] = c0.z; cr[3] = c0.w; cr[4] = c1.x; cr[5] = c1.y; cr[6] = c1.z; cr[7] = c1.w; }
    const size_t t0 = (size_t)b * SEQ + (size_t)ch * 64 + r;
    const int cc = n * 64 + c8 * 8;
    const bf16_t* hl = (const bf16_t*)(p.ws + WS_HLOC) + t0 * 512 + cc;
    const bf16_t* pc = (const bf16_t*)(p.ws + WS_PC) + t0 * 512 + cc;
    const bf16_t* zg = z + t0 * ZW + C_RGG + cc;
    bf16_t* y = (bf16_t*)(p.ws + WS_Y) + t0 * DM + cc;
    u32x4 hwN = *(const u32x4*)hl, pwN = *(const u32x4*)pc, gwN = *(const u32x4*)zg;
#pragma unroll
    for (int it = 0; it < 8; ++it) {
        const u32x4 hw = hwN, pw = pwN, gw = gwN;
        if (it + 1 < 8) {
            hwN = *(const u32x4*)(hl + (size_t)(it + 1) * 8 * 512);
            pwN = *(const u32x4*)(pc + (size_t)(it + 1) * 8 * 512);
            gwN = *(const u32x4*)(zg + (size_t)(it + 1) * 8 * ZW);
        }
        __builtin_amdgcn_sched_barrier(0);
        const unsigned hh[4] = {hw.x, hw.y, hw.z, hw.w}, pp[4] = {pw.x, pw.y, pw.z, pw.w}, gg[4] = {gw.x, gw.y, gw.z, gw.w};
        unsigned o[4];
#pragma unroll
        for (int k = 0; k < 4; ++k) {
            const float v0 = (bflo(hh[k]) + bflo(pp[k]) * cr[2 * k]) * siluf_(bflo(gg[k]));
            const float v1 = (bfhi(hh[k]) + bfhi(pp[k]) * cr[2 * k + 1]) * siluf_(bfhi(gg[k]));
            o[k] = pk2(v0, v1);
        }
        u32x4 ow; ow.x = o[0]; ow.y = o[1]; ow.z = o[2]; ow.w = o[3];
        *(u32x4*)(y + (size_t)it * 8 * DM) = ow;
    }
    LDS_FENCE();
}

__device__ __forceinline__ void phase_attn(const Params& p, int l, unsigned char* lds) {
    const Ids ids = fresh_ids();
    const int wid = ids.tid >> 6, lane = ids.tid & 63, gw = ids.bid * NWAVE + wid, nw = gridDim.x * NWAVE;
    const bool chain = (gridDim.x & 7) == 0;
    int sbase = 0;
    for (int it = ids.bid; it < 1024; it += gridDim.x) {
        const int bg = it & 7, k = it >> 3;
        attn_block_item(p, l, bg, (k < 64) ? 127 - k : k - 64, lds, ids.tid, chain && it != ids.bid, chain && it + (int)gridDim.x < 1024, sbase);
    }
    constexpr int N_RG = NB * NCH * 8;
    float* wsc = (float*)(lds + AT_WAVE_OFF + wid * AT_WAVE_STRIDE);
    for (int r = gw; r < N_RG; r += nw) rgfin_item(p, r / (NCH * 8), (r / 8) % NCH, r & 7, wsc, lane);
}

constexpr int LDS_BYTES = NWAVE * 17408;
static_assert(LDS_BYTES >= pg8::STAGE_BYTES && LDS_BYTES >= AT_END && 256 * 65 * 4 <= AT_WAVE_OFF, "lds");

__global__ void __launch_bounds__(512) k_mega(Params p) {
    extern __shared__ __attribute__((aligned(16))) unsigned char lds[];
    unsigned* bar = (unsigned*)(p.ws + WS_BAR);
    volatile unsigned* st = (volatile unsigned*)(lds + LDS_BYTES);
    {
        const Ids ids = fresh_ids();
        if (ids.tid == 0) { st[0] = 0u; st[1] = 0u; (void)xb_add(&bar[XB_XCNT(xb_xcc_id())], 1u); }
    }
    __syncthreads();
    phase_prologue(p, lds);
    grid_barrier(bar, st);
#pragma unroll 1
    for (int l = 0; l < DEPTH; ++l) {
        phase_gemm_in(p, l, lds);
        grid_barrier(bar, st);
        phase_post(p, l, lds);
        grid_barrier(bar, st);
        phase_attn(p, l, lds);
        grid_barrier(bar, st);
        phase_gemm_out(p, l, lds, (l == 0) ? p.x : p.out, p.out);
        if (l + 1 < DEPTH) grid_barrier(bar, st);
    }
}

extern "C" void kernel_launch(void* const* d_in, const int* in_sizes, int n_in, void* d_out, int out_size, void* d_ws, size_t ws_size,
                              hipStream_t stream) {
    static int grid = 0;
    if (grid == 0) {
        if (n_in != 19 || ws_size < WS_END) { fprintf(stderr, "kernel_launch: unexpected n_in %d / ws_size %zu (need %zu)\n", n_in, ws_size, (size_t)WS_END); grid = -1; return; }
        (void)hipFuncSetAttribute((const void*)k_mega, hipFuncAttributeMaxDynamicSharedMemorySize, LDS_BYTES + 16);
        int dev = 0, cus = 0, per_cu = 0;
        (void)hipGetDevice(&dev);
        (void)hipDeviceGetAttribute(&cus, hipDeviceAttributeMultiprocessorCount, dev);
        (void)hipOccupancyMaxActiveBlocksPerMultiprocessor(&per_cu, (const void*)k_mega, NTHR, LDS_BYTES + 16);
        if (per_cu < 1) { fprintf(stderr, "kernel_launch: occupancy query says %d blocks per CU\n", per_cu); grid = -1; return; }
        per_cu = 1;
        grid = cus * per_cu;
    }
    if (grid < 0) return;
    Params p{};
    const float** dst = (const float**)&p;
    for (int i = 0; i < 19; ++i) dst[i] = (const float*)d_in[i];
    p.out = (float*)d_out;
    p.ws = (unsigned char*)d_ws;
    (void)hipMemsetAsync((unsigned char*)d_ws + WS_BAR, 0, 16384, stream);
    hipLaunchKernelGGL(k_mega, dim3(grid), dim3(NTHR), LDS_BYTES + 16, stream, p);
}
```

```cpp
#include <hip/hip_runtime.h>
#include <stdint.h>
#include <stdio.h>

typedef unsigned short bf16_t;
typedef short bf16x8 __attribute__((ext_vector_type(8)));
typedef float f32x4 __attribute__((ext_vector_type(4)));
typedef unsigned u32x4 __attribute__((ext_vector_type(4)));
typedef unsigned u32x2 __attribute__((ext_vector_type(2)));

constexpr int NB = 4, SEQ = 8192, NT = NB * SEQ, DM = 1024, DEPTH = 2;
constexpr int NIN = 2840, ZW = 3072;
constexpr int NTHR = 512, NWAVE = 8;
constexpr int C_RGX = 0, C_RGG = 512, C_Q = 1024, C_KC = 1536, C_VC = 1664, C_KS = 1792, C_VS = 1920, C_KW = 2048, C_VW = 2176,
              C_NG = 2304, C_BG = 2816;
constexpr int NCH = SEQ / 64;
constexpr float EPS = 1e-6f;
constexpr float LOG2E = 1.4426950408889634f;

constexpr size_t AL(size_t x) { return (x + 255) & ~(size_t)255; }
constexpr size_t WS_WTIN = 0;
constexpr size_t WS_WTOUT = WS_WTIN + AL((size_t)DEPTH * ZW * DM * 2);
constexpr size_t WS_ROPE = WS_WTOUT + AL((size_t)DEPTH * DM * DM * 2);
constexpr size_t WS_W1T = WS_ROPE + AL((size_t)SEQ * 16 * 4);
constexpr size_t WS_B1 = WS_W1T + AL((size_t)DEPTH * 2 * 128 * 2048 * 2);
constexpr size_t WS_W2P = WS_B1 + AL((size_t)DEPTH * 2 * 16 * 128 * 4);
constexpr size_t WS_RGW = WS_W2P + AL((size_t)DEPTH * 2 * 8192 * 2);
constexpr size_t WS_SP = WS_RGW + AL((size_t)DEPTH * 2 * 8 * 4096 * 2);
constexpr size_t WS_MB = WS_SP + AL((size_t)DEPTH * 512 * 4);
constexpr size_t WS_XB = WS_MB + AL(256);
constexpr size_t WS_RSTD = WS_XB + AL((size_t)NT * DM * 2);
constexpr size_t WS_Z = WS_RSTD + AL((size_t)NT * 4);
constexpr size_t WS_QN = WS_Z + AL((size_t)NT * ZW * 2);
constexpr size_t WS_KS = WS_QN + AL((size_t)NT * 512 * 2);
constexpr size_t WS_KW = WS_KS + AL((size_t)NT * 128 * 2);
constexpr size_t WS_VST = WS_KW + AL((size_t)NT * 128 * 2);
constexpr size_t WS_VWT = WS_VST + AL((size_t)NT * 128 * 2);
constexpr size_t WS_KC = WS_VWT + AL((size_t)NT * 128 * 2);
constexpr size_t WS_VCT = WS_KC + AL((size_t)8 * 512 * 64 * 2);
constexpr size_t WS_HLOC = WS_VCT + AL((size_t)8 * 512 * 64 * 2);
constexpr size_t WS_PC = WS_HLOC + AL((size_t)NT * 512 * 2);
constexpr size_t WS_SUMH = WS_PC + AL((size_t)NT * 512 * 2);
constexpr size_t WS_SUMP = WS_SUMH + AL((size_t)NB * NCH * 512 * 4);
constexpr size_t WS_Y = WS_SUMP + AL((size_t)NB * NCH * 512 * 4);
constexpr size_t WS_BAR = WS_Y + AL((size_t)NT * DM * 2);
constexpr size_t WS_ROWP = WS_BAR + 16384;
constexpr size_t WS_KS2 = WS_ROWP + AL((size_t)NT * 16 * 4);
constexpr size_t WS_VST2 = WS_KS2 + AL((size_t)NT * 128 * 2);
constexpr size_t WS_END = WS_VST2 + AL((size_t)NT * 128 * 2);

struct Params {
    const float *x, *norm_g, *w_in, *conv_w, *conv_b, *rg_wr, *rg_br, *rg_wi, *rg_bi, *rg_lam, *q_g, *k_g, *pe_k, *w1_k, *w2_k, *pe_v,
        *w1_v, *w2_v, *w_out;
    float* out;
    unsigned char* ws;
};

typedef float f32x2v_ __attribute__((ext_vector_type(2)));
typedef __bf16 bf16x2v_ __attribute__((ext_vector_type(2)));
__device__ __forceinline__ unsigned pk2(float lo, float hi) {
    const f32x2v_ v = {lo, hi};
    return __builtin_bit_cast(unsigned, __builtin_convertvector(v, bf16x2v_));
}
__device__ __forceinline__ bf16_t f2bf(float f) { return (bf16_t)(pk2(f, 0.f) & 0xffffu); }
__device__ __forceinline__ float bf2f(unsigned h) { return __uint_as_float(h << 16); }
__device__ __forceinline__ float bflo(unsigned w) { return __uint_as_float(w << 16); }
__device__ __forceinline__ float bfhi(unsigned w) { return __uint_as_float(w & 0xffff0000u); }
__device__ __forceinline__ float sigmoidf_(float v) { return __builtin_amdgcn_rcpf(1.f + __expf(-v)); }
__device__ __forceinline__ float siluf_(float v) { return v * __builtin_amdgcn_rcpf(1.f + __expf(-v)); }
__device__ __forceinline__ bf16x8 as_bf16x8(u32x4 v) { return __builtin_bit_cast(bf16x8, v); }
__device__ __forceinline__ float shf(float v, int src) { return __builtin_bit_cast(float, __builtin_amdgcn_ds_bpermute(src << 2, __builtin_bit_cast(int, v))); }
__device__ __forceinline__ unsigned shu(unsigned v, int src) { return (unsigned)__builtin_amdgcn_ds_bpermute(src << 2, (int)v); }
#define MFMA16(a, b, c) __builtin_amdgcn_mfma_f32_16x16x32_bf16((a), (b), (c), 0, 0, 0)
#define LDS_FENCE() asm volatile("s_waitcnt lgkmcnt(0)" ::: "memory")
struct Ids { int tid, bid; };
__device__ __forceinline__ Ids fresh_ids() {
    Ids i;
    const int lane = __builtin_amdgcn_mbcnt_hi(~0u, __builtin_amdgcn_mbcnt_lo(~0u, 0u));
    int wv = __builtin_amdgcn_readfirstlane(threadIdx.x >> 6);
    i.tid = wv * 64 + lane; i.bid = blockIdx.x;
    asm volatile("" : "+v"(i.tid), "+s"(i.bid));
    return i;
}
#define XB_TMO      128
#define XB_XCNT(j)  (256  + 64 * (j))
#define XB_XSUB(j)  (1280 + 64 * (j))
#define XB_XGEN(j)  (2304 + 64 * (j))
#define XB_TOP      3328
#define XB_TOPGEN   3392
#define XCD_BAR_WORDS 3456
#define XB_SPIN_CAP (1u << 20)
__device__ __forceinline__ unsigned xb_ld(unsigned* p) { return __hip_atomic_load(p, __ATOMIC_RELAXED, __HIP_MEMORY_SCOPE_AGENT); }
__device__ __forceinline__ unsigned xb_add(unsigned* p, unsigned v) { return __hip_atomic_fetch_add(p, v, __ATOMIC_RELAXED, __HIP_MEMORY_SCOPE_AGENT); }
__device__ __forceinline__ unsigned xb_xcc_id() { return (unsigned)__builtin_amdgcn_s_getreg((3 << 11) | 20) & 0xFu; }
#define XB_SPIN(cond, bar) do { unsigned _sp = 0; while (cond) { __builtin_amdgcn_s_sleep(1); \
    if ((++_sp & 255u) == 0u) { if (xb_ld(&(bar)[XB_TMO])) break; if (_sp > XB_SPIN_CAP) { atomicAdd(&(bar)[XB_TMO], 1u); break; } } } } while (0)
__device__ __forceinline__ void xcd_barrier_complete(unsigned* bar, unsigned x, unsigned& nloc, unsigned& nx) {
    const unsigned G = gridDim.x;
    unsigned sum, cnt, mine, sp = 0u;
    for (;;) {
        sum = 0u; cnt = 0u; mine = 0u;
#pragma unroll
        for (unsigned j = 0; j < 16; ++j) { const unsigned c = xb_ld(&bar[XB_XCNT(j)]); sum += c; cnt += (c > 0u) ? 1u : 0u; mine = (j == x) ? c : mine; }
        if (sum == G) break;
        __builtin_amdgcn_s_sleep(1);
        if ((++sp & 255u) == 0u) { if (xb_ld(&bar[XB_TMO])) break; if (sp > XB_SPIN_CAP) { atomicAdd(&bar[XB_TMO], 1u); break; } }
    }
    nloc = mine > 0u ? mine : 1u; nx = cnt > 0u ? cnt : 1u;
}
__device__ __forceinline__ void grid_barrier(unsigned* bar, volatile unsigned* st) {
    asm volatile("s_waitcnt vmcnt(0)" ::: "memory");
    __syncthreads();
    const Ids ids = fresh_ids();
    if (ids.tid == 0) {
        const unsigned x = xb_xcc_id();
        __builtin_amdgcn_s_waitcnt(0);
        unsigned nloc = st[0], nx = st[1];
        if (nloc == 0u) { xcd_barrier_complete(bar, x, nloc, nx); st[0] = nloc; st[1] = nx; }
        const unsigned old = xb_add(&bar[XB_XSUB(x)], 1u);
        const unsigned gen = old / nloc;
        if (old + 1u == (gen + 1u) * nloc) {
            __builtin_amdgcn_fence(__ATOMIC_RELEASE, "agent");
            asm volatile("s_waitcnt vmcnt(0)" ::: "memory");
            const unsigned og = xb_add(&bar[XB_TOP], 1u);
            const unsigned tg = og / nx;
            if (og + 1u == (tg + 1u) * nx) xb_add(&bar[XB_TOPGEN], 1u);
            else XB_SPIN(xb_ld(&bar[XB_TOPGEN]) == tg, bar);
            __builtin_amdgcn_fence(__ATOMIC_ACQUIRE, "agent");
            xb_add(&bar[XB_XGEN(x)], 1u);
            asm volatile("s_waitcnt vmcnt(0)" ::: "memory");
        } else {
            XB_SPIN(xb_ld(&bar[XB_XGEN(x)]) == gen, bar);
            __builtin_amdgcn_fence(__ATOMIC_ACQUIRE, "agent");
            asm volatile("s_waitcnt vmcnt(0)" ::: "memory");
        }
    }
    __syncthreads();
}

template <bool FRAG = false>
__device__ __forceinline__ void transpose_tile(const float* W, int K, int N, const float* kscale, bf16_t* Wt, int k0, int n0, float* t, int lane) {
    const int n = n0 + lane;
    float wv[64];
#pragma unroll
    for (int kk = 0; kk < 64; ++kk) wv[kk] = (n < N) ? W[(size_t)(k0 + kk) * N + n] : 0.f;
    __builtin_amdgcn_sched_barrier(0);
    if (kscale) {
        const float ks = kscale[k0 + lane];
#pragma unroll
        for (int kk = 0; kk < 64; ++kk) wv[kk] *= shf(ks, kk);
    }
#pragma unroll
    for (int kk = 0; kk < 64; ++kk) t[kk * 65 + lane] = wv[kk];
    LDS_FENCE();
    const int r = lane >> 3, c8 = lane & 7;
#pragma unroll
    for (int it = 0; it < 8; ++it) {
        const int nn = it * 8 + r;
        const float* src = t + (c8 * 8) * 65 + nn;
        u32x4 o;
        o.x = pk2(src[0], src[65]); o.y = pk2(src[2 * 65], src[3 * 65]); o.z = pk2(src[4 * 65], src[5 * 65]); o.w = pk2(src[6 * 65], src[7 * 65]);
        if (FRAG) { const int n_ = n0 + nn, k_ = k0 + c8 * 8; *(u32x4*)(Wt + ((size_t)(((n_ >> 4) * (K >> 5) + (k_ >> 5)) * 4 + ((k_ >> 3) & 3)) * 16 + (n_ & 15)) * 8) = o; }
        else *(u32x4*)(Wt + (size_t)(n0 + nn) * K + k0 + c8 * 8) = o;
    }
    LDS_FENCE();
}

__device__ __forceinline__ void xrow_item(const float* xr, bf16_t* xb, float* rstd, int lane) {
    const f32x4* p = (const f32x4*)xr;
    f32x4 v[4];
    float s = 0.f;
#pragma unroll
    for (int j = 0; j < 4; ++j) { v[j] = p[j * 64 + lane]; s += v[j].x * v[j].x + v[j].y * v[j].y + v[j].z * v[j].z + v[j].w * v[j].w; }
#pragma unroll
    for (int o = 1; o < 64; o <<= 1) s += shf(s, lane ^ o);
    u32x2* q = (u32x2*)xb;
#pragma unroll
    for (int j = 0; j < 4; ++j) { u32x2 w; w.x = pk2(v[j].x, v[j].y); w.y = pk2(v[j].z, v[j].w); q[j * 64 + lane] = w; }
    if (lane == 0) *rstd = 1.0f / sqrtf(s * (1.0f / DM) + EPS);
}

__device__ __forceinline__ void phase_xprep(const Params& p, const float* xin) {
    const Ids ids = fresh_ids();
    const int lane = ids.tid & 63, gw = ids.bid * NWAVE + (ids.tid >> 6), nw = gridDim.x * NWAVE;
    bf16_t* xb = (bf16_t*)(p.ws + WS_XB);
    float* rstd = (float*)(p.ws + WS_RSTD);
    for (int r = gw; r < NT; r += nw) xrow_item(xin + (size_t)r * DM, xb + (size_t)r * DM, rstd + r, lane);
}

__device__ __forceinline__ void phase_prologue(const Params& p, unsigned char* lds) {
    const Ids ids = fresh_ids();
    const int gtid = ids.bid * NTHR + ids.tid, gth = gridDim.x * NTHR;
    const int wid = ids.tid >> 6, lane = ids.tid & 63, gw = ids.bid * NWAVE + wid, nw = gridDim.x * NWAVE;
    {
        float* t = (float*)(lds + wid * 17408);
        constexpr int T_IN = 16 * 48, T_OUT = 16 * 16, T_W1 = 32 * 2, T_L = T_IN + T_OUT + 2 * T_W1, N_B1 = DEPTH * 2 * 2 * 16;
        for (int it = gw; it < DEPTH * T_L + N_B1; it += nw) {
            if (it < DEPTH * T_L) {
                const int l = it / T_L; int r = it % T_L;
                if (r < T_IN) { transpose_tile(p.w_in + (size_t)l * DM * NIN, DM, NIN, p.norm_g + l * DM, (bf16_t*)(p.ws + WS_WTIN) + (size_t)l * ZW * DM, (r / 48) * 64, (r % 48) * 64, t, lane); continue; }
                r -= T_IN;
                if (r < T_OUT) { transpose_tile(p.w_out + (size_t)l * DM * DM, DM, DM, nullptr, (bf16_t*)(p.ws + WS_WTOUT) + (size_t)l * DM * DM, (r / 16) * 64, (r % 16) * 64, t, lane); continue; }
                r -= T_OUT;
                const int kv = r / T_W1; r %= T_W1;
                transpose_tile<true>((kv ? p.w1_v : p.w1_k) + (size_t)l * 2048 * 128, 2048, 128, nullptr, (bf16_t*)(p.ws + WS_W1T) + (size_t)(l * 2 + kv) * 128 * 2048, (r / 2) * 64, (r % 2) * 64, t, lane);
            } else {
                const int r = it - DEPTH * T_L, ks = r & 15, hg = (r >> 4) & 1, kv = (r >> 5) & 1, l = r >> 6, hu = hg * 64 + lane;
                const float* pe = (kv ? p.pe_v : p.pe_k) + (size_t)l * 2048 + ks * 128;
                const float* w1 = (kv ? p.w1_v : p.w1_k) + (size_t)l * 2048 * 128 + (size_t)ks * 128 * 128 + hu;
                float sacc = 0.f;
#pragma unroll 32
                for (int k = 0; k < 128; ++k) sacc += pe[k] * w1[(size_t)k * 128];
                ((float*)(p.ws + WS_B1))[((l * 2 + kv) * 16 + ks) * 128 + hu] = sacc;
            }
        }
    }
    float* rope = (float*)(p.ws + WS_ROPE);
    for (int it = gtid; it < SEQ * 8; it += gth) {
        const int pos = it >> 3, i = it & 7;
        const float inv = powf(500000.0f, -(float)i / 8.0f);
        const float ang = (float)pos * inv;
        float sn, cs;
        sincosf(ang, &sn, &cs);
        rope[pos * 16 + i] = cs;
        rope[pos * 16 + 8 + i] = sn;
    }
    bf16_t* w2p = (bf16_t*)(p.ws + WS_W2P);
    for (int it = gtid; it < DEPTH * 2 * 8192; it += gth) {
        const int jj = it & 7, quad = (it >> 3) & 3, r = (it >> 5) & 15, dt = (it >> 9) & 3, s = (it >> 11) & 3, kv = (it >> 13) & 1, l = it >> 14;
        const int hu = 16 * (2 * s + (jj >> 2)) + 4 * quad + (jj & 3), d = 16 * dt + r;
        const float* w2 = (kv ? p.w2_v : p.w2_k) + (size_t)l * 128 * 64;
        w2p[it] = f2bf(w2[hu * 64 + d]);
    }
    bf16_t* rgw = (bf16_t*)(p.ws + WS_RGW);
    for (int it = gtid; it < DEPTH * 2 * 8 * 4096; it += gth) {
        const int in = it & 63, out = (it >> 6) & 63, n = (it >> 12) & 7, gate = (it >> 15) & 1, l = it >> 16;
        const float* w = (gate ? p.rg_wi : p.rg_wr) + (size_t)l * 8 * 4096 + n * 4096;
        rgw[it] = f2bf(w[in * 64 + out]);
    }
    float* sp = (float*)(p.ws + WS_SP);
    for (int it = gtid; it < DEPTH * 512; it += gth) {
        const float v = -p.rg_lam[it];
        sp[it] = (v > 20.f) ? v : log1pf(expf(v));
    }
    if (gw < DEPTH * 4) {
        const int l = gw >> 2, br = gw & 3;
        float mq = fabsf(p.q_g[l * 64 + lane]), mk = (br < 3) ? fabsf(p.k_g[(l * 3 + br) * 64 + lane]) : 0.f;
#pragma unroll
        for (int o = 1; o < 64; o <<= 1) { mq = fmaxf(mq, shf(mq, lane ^ o)); mk = fmaxf(mk, shf(mk, lane ^ o)); }
        if (lane == 0) ((float*)(p.ws + WS_MB))[gw] = 8.0f * mq * mk * LOG2E * 1.0001f;
    }
    phase_xprep(p, p.x);
}

namespace pg8 {
#define PG8_LAS __attribute__((address_space(3)))
constexpr int BM = 256, BK = 64, HALF = 128, HTB = HALF * BK * 2, STAGE_BYTES = 8 * HTB, NXCD = 8, WGM = 8;
__host__ __device__ __forceinline__ int lds_byte(int r, int c) { const int st = (r >> 4) * 2 + (c >> 5), rr = r & 15, cc = c & 31, ob = rr * 64 + cc * 2; return st * 1024 + (ob ^ (((ob >> 9) & 1) << 5)); }
__host__ __device__ __forceinline__ void stage_rc(int b, int& R, int& C) { const int st = b / 1024, sb = b % 1024, swz = sb ^ (((sb >> 9) & 1) << 5); R = (st >> 1) * 16 + swz / 64; C = (st & 1) * 32 + (swz % 64) / 2; }
__host__ __device__ __forceinline__ int perm32(int rho) { const int n = rho >> 4, i = rho & 15; return 8 * (i >> 2) + 4 * n + (i & 3); }
struct Unit { int pm, pn; };
struct Gemm { const bf16_t* A; const bf16_t* Bt; int M, N, K; };
struct StaticOrder {
    int nM, nN, nwg, G, c;
    __host__ __device__ void init(int M, int N, int G_, int c_) { nM = M / BM; nN = N / BM; nwg = nM * nN; G = G_; c = c_; }
    __host__ __device__ bool next(int i, Unit& u) const {
        const long L = (long)i * G + c; if (L >= nwg) return false;
        int wgid = (int)L; { const int q = nwg / NXCD, r = nwg % NXCD, xcd = wgid % NXCD, off = wgid / NXCD; wgid = (xcd < r ? xcd * (q + 1) : r * (q + 1) + (xcd - r) * q) + off; }
        const int nig = WGM * nN, gid = wgid / nig, fm = gid * WGM, gsz = (nM - fm) < WGM ? (nM - fm) : WGM;
        u.pm = fm + ((wgid % nig) % gsz); u.pn = (wgid % nig) / gsz; return true;
    }
    __device__ __forceinline__ void a_ready(const Unit&) const {}
    __device__ __forceinline__ void done(const Unit&) const {}
};
struct EpiZ {
    static constexpr bool PERM = true, AFTER_DRAIN = false;
    bf16_t* O; int ldc; const float* rstd;
    __device__ __forceinline__ void operator()(const f32x4 (&acc)[2][2][4][2], const Unit& u, int wr, int wc, int fr, int fq) const {
        const int row0 = u.pm * BM + wr * 64 + fr, col0 = u.pn * BM + wc * 32 + 8 * fq;
#pragma unroll
        for (int ai = 0; ai < 2; ++ai)
#pragma unroll
            for (int m = 0; m < 4; ++m) {
                const int row = row0 + ai * HALF + m * 16;
                const float rs = rstd[row];
                bf16_t* rowp = O + (size_t)row * ldc + col0;
#pragma unroll
                for (int bj = 0; bj < 2; ++bj) {
                    const f32x4 v0 = acc[ai][bj][m][0] * rs, v1 = acc[ai][bj][m][1] * rs;
                    u32x4 w; w.x = pk2(v0[0], v0[1]); w.y = pk2(v0[2], v0[3]); w.z = pk2(v1[0], v1[1]); w.w = pk2(v1[2], v1[3]);
                    *(u32x4*)(rowp + bj * HALF) = w;
                }
            }
    }
};
template <bool NEXT, bool XBF> struct EpiRes {
    static constexpr bool PERM = false, AFTER_DRAIN = false;
    const float* X; float* C; int ldc; bf16_t* XB; float* rowp;
    __device__ __forceinline__ void operator()(const f32x4 (&acc)[2][2][4][2], const Unit& u, int wr, int wc, int fr, int fq) const {
        const int row0 = u.pm * BM + wr * 64 + fr, col0 = u.pn * BM + wc * 32 + 4 * fq, lane = fq * 16 + fr;
#pragma unroll
        for (int ai = 0; ai < 2; ++ai)
#pragma unroll
            for (int m = 0; m < 4; ++m) {
                const int row = row0 + ai * HALF + m * 16;
                const size_t off = (size_t)row * ldc + col0;
                float ss = 0.f;
#pragma unroll
                for (int bj = 0; bj < 2; ++bj)
#pragma unroll
                    for (int n = 0; n < 2; ++n) {
                        f32x4 xv;
                        if (XBF) { const u32x2 xw = *(const u32x2*)(XB + off + bj * HALF + n * 16); xv = (f32x4){bflo(xw.x), bfhi(xw.x), bflo(xw.y), bfhi(xw.y)}; }
                        else xv = *(const f32x4*)(X + off + bj * HALF + n * 16);
                        const f32x4 v = xv + acc[ai][bj][m][n];
                        if (NEXT) {
                            ss += (v.x * v.x + v.y * v.y) + (v.z * v.z + v.w * v.w);
                            u32x2 w; w.x = pk2(v.x, v.y); w.y = pk2(v.z, v.w);
                            *(u32x2*)(XB + off + bj * HALF + n * 16) = w;
                        } else {
                            *(f32x4*)(C + off + bj * HALF + n * 16) = v;
                        }
                    }
                if (NEXT) {
                    ss += shf(ss, lane ^ 16); ss += shf(ss, lane ^ 32);
                    if (fq == 0) rowp[(size_t)row * 16 + u.pn * 4 + wc] = ss;
                }
            }
    }
};
template <class Epi, class Sched, bool ALIGN_EPI = false, bool SP2 = false>
__device__ __forceinline__ void gemm_phase(PG8_LAS unsigned char* lds, const Gemm g, const Sched& S, const Epi& E, const int tid) {
    const int wid = __builtin_amdgcn_readfirstlane(tid >> 6), lane = tid & 63, wr = wid >> 2, wc = wid & 3, fr = lane & 15, fq = lane >> 4;
    const int K = g.K, nt = K / BK;
    unsigned voffA[2], voffB[2];
#pragma unroll
    for (int i = 0; i < 2; ++i) { int R, C; stage_rc(tid * 16 + i * 8192, R, C); const int Rb = Epi::PERM ? ((R & ~31) + perm32(R & 31)) : R;
        voffA[i] = (unsigned)(R * K + C) * 2u; voffB[i] = (unsigned)(Rb * K + C) * 2u; }
    const size_t kstep = (size_t)(BK * 2);
    const size_t hstep = (size_t)HALF * K * 2;
    const size_t tstep = 2 * hstep;
    const unsigned ldsw = (unsigned)wid * 1024u;
    const int aoff = lds_byte(wr * 64 + fr, fq * 8), boff = lds_byte(wc * 32 + fr, fq * 8);
#define PG8_SA(b, h) (((b) * 2 + (h)) * HTB)
#define PG8_SB(b, h) ((4 + (b) * 2 + (h)) * HTB)
#define PG8_STAGE(bufoff, gbase, voff) do { _Pragma("unroll") for (int _i = 0; _i < 2; ++_i) \
        __builtin_amdgcn_global_load_lds((const unsigned*)((const char*)(gbase) + (voff)[_i]), (PG8_LAS unsigned*)(lds + (bufoff) + ldsw + _i * 8192), 16, 0, 0); } while (0)
#define PG8_LDA(dst, b, h) do { _Pragma("unroll") for (int m = 0; m < 4; ++m) _Pragma("unroll") for (int k = 0; k < 2; ++k) dst[m][k] = *(const PG8_LAS bf16x8*)(lds + PG8_SA(b, h) + aoff + m * 2048 + k * 1024); } while (0)
#define PG8_LDB(dst, b, h) do { _Pragma("unroll") for (int n = 0; n < 2; ++n) _Pragma("unroll") for (int k = 0; k < 2; ++k) dst[n][k] = *(const PG8_LAS bf16x8*)(lds + PG8_SB(b, h) + boff + n * 2048 + k * 1024); } while (0)
#define PG8_MMA(ai, bj, At, Bt) do { __builtin_amdgcn_s_setprio(1); _Pragma("unroll") for (int m = 0; m < 4; ++m) _Pragma("unroll") for (int n = 0; n < 2; ++n) _Pragma("unroll") for (int k = 0; k < 2; ++k) \
        acc[ai][bj][m][n] = __builtin_amdgcn_mfma_f32_16x16x32_bf16(Bt[n][k], At[m][k], acc[ai][bj][m][n], 0, 0, 0); __builtin_amdgcn_s_setprio(0); } while (0)
#define PG8_WAIT_V(n) asm volatile("s_waitcnt vmcnt(" #n ")" ::: "memory")
#define PG8_WAIT_L(n) asm volatile("s_waitcnt lgkmcnt(" #n ")" ::: "memory")
#define PG8_BAR __builtin_amdgcn_s_barrier()
#define PG8_SCHED __builtin_amdgcn_sched_barrier(0)
    Unit cur, nxt; int ui = 0;
    if (!S.next(0, cur)) return;
    f32x4 acc[2][2][4][2];
#pragma unroll
    for (int a = 0; a < 2; ++a)
#pragma unroll
        for (int b = 0; b < 2; ++b)
#pragma unroll
            for (int m = 0; m < 4; ++m)
#pragma unroll
                for (int n = 0; n < 2; ++n) acc[a][b][m][n] = (f32x4){0.f, 0.f, 0.f, 0.f};
    bf16x8 At[4][2], B0[2][2], B1[2][2];
    const char* cA = (const char*)g.A + (size_t)cur.pm * tstep; const char* cB = (const char*)g.Bt + (size_t)cur.pn * tstep;
    S.a_ready(cur);
    if constexpr (SP2) {
        PG8_STAGE(PG8_SB(0, 0), cB, voffB); PG8_STAGE(PG8_SB(0, 1), cB + hstep, voffB); PG8_STAGE(PG8_SA(0, 0), cA, voffA); PG8_STAGE(PG8_SA(0, 1), cA + hstep, voffA);
        if (wr == 1) PG8_BAR;
        PG8_WAIT_V(2); PG8_BAR;
        PG8_STAGE(PG8_SB(1, 0), cB + kstep, voffB); PG8_STAGE(PG8_SA(1, 0), cA + kstep, voffA); PG8_STAGE(PG8_SB(1, 1), cB + hstep + kstep, voffB);
        PG8_WAIT_V(6); PG8_BAR;
    } else {
        PG8_STAGE(PG8_SB(0, 0), cB, voffB); PG8_STAGE(PG8_SA(0, 0), cA, voffA); PG8_STAGE(PG8_SB(0, 1), cB + hstep, voffB); PG8_STAGE(PG8_SA(0, 1), cA + hstep, voffA);
        if (wr == 1) PG8_BAR;
        PG8_WAIT_V(4); PG8_BAR;
        PG8_STAGE(PG8_SB(1, 0), cB + kstep, voffB); PG8_STAGE(PG8_SA(1, 0), cA + kstep, voffA); PG8_STAGE(PG8_SB(1, 1), cB + hstep + kstep, voffB);
        PG8_WAIT_V(6); PG8_BAR;
    }
    for (;;) {
        const bool has_next = S.next(ui + 1, nxt);
        const char* nA = has_next ? (const char*)g.A + (size_t)nxt.pm * tstep : cA; const char* nB = has_next ? (const char*)g.Bt + (size_t)nxt.pn * tstep : cB;
        for (int t = 0; t < nt; t += 2) {
            const bool last = (t == nt - 2);
            const char* a1 = cA + (size_t)(t + 1) * kstep;
            const char* a2 = last ? nA : cA + (size_t)(t + 2) * kstep; const char* b2 = last ? nB : cB + (size_t)(t + 2) * kstep;
            const char* a3 = a2 + kstep; const char* b3 = b2 + kstep;
            if (last && has_next) S.a_ready(nxt);
            if constexpr (SP2) {
            PG8_LDB(B0, 0, 0); PG8_LDB(B1, 0, 1); PG8_SCHED; PG8_LDA(At, 0, 0); PG8_STAGE(PG8_SA(1, 1), a1 + hstep, voffA);
            PG8_WAIT_V(8); PG8_WAIT_L(0); PG8_BAR; PG8_MMA(0, 0, At, B0); PG8_MMA(0, 1, At, B1); PG8_BAR; PG8_SCHED;
            PG8_LDA(At, 0, 1); PG8_STAGE(PG8_SB(0, 0), b2, voffB); PG8_STAGE(PG8_SB(0, 1), b2 + hstep, voffB); PG8_STAGE(PG8_SA(0, 0), a2, voffA);
            PG8_WAIT_V(8); PG8_WAIT_L(0); PG8_BAR; PG8_MMA(1, 0, At, B0); PG8_MMA(1, 1, At, B1); PG8_BAR; PG8_SCHED;
            PG8_LDB(B0, 1, 0); PG8_LDB(B1, 1, 1); PG8_SCHED; PG8_LDA(At, 1, 0); PG8_STAGE(PG8_SA(0, 1), a2 + hstep, voffA);
            PG8_WAIT_V(8); PG8_WAIT_L(0); PG8_BAR; PG8_MMA(0, 0, At, B0); PG8_MMA(0, 1, At, B1); PG8_BAR; PG8_SCHED;
            PG8_LDA(At, 1, 1); PG8_STAGE(PG8_SB(1, 0), b3, voffB); PG8_STAGE(PG8_SB(1, 1), b3 + hstep, voffB); PG8_STAGE(PG8_SA(1, 0), a3, voffA);
            PG8_WAIT_V(8); PG8_WAIT_L(0); PG8_BAR; PG8_MMA(1, 0, At, B0); PG8_MMA(1, 1, At, B1); PG8_BAR; PG8_SCHED;
            } else {
            PG8_LDB(B0, 0, 0); PG8_SCHED; PG8_LDA(At, 0, 0); PG8_STAGE(PG8_SA(1, 1), a1 + hstep, voffA);
            PG8_WAIT_L(8); PG8_BAR; PG8_WAIT_L(0); PG8_MMA(0, 0, At, B0); PG8_BAR; PG8_SCHED;
            PG8_LDB(B1, 0, 1); PG8_STAGE(PG8_SB(0, 0), b2, voffB);
            PG8_BAR; PG8_WAIT_L(0); PG8_MMA(0, 1, At, B1); PG8_BAR;
            PG8_LDA(At, 0, 1); PG8_STAGE(PG8_SA(0, 0), a2, voffA);
            PG8_BAR; PG8_WAIT_L(0); PG8_MMA(1, 0, At, B0); PG8_BAR; PG8_SCHED;
            PG8_STAGE(PG8_SB(0, 1), b2 + hstep, voffB);
            PG8_WAIT_V(6); PG8_BAR; PG8_MMA(1, 1, At, B1); PG8_BAR;
            PG8_LDB(B0, 1, 0); PG8_SCHED; PG8_LDA(At, 1, 0); PG8_STAGE(PG8_SA(0, 1), a2 + hstep, voffA);
            PG8_WAIT_L(8); PG8_BAR; PG8_WAIT_L(0); PG8_MMA(0, 0, At, B0); PG8_BAR; PG8_SCHED;
            PG8_LDB(B1, 1, 1); PG8_STAGE(PG8_SB(1, 0), b3, voffB);
            PG8_BAR; PG8_WAIT_L(0); PG8_MMA(0, 1, At, B1); PG8_BAR;
            PG8_LDA(At, 1, 1); PG8_STAGE(PG8_SA(1, 0), a3, voffA);
            PG8_BAR; PG8_WAIT_L(0); PG8_MMA(1, 0, At, B0); PG8_BAR; PG8_SCHED;
            PG8_STAGE(PG8_SB(1, 1), b3 + hstep, voffB);
            PG8_WAIT_V(6); PG8_BAR; PG8_MMA(1, 1, At, B1); PG8_BAR;
            }
        }
        if constexpr (ALIGN_EPI) { if (wr == 0) PG8_BAR; }
        if constexpr (!Epi::AFTER_DRAIN) { E(acc, cur, wr, wc, fr, fq); S.done(cur); }
        if (!has_next) break;
#pragma unroll
        for (int a = 0; a < 2; ++a)
#pragma unroll
            for (int b = 0; b < 2; ++b)
#pragma unroll
                for (int m = 0; m < 4; ++m)
#pragma unroll
                    for (int n = 0; n < 2; ++n) acc[a][b][m][n] = (f32x4){0.f, 0.f, 0.f, 0.f};
        cur = nxt; cA = nA; cB = nB; ++ui;
        if constexpr (ALIGN_EPI) { if (wr == 1) PG8_BAR; }
    }
    PG8_WAIT_V(0);
    if constexpr (!ALIGN_EPI) { if (wr == 0) PG8_BAR; }
    PG8_BAR;
    if constexpr (Epi::AFTER_DRAIN) { E.fused(acc, cur, wr, wc, fr, fq, lds, wid, lane); S.done(cur); }
#undef PG8_SA
#undef PG8_SB
#undef PG8_STAGE
#undef PG8_LDA
#undef PG8_LDB
#undef PG8_MMA
#undef PG8_WAIT_V
#undef PG8_WAIT_L
#undef PG8_BAR
#undef PG8_SCHED
}
}

__device__ __forceinline__ void phase_gemm_in(const Params& p, int l, unsigned char* lds) {
    const Ids ids = fresh_ids();
    pg8::Gemm g{(const bf16_t*)(p.ws + WS_XB), (const bf16_t*)(p.ws + WS_WTIN) + (size_t)l * ZW * DM, NT, ZW, DM};
    pg8::StaticOrder S; S.init(NT, ZW, gridDim.x, ids.bid);
    if (l > 0) {
        pg8::Unit u;
        bool have = S.next(0, u);
        const f32x4 zz = (f32x4){0.f, 0.f, 0.f, 0.f};
        f32x4 a0 = zz, a1 = zz, a2 = zz, a3 = zz;
        int row = 0;
        if (have && ids.tid < 256) {
            row = u.pm * 256 + ids.tid;
            const f32x4* pp = (const f32x4*)((const float*)(p.ws + WS_ROWP) + (size_t)row * 16);
            a0 = pp[0]; a1 = pp[1]; a2 = pp[2]; a3 = pp[3];
        }
        for (int i = 1; have; ++i) {
            pg8::Unit un;
            const bool hn = S.next(i, un);
            f32x4 n0 = zz, n1 = zz, n2 = zz, n3 = zz;
            int rown = 0;
            if (hn && ids.tid < 256) {
                rown = un.pm * 256 + ids.tid;
                const f32x4* pp = (const f32x4*)((const float*)(p.ws + WS_ROWP) + (size_t)rown * 16);
                n0 = pp[0]; n1 = pp[1]; n2 = pp[2]; n3 = pp[3];
            }
            __builtin_amdgcn_sched_barrier(0);
            if (ids.tid < 256) {
                const float ssum = (((a0.x + a0.y) + (a0.z + a0.w)) + ((a1.x + a1.y) + (a1.z + a1.w))) + (((a2.x + a2.y) + (a2.z + a2.w)) + ((a3.x + a3.y) + (a3.z + a3.w)));
                ((float*)(p.ws + WS_RSTD))[row] = 1.0f / sqrtf(ssum * (1.0f / DM) + EPS);
            }
            a0 = n0; a1 = n1; a2 = n2; a3 = n3; row = rown; have = hn;
        }
        asm volatile("s_waitcnt vmcnt(0)" ::: "memory");
        __syncthreads();
    }
    pg8::EpiZ E{(bf16_t*)(p.ws + WS_Z), ZW, (const float*)(p.ws + WS_RSTD)};
    pg8::gemm_phase<pg8::EpiZ, pg8::StaticOrder, true, true>((PG8_LAS unsigned char*)lds, g, S, E, ids.tid);
}
__device__ __forceinline__ void phase_gemm_out(const Params& p, int l, unsigned char* lds, const float* xin, float* xout) {
    const Ids ids = fresh_ids();
    pg8::Gemm g{(const bf16_t*)(p.ws + WS_Y), (const bf16_t*)(p.ws + WS_WTOUT) + (size_t)l * DM * DM, NT, DM, DM};
    pg8::StaticOrder S; S.init(NT, DM, gridDim.x, ids.bid);
    bf16_t* xb = (bf16_t*)(p.ws + WS_XB); float* rowp = (float*)(p.ws + WS_ROWP);
    if (l + 1 < DEPTH) {
        if (l == 0) { pg8::EpiRes<true, false> E{xin, xout, DM, xb, rowp}; pg8::gemm_phase<pg8::EpiRes<true, false>, pg8::StaticOrder, true, true>((PG8_LAS unsigned char*)lds, g, S, E, ids.tid); }
        else        { pg8::EpiRes<true, true>  E{xin, xout, DM, xb, rowp}; pg8::gemm_phase<pg8::EpiRes<true, true>,  pg8::StaticOrder, true, true>((PG8_LAS unsigned char*)lds, g, S, E, ids.tid); }
    } else {
        if (l == 0) { pg8::EpiRes<false, false> E{xin, xout, DM, xb, rowp}; pg8::gemm_phase<pg8::EpiRes<false, false>, pg8::StaticOrder, true, true>((PG8_LAS unsigned char*)lds, g, S, E, ids.tid); }
        else        { pg8::EpiRes<false, true>  E{xin, xout, DM, xb, rowp}; pg8::gemm_phase<pg8::EpiRes<false, true>,  pg8::StaticOrder, true, true>((PG8_LAS unsigned char*)lds, g, S, E, ids.tid); }
    }
}

__device__ __forceinline__ void qkv_item(const Params& p, int l, int tt, int slot, unsigned char* wlds  , int lane) {
    const bf16_t* z = (const bf16_t*)(p.ws + WS_Z);
    const int t = tt * 64 + lane, b = t / SEQ, s = t % SEQ;
    int col; const float* gp = nullptr;
    if (slot < 8) { col = C_Q + slot * 64; gp = p.q_g + l * 64; }
    else if (slot < 10) { col = C_KS + (slot - 8) * 64; gp = p.k_g + (l * 3 + 1) * 64; }
    else if (slot < 12) { col = C_KW + (slot - 10) * 64; gp = p.k_g + (l * 3 + 2) * 64; }
    else if (slot < 14) { col = C_VS + (slot - 12) * 64; }
    else { col = C_VW + (slot - 14) * 64; }
    const u32x4* zr = (const u32x4*)(z + (size_t)t * ZW + col);
    u32x4 raw[8];
#pragma unroll
    for (int i = 0; i < 8; ++i) raw[i] = zr[i];
    if (slot < 12) {
        float* gl = (float*)(wlds + 9216);
        const float gmine = gp[lane];
        const f32x4* rp = (const f32x4*)((const float*)(p.ws + WS_ROPE) + s * 16);
        const f32x4 c0 = rp[0], c1 = rp[1], s0 = rp[2], s1 = rp[3];
        gl[lane] = gmine;
        LDS_FENCE();
        float ss = 0.f;
#pragma unroll
        for (int i = 0; i < 8; ++i) {
            const unsigned w[4] = {raw[i].x, raw[i].y, raw[i].z, raw[i].w};
#pragma unroll
            for (int k = 0; k < 4; ++k) { const float lo = bflo(w[k]), hi = bfhi(w[k]); ss += lo * lo + hi * hi; }
        }
        const float rinv = (1.0f / sqrtf(ss * (1.0f / 64.0f) + EPS)) * ((slot < 8) ? 0.125f * LOG2E : 1.0f);
        bf16_t* dst;
        if (slot < 8) dst = (bf16_t*)(p.ws + WS_QN) + (size_t)t * 512 + slot * 64;
        else if (slot < 10) dst = (bf16_t*)(p.ws + WS_KS) + ((size_t)(b * 2 + (slot - 8)) * SEQ + s) * 64;
        else dst = (bf16_t*)(p.ws + WS_KW) + ((size_t)(b * 2 + (slot - 10)) * SEQ + s) * 64;
        const bool tiled = (slot == 8 || slot == 9);
        const int kk = s & 63, st = kk >> 5, r = kk & 31, cidx = ((r >> 3) << 2) | (r & 3), T = (r >> 2) & 1;
        bf16_t* tb = (bf16_t*)(p.ws + WS_KS2) + ((size_t)(b * 2 + (slot - 8)) * (SEQ / 64) + (s >> 6)) * 4096;
        auto chunk = [&](int i, float (&v)[8]) {
            const unsigned w[4] = {raw[i].x, raw[i].y, raw[i].z, raw[i].w};
            const f32x4 g0 = *(const f32x4*)(gl + 8 * i), g1 = *(const f32x4*)(gl + 8 * i + 4);
            v[0] = bflo(w[0]) * rinv * g0.x; v[1] = bfhi(w[0]) * rinv * g0.y; v[2] = bflo(w[1]) * rinv * g0.z; v[3] = bfhi(w[1]) * rinv * g0.w;
            v[4] = bflo(w[2]) * rinv * g1.x; v[5] = bfhi(w[2]) * rinv * g1.y; v[6] = bflo(w[3]) * rinv * g1.z; v[7] = bfhi(w[3]) * rinv * g1.w;
        };
        auto emit = [&](int i, const float (&v)[8]) {
            u32x4 o; o.x = pk2(v[0], v[1]); o.y = pk2(v[2], v[3]); o.z = pk2(v[4], v[5]); o.w = pk2(v[6], v[7]);
            ((u32x4*)dst)[i] = o;
            if (tiled) *(u32x4*)(tb + ((((st * 2 + T) * 2 + (i >> 2)) * 64 + (i & 3) * 16 + cidx) * 8)) = o;
        };
        {
            float v0[8], v1[8];
            chunk(0, v0); chunk(1, v1);
            const float cs[8] = {c0.x, c0.y, c0.z, c0.w, c1.x, c1.y, c1.z, c1.w};
            const float sn[8] = {s0.x, s0.y, s0.z, s0.w, s1.x, s1.y, s1.z, s1.w};
#pragma unroll
            for (int i = 0; i < 8; ++i) { const float x1 = v0[i], x2 = v1[i]; v0[i] = x1 * cs[i] - x2 * sn[i]; v1[i] = x2 * cs[i] + x1 * sn[i]; }
            emit(0, v0); emit(1, v1);
        }
#pragma unroll
        for (int i = 2; i < 8; ++i) { float v[8]; chunk(i, v); emit(i, v); }
    } else {
#pragma unroll
        for (int i = 0; i < 8; ++i) *(u32x4*)(wlds + lane * 144 + i * 16) = raw[i];
        LDS_FENCE();
        bf16_t* dstb = (slot < 14) ? (bf16_t*)(p.ws + WS_VST) + ((size_t)(b * 2 + (slot - 12)) * 64) * SEQ
                                   : (bf16_t*)(p.ws + WS_VWT) + ((size_t)(b * 2 + (slot - 14)) * 64) * SEQ;
        const int dr = lane >> 3, c8 = lane & 7, sbase = (tt * 64) % SEQ;
#pragma unroll
        for (int pd = 0; pd < 8; ++pd) {
            const int d = 8 * pd + dr;
            unsigned e[8];
#pragma unroll
            for (int k = 0; k < 8; ++k) e[k] = *(const unsigned short*)(wlds + (8 * c8 + k) * 144 + d * 2);
            u32x4 o; o.x = e[0] | (e[1] << 16); o.y = e[2] | (e[3] << 16); o.z = e[4] | (e[5] << 16); o.w = e[6] | (e[7] << 16);
            *(u32x4*)(dstb + (size_t)d * SEQ + sbase + 8 * c8) = o;
            if (slot < 14) *(u32x4*)((bf16_t*)(p.ws + WS_VST2) + ((size_t)(b * 2 + (slot - 12)) * (SEQ / 64) + (sbase >> 6)) * 4096 + (((c8 >> 2) * 4 + (d >> 4)) * 64 + (c8 & 3) * 16 + (d & 15)) * 8) = o;
        }
        LDS_FENCE();
    }
}

__device__ __forceinline__ void rg_item(const Params& p, int l, int b, int ch, int n, float* xcf, int lane) {
    const bf16_t* z = (const bf16_t*)(p.ws + WS_Z);
    const int fr = lane & 15, quad = lane >> 4;
    const size_t t0 = (size_t)b * SEQ + (size_t)ch * 64;
    {
        const int r = lane >> 3, c8 = lane & 7, cc = n * 64 + c8 * 8;
        float w[4][8], cb[8];
#pragma unroll
        for (int k = 0; k < 4; ++k) {
            const f32x4 a0 = *(const f32x4*)(p.conv_w + (l * 4 + k) * 512 + cc), a1 = *(const f32x4*)(p.conv_w + (l * 4 + k) * 512 + cc + 4);
            w[k][0] = a0.x; w[k][1] = a0.y; w[k][2] = a0.z; w[k][3] = a0.w; w[k][4] = a1.x; w[k][5] = a1.y; w[k][6] = a1.z; w[k][7] = a1.w;
        }
        { const f32x4 a0 = *(const f32x4*)(p.conv_b + l * 512 + cc), a1 = *(const f32x4*)(p.conv_b + l * 512 + cc + 4);
          cb[0] = a0.x; cb[1] = a0.y; cb[2] = a0.z; cb[3] = a0.w; cb[4] = a1.x; cb[5] = a1.y; cb[6] = a1.z; cb[7] = a1.w; }
        const bf16_t* zc = z + t0 * ZW + C_RGX + cc;
        u32x4 xr[11];
#pragma unroll
        for (int k = 0; k < 11; ++k) {
            const int ts = r * 8 - 3 + k;
            const bool ok = (ts >= 0) || (ch > 0);
            xr[k] = ok ? *(const u32x4*)(zc + (ptrdiff_t)ts * ZW) : (u32x4){0u, 0u, 0u, 0u};
        }
        float xf[4][8];
#pragma unroll
        for (int k = 0; k < 3; ++k) {
            const unsigned ww[4] = {xr[k].x, xr[k].y, xr[k].z, xr[k].w};
#pragma unroll
            for (int q = 0; q < 4; ++q) { xf[k][2 * q] = bflo(ww[q]); xf[k][2 * q + 1] = bfhi(ww[q]); }
        }
#pragma unroll
        for (int i = 0; i < 8; ++i) {
            { const unsigned ww[4] = {xr[i + 3].x, xr[i + 3].y, xr[i + 3].z, xr[i + 3].w};
#pragma unroll
              for (int q = 0; q < 4; ++q) { xf[(i + 3) & 3][2 * q] = bflo(ww[q]); xf[(i + 3) & 3][2 * q + 1] = bfhi(ww[q]); } }
            float o[8];
#pragma unroll
            for (int e = 0; e < 8; ++e) o[e] = cb[e];
#pragma unroll
            for (int k = 0; k < 4; ++k)
#pragma unroll
                for (int e = 0; e < 8; ++e) o[e] += w[k][e] * xf[(i + k) & 3][e];
            f32x4* dst = (f32x4*)(xcf + (r * 8 + i) * 68 + c8 * 8);
            dst[0] = (f32x4){o[0], o[1], o[2], o[3]}; dst[1] = (f32x4){o[4], o[5], o[6], o[7]};
        }
    }
    LDS_FENCE();
    bf16x8 af[4][2];
#pragma unroll
    for (int m = 0; m < 4; ++m)
#pragma unroll
        for (int ks = 0; ks < 2; ++ks) {
            const f32x4* src = (const f32x4*)(xcf + (16 * m + fr) * 68 + 32 * ks + 8 * quad);
            const f32x4 a = src[0], c = src[1];
            u32x4 w; w.x = pk2(a.x, a.y); w.y = pk2(a.z, a.w); w.z = pk2(c.x, c.y); w.w = pk2(c.z, c.w);
            af[m][ks] = as_bf16x8(w);
        }
    const bf16_t* wr_ = (const bf16_t*)(p.ws + WS_RGW) + ((size_t)(l * 2 + 0) * 8 + n) * 4096;
    const bf16_t* wi_ = (const bf16_t*)(p.ws + WS_RGW) + ((size_t)(l * 2 + 1) * 8 + n) * 4096;
    bf16x8 brC[2], biC[2]; float brvC, bivC, spvC;
    auto ldw = [&](int nt, bf16x8 (&br)[2], bf16x8 (&bi)[2], float& brv, float& biv, float& spv) {
        const int c = n * 64 + 16 * nt + fr;
#pragma unroll
        for (int ks = 0; ks < 2; ++ks) {
            br[ks] = *(const bf16x8*)(wr_ + (16 * nt + fr) * 64 + 32 * ks + 8 * quad);
            bi[ks] = *(const bf16x8*)(wi_ + (16 * nt + fr) * 64 + 32 * ks + 8 * quad);
        }
        brv = p.rg_br[l * 512 + c]; biv = p.rg_bi[l * 512 + c]; spv = ((const float*)(p.ws + WS_SP))[l * 512 + c];
    };
    ldw(0, brC, biC, brvC, bivC, spvC);
#pragma unroll 1
    for (int nt = 0; nt < 4; ++nt) {
        const int c = n * 64 + 16 * nt + fr;
        bf16x8 brN[2], biN[2]; float brvN, bivN, spvN;
        ldw(nt < 3 ? nt + 1 : 3, brN, biN, brvN, bivN, spvN);
        __builtin_amdgcn_sched_barrier(0);
        f32x4 ar[4], ai[4];
#pragma unroll
        for (int m = 0; m < 4; ++m) { ar[m] = (f32x4){0.f, 0.f, 0.f, 0.f}; ai[m] = (f32x4){0.f, 0.f, 0.f, 0.f}; }
#pragma unroll
        for (int ks = 0; ks < 2; ++ks) {
#pragma unroll
            for (int m = 0; m < 4; ++m) { ar[m] = MFMA16(af[m][ks], brC[ks], ar[m]); ai[m] = MFMA16(af[m][ks], biC[ks], ai[m]); }
        }
        const float brv = brvC, biv = bivC, spv = spvC;
        float Am = 1.f, Hm = 0.f;
#pragma unroll
        for (int m = 0; m < 4; ++m) {
            float Pl[4], hl[4];
            float pa = 1.f, ph = 0.f;
#pragma unroll
            for (int j = 0; j < 4; ++j) {
                const float xcv = xcf[(16 * m + 4 * quad + j) * 68 + 16 * nt + fr];
                const float r = sigmoidf_(ar[m][j] + brv), ig = sigmoidf_(ai[m][j] + biv);
                const float la = -8.0f * r * spv;
                const float a = __expf(la);
                const float em = 1.0f - a * a;
                const float u = __builtin_amdgcn_sqrtf(em) * (ig * xcv);
                pa = pa * a; ph = a * ph + u;
                Pl[j] = pa; hl[j] = ph;
            }
            float Ai = pa, Hi = ph;
            {
                const float a1 = shf(Ai, lane - 16), h1 = shf(Hi, lane - 16);
                if (quad >= 1) { Hi = Ai * h1 + Hi; Ai = a1 * Ai; }
                const float a2 = shf(Ai, lane - 32), h2 = shf(Hi, lane - 32);
                if (quad >= 2) { Hi = Ai * h2 + Hi; Ai = a2 * Ai; }
            }
            float Ae = shf(Ai, lane - 16), He = shf(Hi, lane - 16);
            if (quad == 0) { Ae = 1.f; He = 0.f; }
            const float Pin = Am * Ae, Hin = Ae * Hm + He;
#pragma unroll
            for (int j = 0; j < 4; ++j)
                ((unsigned*)xcf)[(16 * m + 4 * quad + j) * 68 + 16 * nt + fr] = pk2(hl[j] + Pl[j] * Hin, Pl[j] * Pin);
            const float A3 = shf(Ai, 48 + fr), H3 = shf(Hi, 48 + fr);
            Hm = A3 * Hm + H3; Am = Am * A3;
        }
        if (quad == 0) {
            ((float*)(p.ws + WS_SUMH))[((size_t)b * NCH + ch) * 512 + c] = Hm;
            ((float*)(p.ws + WS_SUMP))[((size_t)b * NCH + ch) * 512 + c] = Am;
        }
        brC[0] = brN[0]; brC[1] = brN[1]; biC[0] = biN[0]; biC[1] = biN[1]; brvC = brvN; bivC = bivN; spvC = spvN;
    }
    LDS_FENCE();
    {
        const int r = lane >> 3, c8 = lane & 7, cc = n * 64 + c8 * 8;
        bf16_t* hloc = (bf16_t*)(p.ws + WS_HLOC) + (t0 + r) * 512 + cc;
        bf16_t* pc = (bf16_t*)(p.ws + WS_PC) + (t0 + r) * 512 + cc;
#pragma unroll
        for (int it = 0; it < 8; ++it) {
            const u32x4* src = (const u32x4*)(xcf + (it * 8 + r) * 68 + c8 * 8);
            const u32x4 v0 = src[0], v1 = src[1];
            u32x4 hh, pp;
            hh.x = (v0.x & 0xffffu) | (v0.y << 16); hh.y = (v0.z & 0xffffu) | (v0.w << 16); hh.z = (v1.x & 0xffffu) | (v1.y << 16); hh.w = (v1.z & 0xffffu) | (v1.w << 16);
            pp.x = (v0.x >> 16) | (v0.y & 0xffff0000u); pp.y = (v0.z >> 16) | (v0.w & 0xffff0000u); pp.z = (v1.x >> 16) | (v1.y & 0xffff0000u); pp.w = (v1.z >> 16) | (v1.w & 0xffff0000u);
            *(u32x4*)(hloc + (size_t)it * 8 * 512) = hh;
            *(u32x4*)(pc + (size_t)it * 8 * 512) = pp;
        }
    }
    LDS_FENCE();
}

__device__ __forceinline__ void cmp_block_item(const Params& p, int l, int kv, int bg, int blk32, unsigned char* lds, int tid) {
    const bf16_t* z = (const bf16_t*)(p.ws + WS_Z);
    const int wid = __builtin_amdgcn_readfirstlane(tid >> 6), lane = tid & 63, fr = lane & 15, quad = lane >> 4, b = bg >> 1, g = bg & 1;
    const int i0 = blk32 * 32;
    const bf16_t* w1t = (const bf16_t*)(p.ws + WS_W1T) + (size_t)(l * 2 + kv) * 128 * 2048;
    const int colbase = (kv ? C_VC : C_KC) + g * 64;
    f32x4 acc[8][2];
#pragma unroll
    for (int mt = 0; mt < 8; ++mt) { acc[mt][0] = (f32x4){0.f, 0.f, 0.f, 0.f}; acc[mt][1] = (f32x4){0.f, 0.f, 0.f, 0.f}; }
    const bf16_t* arow = w1t + lane * 8;
    const int blkA = i0 + fr, blkB = i0 + 16 + fr;
    auto ldstep = [&](int kq, bf16x8 (&af)[8], bf16x8 (&bf)[2]) {
        const int kk = wid * 8 + kq;
        const int j = kk >> 1, d = 32 * (kk & 1) + 8 * quad;
        int tokA = 16 * blkA + j, tokB = 16 * blkB + j;
        tokA = tokA < SEQ ? tokA : SEQ - 1; tokB = tokB < SEQ ? tokB : SEQ - 1;
        bf[0] = *(const bf16x8*)(z + ((size_t)b * SEQ + tokA) * ZW + colbase + d);
        bf[1] = *(const bf16x8*)(z + ((size_t)b * SEQ + tokB) * ZW + colbase + d);
#pragma unroll
        for (int mt = 0; mt < 8; ++mt) af[mt] = *(const bf16x8*)(arow + (size_t)(mt * 64 + kk) * 512);
    };
    {
        bf16x8 aC[8], bC[2], aN[8], bN[2];
        ldstep(0, aC, bC);
#pragma unroll
        for (int kq = 0; kq < 8; ++kq) {
            if (kq + 1 < 8) ldstep(kq + 1, aN, bN);
            __builtin_amdgcn_sched_barrier(0);
#pragma unroll
            for (int mt = 0; mt < 8; ++mt) {
                acc[mt][0] = MFMA16(aC[mt], bC[0], acc[mt][0]);
                acc[mt][1] = MFMA16(aC[mt], bC[1], acc[mt][1]);
            }
            __builtin_amdgcn_sched_barrier(0);
#pragma unroll
            for (int mt = 0; mt < 8; ++mt) aC[mt] = aN[mt];
            bC[0] = bN[0]; bC[1] = bN[1];
        }
    }
    __syncthreads();
    f32x4* red = (f32x4*)lds;
#pragma unroll
    for (int mt = 0; mt < 8; ++mt) { red[((wid * 8 + mt) * 2 + 0) * 64 + lane] = acc[mt][0]; red[((wid * 8 + mt) * 2 + 1) * 64 + lane] = acc[mt][1]; }
    __syncthreads();
    {
        const float* b1p = (const float*)(p.ws + WS_B1) + (size_t)(l * 2 + kv) * 16 * 128 + 16 * wid + 4 * quad;
        float b1[4] = {0.f, 0.f, 0.f, 0.f};
#pragma unroll
        for (int ks = 0; ks < 16; ++ks) { const f32x4 v = *(const f32x4*)(b1p + ks * 128); b1[0] += v.x; b1[1] += v.y; b1[2] += v.z; b1[3] += v.w; }
        unsigned char* hid = lds + 131072;
#pragma unroll
        for (int ct = 0; ct < 2; ++ct) {
            f32x4 sum = red[((0 * 8 + wid) * 2 + ct) * 64 + lane];
#pragma unroll
            for (int w2 = 1; w2 < 8; ++w2) sum += red[((w2 * 8 + wid) * 2 + ct) * 64 + lane];
            u32x2 w; w.x = pk2(siluf_(sum.x + b1[0]), siluf_(sum.y + b1[1])); w.y = pk2(siluf_(sum.z + b1[2]), siluf_(sum.w + b1[3]));
            *(u32x2*)(hid + ((((ct * 4 + (wid >> 1)) * 16 + fr) * 4 + quad) * 16) + (wid & 1) * 8) = w;
        }
    }
    __syncthreads();
    const int ct = wid & 1, dt = wid >> 1;
    f32x4 o = (f32x4){0.f, 0.f, 0.f, 0.f};
    {
        const bf16_t* w2p = (const bf16_t*)(p.ws + WS_W2P) + (size_t)(l * 2 + kv) * 8192;
        const unsigned char* hid = lds + 131072;
#pragma unroll
        for (int s = 0; s < 4; ++s) {
            const bf16x8 a = *(const bf16x8*)(w2p + ((((s * 4 + dt) * 16 + fr) * 4 + quad) * 8));
            const bf16x8 hf = *(const bf16x8*)(hid + ((((ct * 4 + s) * 16 + fr) * 4 + quad) * 16));
            o = MFMA16(a, hf, o);
        }
    }
    float* ssb = (float*)lds;
    {
        float ss = o.x * o.x + o.y * o.y + o.z * o.z + o.w * o.w;
        ss += shf(ss, lane ^ 16); ss += shf(ss, lane ^ 32);
        if (quad == 0) ssb[(ct * 4 + dt) * 16 + fr] = ss;
    }
    __syncthreads();
    const int blk = i0 + 16 * ct + fr;
    const bool valid = blk < 511;
    if (kv == 0) {
        const float ss = ssb[(ct * 4 + 0) * 16 + fr] + ssb[(ct * 4 + 1) * 16 + fr] + ssb[(ct * 4 + 2) * 16 + fr] + ssb[(ct * 4 + 3) * 16 + fr];
        const float rinv = 1.0f / sqrtf(ss * (1.0f / 64.0f) + EPS);
        const float* kg = p.k_g + (l * 3 + 0) * 64 + 16 * dt + 4 * quad;
        float v[4] = {o.x * rinv * kg[0], o.y * rinv * kg[1], o.z * rinv * kg[2], o.w * rinv * kg[3]};
        if (dt == 0) {
            const int pos = 16 * (valid ? blk : 0) + 31;
            const float* rp = (const float*)(p.ws + WS_ROPE) + pos * 16;
#pragma unroll
            for (int j = 0; j < 4; ++j) {
                const float own = v[j], oth = shf(own, lane ^ 32);
                const int i = 4 * (quad & 1) + j;
                const float cs = rp[i], sn = rp[8 + i];
                v[j] = (quad < 2) ? (own * cs - oth * sn) : (own * cs + oth * sn);
            }
        }
        u32x2 w; w.x = valid ? pk2(v[0], v[1]) : 0u; w.y = valid ? pk2(v[2], v[3]) : 0u;
        *(u32x2*)((bf16_t*)(p.ws + WS_KC) + ((size_t)bg * 512 + blk) * 64 + 16 * dt + 4 * quad) = w;
    } else {
        bf16_t* dst = (bf16_t*)(p.ws + WS_VCT) + ((size_t)bg * 64 + 16 * dt + 4 * quad) * 512 + blk;
#pragma unroll
        for (int j = 0; j < 4; ++j) dst[(size_t)j * 512] = valid ? f2bf(o[j]) : (bf16_t)0;
    }
}

__device__ __forceinline__ void phase_post(const Params& p, int l, unsigned char* lds) {
    const Ids ids = fresh_ids();
    const int wid = ids.tid >> 6, lane = ids.tid & 63, gw = ids.bid * NWAVE + wid, nw = gridDim.x * NWAVE;
    constexpr int N_CMP = 2 * 8 * 16, N_RG = NB * NCH * 8, N_QKV = (NT / 64) * 16;
    for (int it = ids.bid; it < N_CMP; it += gridDim.x) cmp_block_item(p, l, it & 1, (it >> 1) & 7, it >> 4, lds, ids.tid);
    __syncthreads();
    float* xcf = (float*)(lds + wid * 17408);
    for (int it = gw; it < N_RG + N_QKV; it += nw) {
        if (it < N_RG) { rg_item(p, l, it / (NCH * 8), (it / 8) % NCH, it & 7, xcf, lane); }
        else { const int r = it - N_RG; qkv_item(p, l, r >> 4, r & 15, (unsigned char*)xcf, lane); }
    }
}

constexpr int AT_WAVE_OFF = 66560, AT_WAVE_STRIDE = 4352, NCG = 2;
constexpr int AT_OACC = 0, AT_QS = AT_WAVE_OFF + 8 * AT_WAVE_STRIDE, AT_LACC = AT_QS + 32768, AT_SELM = AT_LACC + 1024, AT_QUEUE = AT_SELM + 1024, AT_END = AT_QUEUE + 16;
__device__ __forceinline__ int kswz(int row) { return ((row >> 1) & 1) | (((row >> 3) & 3) << 1); }

struct AttnCtx {
    int c, quad, lane, wid, tid;
    int tq0;
    int kb0, kb1, vb0, vb1;
    int ksrc, vsrc, vrow;
    bf16x8 qf[NCG][2];
};

#define AT_LAS __attribute__((address_space(3)))
__device__ __forceinline__ void stage_issue(const AttnCtx& a, AT_LAS unsigned char* ldsb, int bufoff, const bf16_t* Kb, const bf16_t* Vt, int NK, int kb) {
    const int wv = __builtin_amdgcn_readfirstlane(a.wid);
    __builtin_amdgcn_global_load_lds((const unsigned*)(Kb + (size_t)kb * 64 + a.ksrc), (AT_LAS unsigned*)(ldsb + bufoff + wv * 1024), 16, 0, 0);
    __builtin_amdgcn_global_load_lds((const unsigned*)(Vt + (size_t)a.vrow * NK + kb + a.vsrc), (AT_LAS unsigned*)(ldsb + bufoff + 8192 + wv * 1024), 16, 0, 0);
}
__device__ __forceinline__ void stage_wait_barrier(int rem) {
    if (rem >= 2) asm volatile("s_waitcnt vmcnt(4)" ::: "memory");
    else if (rem == 1) asm volatile("s_waitcnt vmcnt(2)" ::: "memory");
    else asm volatile("s_waitcnt vmcnt(0)" ::: "memory");
    asm volatile("s_waitcnt lgkmcnt(0)" ::: "memory");
    __builtin_amdgcn_s_barrier();
    asm volatile("" ::: "memory");
}
template <class KBF, class BODY, class NEXT>
__device__ __forceinline__ int tile_stream(const AttnCtx& a, unsigned char* lds, int nt, const bf16_t* Ksrc, const bf16_t* Vsrc, int NK, KBF kbf, BODY body,
                                           int base, bool primed, NEXT next) {
    AT_LAS unsigned char* ldsb = (AT_LAS unsigned char*)lds;
    if (!primed) {
        asm volatile("s_waitcnt lgkmcnt(0)" ::: "memory"); __builtin_amdgcn_s_barrier(); asm volatile("" ::: "memory");
        if (nt > 0) stage_issue(a, ldsb, (base & 1) * 32768, Ksrc, Vsrc, NK, kbf(0));
        if (nt > 1) stage_issue(a, ldsb, (base & 1) * 32768 + 16384, Ksrc, Vsrc, NK, kbf(1));
    }
    const int np = (nt + 1) >> 1;
    for (int P = 0; P < np; ++P) {
        stage_wait_barrier(0);
        const int nb = 2 * P + 2, sb = ((P + 1 + base) & 1) * 32768;
        if (nb < nt) stage_issue(a, ldsb, sb, Ksrc, Vsrc, NK, kbf(nb));
        if (nb + 1 < nt) stage_issue(a, ldsb, sb + 16384, Ksrc, Vsrc, NK, kbf(nb + 1));
        if (P + 1 == np) next(sb);
#pragma unroll 1
        for (int h = 0; h < 2; ++h) {
            const int i = 2 * P + h;
            if (i < nt) body(lds + ((P + base) & 1) * 32768 + h * 16384, i);
        }
    }
    return (base + np) & 1;
}
template <class KBF, class BODY>
__device__ __forceinline__ void tile_stream(const AttnCtx& a, unsigned char* lds, int nt, const bf16_t* Ksrc, const bf16_t* Vsrc, int NK, KBF kbf, BODY body) {
    (void)tile_stream(a, lds, nt, Ksrc, Vsrc, NK, kbf, body, 0, false, [](int) {});
}

template <bool DO_PV, bool IMP, int MM>
__device__ __forceinline__ void tile_step(const AttnCtx& a, const unsigned char* buf, int st, int kabs  ,
                                          unsigned act  , f32x4 (&O)[4][NCG], f32x4 (&L)[NCG],
                                          unsigned selbits  , float mb, float (&imp3)[NCG][3]) {
    bf16x8 kf[2][2];
#pragma unroll
    for (int T = 0; T < 2; ++T) {
        kf[T][0] = *(const bf16x8*)(buf + a.kb0 + st * 4096 + T * 512);
        kf[T][1] = *(const bf16x8*)(buf + a.kb1 + st * 4096 + T * 512);
    }
    bf16x8 vf[4];
    if (DO_PV) {
#pragma unroll
        for (int dt = 0; dt < 4; ++dt) vf[dt] = *(const bf16x8*)(buf + (st ? a.vb1 : a.vb0) + dt * 2048);
    }
    const int k0 = kabs + 8 * a.quad;
    const bf16x8 ones = {(short)0x3F80, (short)0x3F80, (short)0x3F80, (short)0x3F80, (short)0x3F80, (short)0x3F80, (short)0x3F80, (short)0x3F80};
#pragma unroll
    for (int cg = 0; cg < NCG; ++cg) {
        if (!((act >> cg) & 1u)) continue;
        const f32x4 c0 = (f32x4){-mb, -mb, -mb, -mb};
        f32x4 s0 = MFMA16(kf[0][0], a.qf[cg][0], c0);
        f32x4 s1 = MFMA16(kf[1][0], a.qf[cg][0], c0);
        s0 = MFMA16(kf[0][1], a.qf[cg][1], s0);
        s1 = MFMA16(kf[1][1], a.qf[cg][1], s1);
        const int tq = a.tq0 + 4 * cg;
        int hi = tq, lo = -1;
        if (MM == 1) lo = tq - 512;
        if (MM == 4) hi = ((tq + 1) >> 4) - 2;
        const bool sel = (selbits >> cg) & 1u;
        float pv[8];
#pragma unroll
        for (int e = 0; e < 8; ++e) {
            float v = __builtin_amdgcn_exp2f((e < 4) ? s0[e & 3] : s1[e & 3]);
            if (MM == 1) { const int k = k0 + e; v = (k > lo && k <= hi) ? v : 0.f; }
            if (MM == 3 || MM == 4) { const int k = k0 + e; v = (k <= hi) ? v : 0.f; }
            if (MM == 2) v = sel ? v : 0.f;
            pv[e] = v;
        }
        if (IMP) {
            imp3[cg][0] = pv[0] + pv[1] + pv[2] + 0.5f * pv[3];
            imp3[cg][1] = pv[4] + pv[5] + pv[6] + 0.5f * pv[7] + 0.5f * pv[3];
            imp3[cg][2] = 0.5f * pv[7];
        }
        u32x4 w; w.x = pk2(pv[0], pv[1]); w.y = pk2(pv[2], pv[3]); w.z = pk2(pv[4], pv[5]); w.w = pk2(pv[6], pv[7]);
        const bf16x8 pf = as_bf16x8(w);
        L[cg] = MFMA16(ones, pf, L[cg]);
        if (DO_PV) {
#pragma unroll
            for (int dt = 0; dt < 4; ++dt) O[dt][cg] = MFMA16(vf[dt], pf, O[dt][cg]);
        }
    }
}

template <bool DO_PV, bool IMP, int MM, int CGM>
__device__ __forceinline__ void tile_compute(const AttnCtx& a, const bf16x8 (&kf)[2][2][2], const bf16x8 (&vf)[2][4], int kabs  ,
                                             f32x4 (&O)[4][NCG], f32x4 (&L)[NCG], unsigned selbits, float mb, float (&imp3)[2][NCG][3]) {
    const bf16x8 ones = {(short)0x3F80, (short)0x3F80, (short)0x3F80, (short)0x3F80, (short)0x3F80, (short)0x3F80, (short)0x3F80, (short)0x3F80};
    const f32x4 c0 = (f32x4){-mb, -mb, -mb, -mb};
    f32x4 sc[2][NCG][2];
#pragma unroll
    for (int st = 0; st < 2; ++st)
#pragma unroll
        for (int cg = 0; cg < NCG; ++cg) {
            if (!((CGM >> cg) & 1)) continue;
            sc[st][cg][0] = MFMA16(kf[st][0][0], a.qf[cg][0], c0);
            sc[st][cg][1] = MFMA16(kf[st][1][0], a.qf[cg][0], c0);
        }
#pragma unroll
    for (int st = 0; st < 2; ++st)
#pragma unroll
        for (int cg = 0; cg < NCG; ++cg) {
            if (!((CGM >> cg) & 1)) continue;
            sc[st][cg][0] = MFMA16(kf[st][0][1], a.qf[cg][1], sc[st][cg][0]);
            sc[st][cg][1] = MFMA16(kf[st][1][1], a.qf[cg][1], sc[st][cg][1]);
        }
    bf16x8 pf[2][NCG];
#pragma unroll
    for (int st = 0; st < 2; ++st)
#pragma unroll
        for (int cg = 0; cg < NCG; ++cg) {
            if (!((CGM >> cg) & 1)) continue;
            const int k0 = kabs + 32 * st + 8 * a.quad;
            const int tq = a.tq0 + 4 * cg;
            int hi = tq, lo = -1;
            if (MM == 1) lo = tq - 512;
            if (MM == 4) hi = ((tq + 1) >> 4) - 2;
            const bool sel = (selbits >> cg) & 1u;
            float pv[8];
#pragma unroll
            for (int e = 0; e < 8; ++e) {
                float v = __builtin_amdgcn_exp2f(sc[st][cg][e >> 2][e & 3]);
                if (MM == 1) { const int k = k0 + e; v = (k > lo && k <= hi) ? v : 0.f; }
                if (MM == 3 || MM == 4) { const int k = k0 + e; v = (k <= hi) ? v : 0.f; }
                if (MM == 2) v = sel ? v : 0.f;
                pv[e] = v;
            }
            if (IMP) {
                imp3[st][cg][0] = pv[0] + pv[1] + pv[2] + 0.5f * pv[3];
                imp3[st][cg][1] = pv[4] + pv[5] + pv[6] + 0.5f * pv[7] + 0.5f * pv[3];
                imp3[st][cg][2] = 0.5f * pv[7];
            }
            u32x4 w; w.x = pk2(pv[0], pv[1]); w.y = pk2(pv[2], pv[3]); w.z = pk2(pv[4], pv[5]); w.w = pk2(pv[6], pv[7]);
            pf[st][cg] = as_bf16x8(w);
        }
#pragma unroll
    for (int st = 0; st < 2; ++st)
#pragma unroll
        for (int cg = 0; cg < NCG; ++cg) {
            if (!((CGM >> cg) & 1)) continue;
            L[cg] = MFMA16(ones, pf[st][cg], L[cg]);
            if (DO_PV) {
#pragma unroll
                for (int dt = 0; dt < 4; ++dt) O[dt][cg] = MFMA16(vf[st][dt], pf[st][cg], O[dt][cg]);
            }
        }
}

template <bool DO_PV, bool IMP, int MM, int CGM>
__device__ __forceinline__ void tile_full(const AttnCtx& a, const unsigned char* buf, int kabs, f32x4 (&O)[4][NCG], f32x4 (&L)[NCG], unsigned selbits, float mb,
                                          float (&imp3)[2][NCG][3]) {
    bf16x8 kf[2][2][2], vf[2][4];
#pragma unroll
    for (int st = 0; st < 2; ++st)
#pragma unroll
        for (int T = 0; T < 2; ++T) {
            kf[st][T][0] = *(const bf16x8*)(buf + a.kb0 + st * 4096 + T * 512);
            kf[st][T][1] = *(const bf16x8*)(buf + a.kb1 + st * 4096 + T * 512);
        }
    if (DO_PV) {
#pragma unroll
        for (int dt = 0; dt < 4; ++dt) { vf[0][dt] = *(const bf16x8*)(buf + a.vb0 + dt * 2048); vf[1][dt] = *(const bf16x8*)(buf + a.vb1 + dt * 2048); }
    }
    tile_compute<DO_PV, IMP, MM, CGM>(a, kf, vf, kabs, O, L, selbits, mb, imp3);
}
__device__ __forceinline__ void frags_tiled(const AttnCtx& a, const bf16_t* Kt, const bf16_t* Vtt, int tile, bf16x8 (&kf)[2][2][2], bf16x8 (&vf)[2][4]) {
    const bf16_t* kp = Kt + (size_t)tile * 4096 + a.lane * 8;
    const bf16_t* vp = Vtt + (size_t)tile * 4096 + a.lane * 8;
#pragma unroll
    for (int st = 0; st < 2; ++st) {
#pragma unroll
        for (int T = 0; T < 2; ++T) { kf[st][T][0] = *(const bf16x8*)(kp + ((st * 2 + T) * 2 + 0) * 512); kf[st][T][1] = *(const bf16x8*)(kp + ((st * 2 + T) * 2 + 1) * 512); }
#pragma unroll
        for (int dt = 0; dt < 4; ++dt) vf[st][dt] = *(const bf16x8*)(vp + (st * 4 + dt) * 512);
    }
}
__device__ __forceinline__ void frags_global(const AttnCtx& a, const bf16_t* Kb, const bf16_t* Vt, int kb, bf16x8 (&kf)[2][2][2], bf16x8 (&vf)[2][4]) {
#pragma unroll
    for (int st = 0; st < 2; ++st) {
#pragma unroll
        for (int T = 0; T < 2; ++T) {
            const bf16_t* kp = Kb + (size_t)(kb + 32 * st + (a.c >> 2) * 8 + T * 4 + (a.c & 3)) * 64 + 8 * a.quad;
            kf[st][T][0] = *(const bf16x8*)kp; kf[st][T][1] = *(const bf16x8*)(kp + 32);
        }
#pragma unroll
        for (int dt = 0; dt < 4; ++dt) vf[st][dt] = *(const bf16x8*)(Vt + (size_t)(16 * dt + a.c) * SEQ + kb + 32 * st + 8 * a.quad);
    }
}

typedef __fp16 h2v_ __attribute__((ext_vector_type(2)));
__device__ __forceinline__ unsigned pkh2(float lo, float hi) { return __builtin_bit_cast(unsigned, __builtin_amdgcn_cvt_pkrtz(lo, hi)); }
__device__ __forceinline__ float h2lo(unsigned u) { return (float)__builtin_bit_cast(h2v_, u)[0]; }
__device__ __forceinline__ float h2hi(unsigned u) { return (float)__builtin_bit_cast(h2v_, u)[1]; }
__device__ __forceinline__ float dpp_swap1(float v) {
    return __builtin_bit_cast(float, __builtin_amdgcn_mov_dpp(__builtin_bit_cast(int, v), 0xB1, 0xF, 0xF, true));
}
__device__ __forceinline__ float dpp_quad_sum(float v) {
    int x = __builtin_bit_cast(int, v);
    float t = v + __builtin_bit_cast(float, __builtin_amdgcn_mov_dpp(x, 0xB1, 0xF, 0xF, true));
    x = __builtin_bit_cast(int, t);
    return t + __builtin_bit_cast(float, __builtin_amdgcn_mov_dpp(x, 0x4E, 0xF, 0xF, true));
}

__device__ __forceinline__ void attn_block_item(const Params& p, int l, int bg, int qi, unsigned char* lds, int tid, bool primed_c, bool prime_next, int& sbase) {
    asm volatile("" : "+v"(tid));
    const bf16_t* z = (const bf16_t*)(p.ws + WS_Z);
    AttnCtx a;
    a.tid = tid; a.wid = tid >> 6; a.lane = tid & 63; a.c = a.lane & 15; a.quad = a.lane >> 4;
    const int b = bg >> 1, g = bg & 1, s0 = qi * 64, sw = s0 + 8 * a.wid, hd = a.c & 3;
    float* wl = (float*)(lds + AT_WAVE_OFF + a.wid * AT_WAVE_STRIDE);
    unsigned short* selm = (unsigned short*)(lds + AT_SELM) + a.wid * 64;
    a.tq0 = sw + (a.c >> 2);
    {
        const int swc = ((a.c >> 1) & 1) | ((a.c >> 2) << 1);
        const int rowb = (a.c >> 2) * 1024 + (a.c & 3) * 128;
        a.kb0 = rowb + ((a.quad ^ swc) << 4); a.kb1 = rowb + (((4 + a.quad) ^ swc) << 4);
        const int swv = (a.c >> 1) & 7;
        a.vb0 = 8192 + a.c * 128 + ((a.quad ^ swv) << 4); a.vb1 = 8192 + a.c * 128 + (((4 + a.quad) ^ swv) << 4);
        const int row = tid >> 3, cp = tid & 7;
        a.ksrc = row * 64 + ((cp ^ kswz(row)) << 3); a.vrow = row; a.vsrc = (cp ^ ((row >> 1) & 7)) << 3;
        asm volatile("" : "+v"(a.kb0), "+v"(a.kb1), "+v"(a.vb0), "+v"(a.vb1), "+v"(a.ksrc), "+v"(a.vsrc));
    }
#define TROW(cg) ((size_t)b * SEQ + (size_t)(a.tq0 + 4 * (cg)))
#pragma unroll
    for (int cg = 0; cg < NCG; ++cg) {
        const bf16_t* qp = (const bf16_t*)(p.ws + WS_QN) + TROW(cg) * 512 + (4 * g + hd) * 64 + 8 * a.quad;
        a.qf[cg][0] = *(const bf16x8*)qp; a.qf[cg][1] = *(const bf16x8*)(qp + 32);
    }
    float gv[NCG];
#pragma unroll
    for (int cg = 0; cg < NCG; ++cg) gv[cg] = sigmoidf_(bf2f(z[TROW(cg) * ZW + C_BG + 12 * g + 3 * hd + (a.quad < 2 ? a.quad : 2)]));
#define GATE(cg, br) shf(gv[cg], a.c + 16 * (br))
    const float* mbp = (const float*)(p.ws + WS_MB) + l * 4;
    f32x4 O[4][NCG], L[NCG];
    float invl[NCG], imp3[2][NCG][3];
    AT_LAS unsigned char* ldsb = (AT_LAS unsigned char*)lds;
#define ZERO_ACC() { _Pragma("unroll") for (int h_ = 0; h_ < NCG; ++h_) L[h_] = (f32x4){0.f, 0.f, 0.f, 0.f}; \
                     _Pragma("unroll") for (int dt_ = 0; dt_ < 4; ++dt_) _Pragma("unroll") for (int h_ = 0; h_ < NCG; ++h_) O[dt_][h_] = (f32x4){0.f, 0.f, 0.f, 0.f}; }
    {
        const bf16_t* kc = (const bf16_t*)(p.ws + WS_KC) + (size_t)bg * 512 * 64;
        const bf16_t* vct = (const bf16_t*)(p.ws + WS_VCT) + (size_t)bg * 64 * 512;
        const int nmax_b = ((s0 + 64) >> 4) - 1;
        const int nct = (nmax_b + 63) >> 6;
        const int nmax_w = ((sw + 8) >> 4) - 1;
        const int nmin_w = ((sw + 1) >> 4) - 1;
        const float mb_c = mbp[0];
        const float isc = __builtin_amdgcn_exp2f(fminf(floorf(mb_c) - 2.0f, 100.0f));
        unsigned* rawp = (unsigned*)((hd < 2) ? (unsigned char*)wl : lds + AT_QS + a.wid * 4096);
        ZERO_ACC();
        float co_prev[NCG] = {0.f, 0.f};
        (void)tile_stream(a, lds, nct, kc, vct, 512, [](int i) { return i * 64; }, [&](const unsigned char* buf, int i_) {
            const int kb = i_ * 64;
            if (kb < nmax_w) {
                if (kb + 63 >= nmin_w) tile_full<true, true, 4, 3>(a, buf, kb, O, L, 0u, mb_c, imp3);
                else tile_full<true, true, 0, 3>(a, buf, kb, O, L, 0u, mb_c, imp3);
#pragma unroll
                for (int st = 0; st < 2; ++st) {
                    const int j0 = ((kb + 32 * st) >> 2) + 2 * a.quad;
#pragma unroll
                    for (int cg = 0; cg < NCG; ++cg) {
                        float X0 = imp3[st][cg][0], X1 = imp3[st][cg][1];
                        const float co = imp3[st][cg][2];
                        const float send = (a.quad == 3) ? co_prev[cg] : co;
                        X0 += shf(send, (a.lane + 48) & 63);
                        co_prev[cg] = co;
                        X0 *= isc; X1 *= isc;
                        const float Y0 = dpp_swap1(X0), Y1 = dpp_swap1(X1);
                        if (!(hd & 1)) { const int q = 4 * cg + (a.c >> 2); rawp[j0 * 8 + q] = pkh2(X0, Y0); rawp[(j0 + 1) * 8 + q] = pkh2(X1, Y1); }
                    }
                }
            }
        }, sbase, primed_c, [](int) {});
#pragma unroll
        for (int cg = 0; cg < NCG; ++cg) {
            invl[cg] = L[cg].x > 0.f ? 1.0f / L[cg].x : 0.f;
            if (a.quad == 0) wl[1024 + (4 * cg + (a.c >> 2)) * 4 + hd] = invl[cg];
        }
    }
    LDS_FENCE();
    const int bt = s0 >> 6;
    {
        const int q = a.lane & 7, part = a.lane >> 3;
        unsigned mymask = 0u;
        if (bt >= 16) {
            unsigned key[16];
            const unsigned* r01 = (const unsigned*)wl + (16 * part) * 8 + q;
            const unsigned* r23 = (const unsigned*)(lds + AT_QS + a.wid * 4096) + (16 * part) * 8 + q;
            const f32x4 il = *(const f32x4*)(wl + 1024 + q * 4);
            const int ilo = 1 - 16 * part, ihi = bt - 2 - 16 * part, jrev = 127 - 16 * part;
#pragma unroll
            for (int i = 0; i < 16; ++i) {
                const unsigned u0 = r01[i * 8], u1 = r23[i * 8];
                const unsigned bits = __float_as_uint((h2lo(u0) * il.x + h2hi(u0) * il.y) + (h2lo(u1) * il.z + h2hi(u1) * il.w));
                key[i] = (i >= ilo && i <= ihi) ? ((bits & ~127u) | (unsigned)(jrev - i)) : 0u;
            }
            for (int it = 0; it < 13; ++it) {
                unsigned m = 0u;
#pragma unroll
                for (int i = 0; i < 16; ++i) m = key[i] > m ? key[i] : m;
                { const unsigned o = (unsigned)__builtin_amdgcn_update_dpp(0, (int)m, 0x128, 0xF, 0xF, false); m = o > m ? o : m; }
                { const auto r = __builtin_amdgcn_permlane16_swap(m, m, false, false); m = r[0] > r[1] ? r[0] : r[1]; }
                { const auto r = __builtin_amdgcn_permlane32_swap(m, m, false, false); m = r[0] > r[1] ? r[0] : r[1]; }
                const int jsel = 127 - (int)(m & 127u);
                if ((jsel >> 4) == part) mymask |= 1u << (jsel & 15);
#pragma unroll
                for (int i = 0; i < 16; ++i) key[i] = (key[i] == m) ? 0u : key[i];
            }
            if (part == 0) mymask |= 1u;
            if (((bt - 1) >> 4) == part) mymask |= 1u << ((bt - 1) & 15);
            if ((bt >> 4) == part) mymask |= 1u << (bt & 15);
        } else {
            if (part == 0) mymask = (2u << bt) - 1u;
        }
        selm[q * 8 + part] = (unsigned short)mymask;
    }
    LDS_FENCE();
#define PARK_ADDR(cg, dt) ((unsigned char*)wl + (16 * (cg) + a.c) * 128 + (((4 * (dt) + a.quad) ^ (((16 * (cg) + a.c) >> 1) & 7)) << 3))
#pragma unroll
    for (int cg = 0; cg < NCG; ++cg) {
        const float gc = GATE(cg, 0) * invl[cg];
#pragma unroll
        for (int dt = 0; dt < 4; ++dt) {
            u32x2 w; w.x = pk2(gc * O[dt][cg].x, gc * O[dt][cg].y); w.y = pk2(gc * O[dt][cg].z, gc * O[dt][cg].w);
            *(u32x2*)PARK_ADDR(cg, dt) = w;
        }
    }
    const bf16_t* kwb = (const bf16_t*)(p.ws + WS_KW) + (size_t)bg * SEQ * 64;
    const bf16_t* vwt = (const bf16_t*)(p.ws + WS_VWT) + (size_t)bg * 64 * SEQ;
    int t0w = s0 - 511; t0w = t0w < 0 ? 0 : t0w; t0w >>= 6;
    const int t1w = (s0 + 63) >> 6;
    auto prime_window = [&](int sb) {
        stage_issue(a, ldsb, sb, kwb, vwt, SEQ, t0w * 64);
        if (t1w > t0w) stage_issue(a, ldsb, sb + 16384, kwb, vwt, SEQ, (t0w + 1) * 64);
    };
    int wbase = 0;
    {
        const bf16_t* ksb = (const bf16_t*)(p.ws + WS_KS) + (size_t)bg * SEQ * 64;
        const bf16_t* vst = (const bf16_t*)(p.ws + WS_VST) + (size_t)bg * 64 * SEQ;
        const float mb_s = mbp[1];
        const bf16_t* ks2 = (const bf16_t*)(p.ws + WS_KS2) + (size_t)bg * SEQ * 64;
        const bf16_t* vs2 = (const bf16_t*)(p.ws + WS_VST2) + (size_t)bg * 64 * SEQ;
        if (bt < 16) {
            ZERO_ACC();
            wbase = tile_stream(a, lds, bt + 1, ksb, vst, SEQ, [](int i) { return i * 64; }, [&](const unsigned char* buf, int i_) {
                if (i_ == bt) tile_full<true, false, 3, 3>(a, buf, i_ * 64, O, L, 3u, mb_s, imp3);
                else tile_full<true, false, 0, 3>(a, buf, i_ * 64, O, L, 3u, mb_s, imp3);
            }, 0, false, prime_window);
        } else {
            const int wv = __builtin_amdgcn_readfirstlane(a.wid);
            asm volatile("s_waitcnt lgkmcnt(0)" ::: "memory"); __builtin_amdgcn_s_barrier(); asm volatile("" ::: "memory");
#pragma unroll
            for (int cg = 0; cg < NCG; ++cg) {
                const int row = (8 * wv + 4 * cg + (a.c >> 2)) * 4 + hd, qs = ((row >> 1) & 1) | (((row >> 2) & 3) << 1);
                *(bf16x8*)(lds + AT_QS + row * 128 + (((0 + a.quad) ^ qs) << 4)) = a.qf[cg][0];
                *(bf16x8*)(lds + AT_QS + row * 128 + (((4 + a.quad) ^ qs) << 4)) = a.qf[cg][1];
            }
            { u32x4 zz = (u32x4){0u, 0u, 0u, 0u}; asm volatile("" : "+v"(zz));
              for (int i = tid; i < (256 * 65 * 4) / 16; i += NTHR) *(u32x4*)(lds + AT_OACC + i * 16) = zz; }
            if (tid < 256) ((float*)(lds + AT_LACC))[tid] = 0.f;
            if (tid == 0) *(unsigned*)(lds + AT_QUEUE) = 1u;
            asm volatile("s_waitcnt lgkmcnt(0)" ::: "memory"); __builtin_amdgcn_s_barrier(); asm volatile("" ::: "memory");
            {
                const u32x4 mq = *(const u32x4*)(lds + AT_SELM + a.lane * 16);
                const bf16x8 ones = {(short)0x3F00, (short)0x3F00, (short)0x3F00, (short)0x3F00, (short)0x3F00, (short)0x3F00, (short)0x3F00, (short)0x3F00};
                const float cb = 22.0f - mb_s;
                const f32x4 c0 = (f32x4){cb, cb, cb, cb};
                float* oacc = (float*)(lds + AT_OACC);
                float* lacc = (float*)(lds + AT_LACC);
                unsigned* queue = (unsigned*)(lds + AT_QUEUE);
                auto next_blk = [&](unsigned long long& qm) -> int {
                    for (;;) {
                        int j = 0;
                        if (a.lane == 0) j = (int)__hip_atomic_fetch_add(queue, 1u, __ATOMIC_RELAXED, __HIP_MEMORY_SCOPE_WORKGROUP);
                        j = __builtin_amdgcn_readfirstlane(j);
                        if (j > bt - 2) { qm = 0ull; return -1; }
                        const unsigned wsel = (j < 32) ? mq.x : (j < 64) ? mq.y : (j < 96) ? mq.z : mq.w;
                        qm = __ballot((wsel >> (j & 31)) & 1u);
                        if (qm != 0ull) return j;
                    }
                };
                auto groups = [&](const bf16x8 (&kf)[2][2][2], const bf16x8 (&vf)[2][4], unsigned long long qm) {
#pragma unroll 1
                    while (qm != 0ull) {
                        const int q0 = __builtin_ctzll(qm); qm &= qm - 1ull;
                        int q1 = -1, q2 = -1, q3 = -1;
                        if (qm != 0ull) { q1 = __builtin_ctzll(qm); qm &= qm - 1ull; }
                        if (qm != 0ull) { q2 = __builtin_ctzll(qm); qm &= qm - 1ull; }
                        if (qm != 0ull) { q3 = __builtin_ctzll(qm); qm &= qm - 1ull; }
                        const int qi = a.c >> 2;
                        int myq = (qi == 0) ? q0 : (qi == 1) ? q1 : (qi == 2) ? q2 : q3;
                        const bool valid = myq >= 0;
                        myq = valid ? myq : q0;
                        const int row = myq * 4 + hd, qs = ((row >> 1) & 1) | (((row >> 2) & 3) << 1);
                        const unsigned char* qrow = lds + AT_QS + row * 128;
                        const bf16x8 qa = *(const bf16x8*)(qrow + (((0 + a.quad) ^ qs) << 4)), qb = *(const bf16x8*)(qrow + (((4 + a.quad) ^ qs) << 4));
                        f32x4 sa[2][2];
#pragma unroll
                        for (int st = 0; st < 2; ++st)
#pragma unroll
                            for (int T = 0; T < 2; ++T) sa[st][T] = MFMA16(kf[st][T][0], qa, c0);
#pragma unroll
                        for (int st = 0; st < 2; ++st)
#pragma unroll
                            for (int T = 0; T < 2; ++T) sa[st][T] = MFMA16(kf[st][T][1], qb, sa[st][T]);
                        bf16x8 pf[2];
#pragma unroll
                        for (int st = 0; st < 2; ++st) {
                            float pv[8];
#pragma unroll
                            for (int e = 0; e < 8; ++e) pv[e] = __builtin_amdgcn_exp2f(sa[st][e >> 2][e & 3]);
                            u32x4 w; w.x = pk2(pv[0], pv[1]); w.y = pk2(pv[2], pv[3]); w.z = pk2(pv[4], pv[5]); w.w = pk2(pv[6], pv[7]);
                            pf[st] = as_bf16x8(w);
                        }
                        f32x4 Lc = MFMA16(ones, pf[0], ((f32x4){0.f, 0.f, 0.f, 0.f}));
                        Lc = MFMA16(ones, pf[1], Lc);
                        f32x4 Oc[4];
#pragma unroll
                        for (int dt = 0; dt < 4; ++dt) { Oc[dt] = MFMA16(vf[0][dt], pf[0], ((f32x4){0.f, 0.f, 0.f, 0.f})); Oc[dt] = MFMA16(vf[1][dt], pf[1], Oc[dt]); }
                        if (valid) {
                            float* ob = oacc + row * 65 + 4 * a.quad;
#pragma unroll
                            for (int dt = 0; dt < 4; ++dt)
#pragma unroll
                                for (int e = 0; e < 4; ++e) (void)__hip_atomic_fetch_add((int*)(ob + 16 * dt + e), (int)Oc[dt][e], __ATOMIC_RELAXED, __HIP_MEMORY_SCOPE_WORKGROUP);
                            if (a.quad == 0) (void)__hip_atomic_fetch_add((int*)(lacc + row), (int)Lc.x, __ATOMIC_RELAXED, __HIP_MEMORY_SCOPE_WORKGROUP);
                        }
                    }
                };
                bf16x8 kfA[2][2][2], vfA[2][4], kfB[2][2][2], vfB[2][4];
                unsigned long long qmA = 0ull, qmB = 0ull;
                int jA = next_blk(qmA);
                if (jA >= 0) frags_tiled(a, ks2, vs2, jA, kfA, vfA);
#pragma unroll 1
                while (jA >= 0) {
                    const int jB = next_blk(qmB);
                    if (jB >= 0) frags_tiled(a, ks2, vs2, jB, kfB, vfB);
                    groups(kfA, vfA, qmA);
                    if (jB < 0) break;
                    jA = next_blk(qmA);
                    if (jA >= 0) frags_tiled(a, ks2, vs2, jA, kfA, vfA);
                    groups(kfB, vfB, qmB);
                }
            }
            asm volatile("s_waitcnt lgkmcnt(0)" ::: "memory"); __builtin_amdgcn_s_barrier(); asm volatile("" ::: "memory");
            asm volatile("" : "+v"(a.tq0));
#pragma unroll
            for (int cg = 0; cg < NCG; ++cg) {
                const int row = (8 * wv + 4 * cg + (a.c >> 2)) * 4 + hd;
                { const int qs = ((row >> 1) & 1) | (((row >> 2) & 3) << 1);
                  a.qf[cg][0] = *(const bf16x8*)(lds + AT_QS + row * 128 + (((0 + a.quad) ^ qs) << 4));
                  a.qf[cg][1] = *(const bf16x8*)(lds + AT_QS + row * 128 + (((4 + a.quad) ^ qs) << 4)); }
                const int* ob = (const int*)(lds + AT_OACC) + row * 65 + 4 * a.quad;
                const float lv = (float)((const int*)(lds + AT_LACC))[row] * (1.0f / 2097152.0f);
                L[cg] = (f32x4){lv, lv, lv, lv};
#pragma unroll
                for (int dt = 0; dt < 4; ++dt)
#pragma unroll
                    for (int e = 0; e < 4; ++e) O[dt][cg][e] = (float)ob[16 * dt + e] * (1.0f / 4194304.0f);
            }
            wbase = tile_stream(a, lds, 3, ksb, vst, SEQ, [bt](int i) { return ((i == 0) ? 0 : bt - 2 + i) * 64; }, [&](const unsigned char* buf, int i_) {
                if (i_ == 2) tile_full<true, false, 3, 3>(a, buf, bt * 64, O, L, 3u, mb_s, imp3);
                else tile_full<true, false, 0, 3>(a, buf, ((i_ == 0) ? 0 : bt - 1) * 64, O, L, 3u, mb_s, imp3);
            }, 0, false, prime_window);
        }
#pragma unroll
        for (int cg = 0; cg < NCG; ++cg) {
            const float coef = L[cg].x > 0.f ? GATE(cg, 1) / L[cg].x : 0.f;
#pragma unroll
            for (int dt = 0; dt < 4; ++dt) {
                u32x2* pa = (u32x2*)PARK_ADDR(cg, dt);
                const u32x2 o = *pa;
                u32x2 w;
                w.x = pk2(bflo(o.x) + coef * O[dt][cg].x, bfhi(o.x) + coef * O[dt][cg].y);
                w.y = pk2(bflo(o.y) + coef * O[dt][cg].z, bfhi(o.y) + coef * O[dt][cg].w);
                *pa = w;
            }
        }
    }
    {
        const float mb_w = mbp[2];
        ZERO_ACC();
        {
            const int wv = __builtin_amdgcn_readfirstlane(a.wid);
#pragma unroll
            for (int i = 0; i < 4; ++i) {
                const int r = i * 8 + (a.lane >> 3), ch = a.lane & 7;
                const bf16_t* src = z + ((size_t)b * SEQ + sw + (r >> 2)) * ZW + C_NG + (4 * g + (r & 3)) * 64 + ((ch ^ (r & 7)) << 3);
                __builtin_amdgcn_global_load_lds((const unsigned*)src, (AT_LAS unsigned*)(ldsb + AT_QS + wv * 4096 + i * 1024), 16, 0, 0);
            }
        }
        sbase = tile_stream(a, lds, t1w - t0w + 1, kwb, vwt, SEQ, [t0w](int i) { return (t0w + i) * 64; }, [&](const unsigned char* buf, int i_) {
            const int kb = (t0w + i_) * 64;
            if (kb + 63 > sw - 512 && kb <= sw + 7) {
                if ((kb > sw + 7 - 512) && (kb + 63 <= sw)) tile_full<true, false, 0, 3>(a, buf, kb, O, L, 0u, mb_w, imp3);
                else tile_full<true, false, 1, 3>(a, buf, kb, O, L, 0u, mb_w, imp3);
            }
        }, wbase, true, [&](int sb) {
            if (prime_next) {
                const bf16_t* kc = (const bf16_t*)(p.ws + WS_KC) + (size_t)bg * 512 * 64;
                const bf16_t* vct = (const bf16_t*)(p.ws + WS_VCT) + (size_t)bg * 64 * 512;
                stage_issue(a, ldsb, sb, kc, vct, 512, 0);
                stage_issue(a, ldsb, sb + 16384, kc, vct, 512, 64);
            }
        });
        u32x2 gwv[NCG][4];
        asm volatile("" ::: "memory");
#pragma unroll
        for (int cg = 0; cg < NCG; ++cg) {
            const int row = (4 * cg + (a.c >> 2)) * 4 + hd;
            const unsigned char* ngl = lds + AT_QS + a.wid * 4096 + row * 128 + (a.quad & 1) * 8;
#pragma unroll
            for (int dt = 0; dt < 4; ++dt) gwv[cg][dt] = *(const u32x2*)(ngl + (((2 * dt + (a.quad >> 1)) ^ (row & 7)) << 4));
        }
#pragma unroll
        for (int cg = 0; cg < NCG; ++cg) {
            const float coef = L[cg].x > 0.f ? GATE(cg, 2) / L[cg].x : 0.f;
            bf16_t* yo = (bf16_t*)(p.ws + WS_Y) + TROW(cg) * DM + 512 + (4 * g + hd) * 64 + 4 * a.quad;
#pragma unroll
            for (int dt = 0; dt < 4; ++dt) {
                const u32x2 o = *(const u32x2*)PARK_ADDR(cg, dt);
                const u32x2 gw = gwv[cg][dt];
                float r0 = bflo(o.x) + coef * O[dt][cg].x, r1 = bfhi(o.x) + coef * O[dt][cg].y, r2 = bflo(o.y) + coef * O[dt][cg].z, r3 = bfhi(o.y) + coef * O[dt][cg].w;
                r0 *= siluf_(bflo(gw.x)); r1 *= siluf_(bfhi(gw.x)); r2 *= siluf_(bflo(gw.y)); r3 *= siluf_(bfhi(gw.y));
                u32x2 w; w.x = pk2(r0, r1); w.y = pk2(r2, r3);
                *(u32x2*)(yo + 16 * dt) = w;
            }
        }
    }
    LDS_FENCE();
#undef GATE
#undef TROW
#undef ZERO_ACC
#undef PARK_ADDR
}

__device__ __forceinline__ void rgfin_item(const Params& p, int b, int ch, int n, float* wsc  , int lane) {
    const bf16_t* z = (const bf16_t*)(p.ws + WS_Z);
    float hnext;
    {
        const int c = n * 64 + lane;
        const float* sh = (const float*)(p.ws + WS_SUMH) + (size_t)b * NCH * 512 + c;
        const float* sp = (const float*)(p.ws + WS_SUMP) + (size_t)b * NCH * 512 + c;
        float h = 0.f;
        int j = 0;
        for (; j + 32 <= ch; j += 32) {
            float pv[32], hv[32];
#pragma unroll
            for (int u = 0; u < 32; ++u) { pv[u] = sp[(size_t)(j + u) * 512]; hv[u] = sh[(size_t)(j + u) * 512]; }
#pragma unroll
            for (int u = 0; u < 32; ++u) h = pv[u] * h + hv[u];
        }
        {
            float pv[32], hv[32];
#pragma unroll
            for (int u = 0; u < 32; ++u) { const bool ok = j + u < ch; pv[u] = ok ? sp[(size_t)(j + u) * 512] : 1.f; hv[u] = ok ? sh[(size_t)(j + u) * 512] : 0.f; }
#pragma unroll
            for (int u = 0; u < 32; ++u) h = pv[u] * h + hv[u];
        }
        wsc[lane] = h;
        hnext = sp[(size_t)ch * 512] * h + sh[(size_t)ch * 512];
    }
#pragma unroll 1
    for (int half = 0; half < 2; ++half, ++ch) {
    if (half) { wsc[lane] = hnext; }
    LDS_FENCE();
    const int r = lane >> 3, c8 = lane & 7;
    float cr[8];
    { const f32x4 c0 = *(const f32x4*)(wsc + c8 * 8), c1 = *(const f32x4*)(wsc + c8 * 8 + 4); cr[0] = c0.x; cr[1] = c0.y; cr[2] = c0.z; cr[3] = c0.w; cr[4] = c1.x; cr[5] = c1.y; cr[6] = c1.z; cr[7] = c1.w; }
    const size_t t0 = (size_t)b * SEQ + (size_t)ch * 64 + r;
    const int cc = n * 64 + c8 * 8;
    const bf16_t* hl = (const bf16_t*)(p.ws + WS_HLOC) + t0 * 512 + cc;
    const bf16_t* pc = (const bf16_t*)(p.ws + WS_PC) + t0 * 512 + cc;
    const bf16_t* zg = z + t0 * ZW + C_RGG + cc;
    bf16_t* y = (bf16_t*)(p.ws + WS_Y) + t0 * DM + cc;
    u32x4 hwN = *(const u32x4*)hl, pwN = *(const u32x4*)pc, gwN = *(const u32x4*)zg;
#pragma unroll
    for (int it = 0; it < 8; ++it) {
        const u32x4 hw = hwN, pw = pwN, gw = gwN;
        if (it + 1 < 8) {
            hwN = *(const u32x4*)(hl + (size_t)(it + 1) * 8 * 512);
            pwN = *(const u32x4*)(pc + (size_t)(it + 1) * 8 * 512);
            gwN = *(const u32x4*)(zg + (size_t)(it + 1) * 8 * ZW);
        }
        __builtin_amdgcn_sched_barrier(0);
        const unsigned hh[4] = {hw.x, hw.y, hw.z, hw.w}, pp[4] = {pw.x, pw.y, pw.z, pw.w}, gg[4] = {gw.x, gw.y, gw.z, gw.w};
        unsigned o[4];
#pragma unroll
        for (int k = 0; k < 4; ++k) {
            const float v0 = (bflo(hh[k]) + bflo(pp[k]) * cr[2 * k]) * siluf_(bflo(gg[k]));
            const float v1 = (bfhi(hh[k]) + bfhi(pp[k]) * cr[2 * k + 1]) * siluf_(bfhi(gg[k]));
            o[k] = pk2(v0, v1);
        }
        u32x4 ow; ow.x = o[0]; ow.y = o[1]; ow.z = o[2]; ow.w = o[3];
        *(u32x4*)(y + (size_t)it * 8 * DM) = ow;
    }
    LDS_FENCE();
    }
}

__device__ __forceinline__ void phase_attn(const Params& p, int l, unsigned char* lds) {
    const Ids ids = fresh_ids();
    const int wid = ids.tid >> 6, lane = ids.tid & 63, gw = ids.bid * NWAVE + wid, nw = gridDim.x * NWAVE;
    const bool chain = (gridDim.x & 7) == 0;
    int sbase = 0;
    for (int it = ids.bid; it < 1024; it += gridDim.x) {
        const int bg = it & 7, k = it >> 3;
        attn_block_item(p, l, bg, (k < 64) ? 127 - k : k - 64, lds, ids.tid, chain && it != ids.bid, chain && it + (int)gridDim.x < 1024, sbase);
    }
    constexpr int N_RG = NB * NCH * 8;
    float* wsc = (float*)(lds + AT_WAVE_OFF + wid * AT_WAVE_STRIDE);
    for (int r = gw; r < N_RG / 2; r += nw) rgfin_item(p, r / (NCH * 4), 2 * ((r / 8) % (NCH / 2)), r & 7, wsc, lane);
}

constexpr int LDS_BYTES = NWAVE * 17408;
static_assert(LDS_BYTES >= pg8::STAGE_BYTES && LDS_BYTES >= AT_END && 256 * 65 * 4 <= AT_WAVE_OFF, "lds");

__global__ void __launch_bounds__(512) k_mega(Params p) {
    extern __shared__ __attribute__((aligned(16))) unsigned char lds[];
    unsigned* bar = (unsigned*)(p.ws + WS_BAR);
    volatile unsigned* st = (volatile unsigned*)(lds + LDS_BYTES);
    {
        const Ids ids = fresh_ids();
        if (ids.tid == 0) { st[0] = 0u; st[1] = 0u; (void)xb_add(&bar[XB_XCNT(xb_xcc_id())], 1u); }
    }
    __syncthreads();
    phase_prologue(p, lds);
    grid_barrier(bar, st);
#pragma unroll 1
    for (int l = 0; l < DEPTH; ++l) {
        phase_gemm_in(p, l, lds);
        grid_barrier(bar, st);
        phase_post(p, l, lds);
        grid_barrier(bar, st);
        phase_attn(p, l, lds);
        grid_barrier(bar, st);
        phase_gemm_out(p, l, lds, (l == 0) ? p.x : p.out, p.out);
        if (l + 1 < DEPTH) grid_barrier(bar, st);
    }
}

extern "C" void kernel_launch(void* const* d_in, const int* in_sizes, int n_in, void* d_out, int out_size, void* d_ws, size_t ws_size,
                              hipStream_t stream) {
    static int grid = 0;
    if (grid == 0) {
        if (n_in != 19 || ws_size < WS_END) { fprintf(stderr, "kernel_launch: unexpected n_in %d / ws_size %zu (need %zu)\n", n_in, ws_size, (size_t)WS_END); grid = -1; return; }
        (void)hipFuncSetAttribute((const void*)k_mega, hipFuncAttributeMaxDynamicSharedMemorySize, LDS_BYTES + 16);
        int dev = 0, cus = 0, per_cu = 0;
        (void)hipGetDevice(&dev);
        (void)hipDeviceGetAttribute(&cus, hipDeviceAttributeMultiprocessorCount, dev);
        (void)hipOccupancyMaxActiveBlocksPerMultiprocessor(&per_cu, (const void*)k_mega, NTHR, LDS_BYTES + 16);
        if (per_cu < 1) { fprintf(stderr, "kernel_launch: occupancy query says %d blocks per CU\n", per_cu); grid = -1; return; }
        per_cu = 1;
        grid = cus * per_cu;
    }
    if (grid < 0) return;
    Params p{};
    const float** dst = (const float**)&p;
    for (int i = 0; i < 19; ++i) dst[i] = (const float*)d_in[i];
    p.out = (float*)d_out;
    p.ws = (unsigned char*)d_ws;
    (void)hipMemsetAsync((unsigned char*)d_ws + WS_BAR, 0, 16384, stream);
    hipLaunchKernelGGL(k_mega, dim3(grid), dim3(NTHR), LDS_BYTES + 16, stream, p);
}
```

```cpp
#include <hip/hip_runtime.h>
#include <stdint.h>
#include <stdio.h>

typedef unsigned short bf16_t;
typedef short bf16x8 __attribute__((ext_vector_type(8)));
typedef float f32x4 __attribute__((ext_vector_type(4)));
typedef unsigned u32x4 __attribute__((ext_vector_type(4)));
typedef unsigned u32x2 __attribute__((ext_vector_type(2)));

constexpr int NB = 4, SEQ = 8192, NT = NB * SEQ, DM = 1024, DEPTH = 2;
constexpr int NIN = 2840, ZW = 3072;
constexpr int NTHR = 512, NWAVE = 8;
constexpr int C_RGX = 0, C_RGG = 512, C_Q = 1024, C_KC = 1536, C_VC = 1664, C_KS = 1792, C_VS = 1920, C_KW = 2048, C_VW = 2176,
              C_NG = 2304, C_BG = 2816;
constexpr int NCH = SEQ / 64;
constexpr float EPS = 1e-6f;
constexpr float LOG2E = 1.4426950408889634f;

constexpr size_t AL(size_t x) { return (x + 255) & ~(size_t)255; }
constexpr size_t WS_WTIN = 0;
constexpr size_t WS_WTOUT = WS_WTIN + AL((size_t)DEPTH * ZW * DM * 2);
constexpr size_t WS_ROPE = WS_WTOUT + AL((size_t)DEPTH * DM * DM * 2);
constexpr size_t WS_W1T = WS_ROPE + AL((size_t)SEQ * 16 * 4);
constexpr size_t WS_B1 = WS_W1T + AL((size_t)DEPTH * 2 * 128 * 2048 * 2);
constexpr size_t WS_W2P = WS_B1 + AL((size_t)DEPTH * 2 * 16 * 128 * 4);
constexpr size_t WS_RGW = WS_W2P + AL((size_t)DEPTH * 2 * 8192 * 2);
constexpr size_t WS_SP = WS_RGW + AL((size_t)DEPTH * 2 * 8 * 4096 * 2);
constexpr size_t WS_MB = WS_SP + AL((size_t)DEPTH * 512 * 4);
constexpr size_t WS_XB = WS_MB + AL(256);
constexpr size_t WS_RSTD = WS_XB + AL((size_t)NT * DM * 2);
constexpr size_t WS_Z = WS_RSTD + AL((size_t)NT * 4);
constexpr size_t WS_QN = WS_Z + AL((size_t)NT * ZW * 2);
constexpr size_t WS_KS = WS_QN + AL((size_t)NT * 512 * 2);
constexpr size_t WS_KW = WS_KS + AL((size_t)NT * 128 * 2);
constexpr size_t WS_VST = WS_KW + AL((size_t)NT * 128 * 2);
constexpr size_t WS_VWT = WS_VST + AL((size_t)NT * 128 * 2);
constexpr size_t WS_KC = WS_VWT + AL((size_t)NT * 128 * 2);
constexpr size_t WS_VCT = WS_KC + AL((size_t)8 * 512 * 64 * 2);
constexpr size_t WS_HLOC = WS_VCT + AL((size_t)8 * 512 * 64 * 2);
constexpr size_t WS_PC = WS_HLOC + AL((size_t)NT * 512 * 2);
constexpr size_t WS_SUMH = WS_PC + AL((size_t)NT * 512 * 2);
constexpr size_t WS_SUMP = WS_SUMH + AL((size_t)NB * NCH * 512 * 4);
constexpr size_t WS_Y = WS_SUMP + AL((size_t)NB * NCH * 512 * 4);
constexpr size_t WS_BAR = WS_Y + AL((size_t)NT * DM * 2);
constexpr size_t WS_ROWP = WS_BAR + 16384;
constexpr size_t WS_KS2 = WS_ROWP + AL((size_t)NT * 16 * 4);
constexpr size_t WS_VST2 = WS_KS2 + AL((size_t)NT * 128 * 2);
constexpr size_t WS_END = WS_VST2 + AL((size_t)NT * 128 * 2);

struct Params {
    const float *x, *norm_g, *w_in, *conv_w, *conv_b, *rg_wr, *rg_br, *rg_wi, *rg_bi, *rg_lam, *q_g, *k_g, *pe_k, *w1_k, *w2_k, *pe_v,
        *w1_v, *w2_v, *w_out;
    float* out;
    unsigned char* ws;
};

typedef float f32x2v_ __attribute__((ext_vector_type(2)));
typedef __bf16 bf16x2v_ __attribute__((ext_vector_type(2)));
__device__ __forceinline__ unsigned pk2(float lo, float hi) {
    const f32x2v_ v = {lo, hi};
    return __builtin_bit_cast(unsigned, __builtin_convertvector(v, bf16x2v_));
}
__device__ __forceinline__ bf16_t f2bf(float f) { return (bf16_t)(pk2(f, 0.f) & 0xffffu); }
__device__ __forceinline__ float bf2f(unsigned h) { return __uint_as_float(h << 16); }
__device__ __forceinline__ float bflo(unsigned w) { return __uint_as_float(w << 16); }
__device__ __forceinline__ float bfhi(unsigned w) { return __uint_as_float(w & 0xffff0000u); }
__device__ __forceinline__ float sigmoidf_(float v) { return __builtin_amdgcn_rcpf(1.f + __expf(-v)); }
__device__ __forceinline__ float siluf_(float v) { return v * __builtin_amdgcn_rcpf(1.f + __expf(-v)); }
__device__ __forceinline__ bf16x8 as_bf16x8(u32x4 v) { return __builtin_bit_cast(bf16x8, v); }
__device__ __forceinline__ float shf(float v, int src) { return __builtin_bit_cast(float, __builtin_amdgcn_ds_bpermute(src << 2, __builtin_bit_cast(int, v))); }
__device__ __forceinline__ unsigned shu(unsigned v, int src) { return (unsigned)__builtin_amdgcn_ds_bpermute(src << 2, (int)v); }
#define MFMA16(a, b, c) __builtin_amdgcn_mfma_f32_16x16x32_bf16((a), (b), (c), 0, 0, 0)
#define LDS_FENCE() asm volatile("s_waitcnt lgkmcnt(0)" ::: "memory")
struct Ids { int tid, bid; };
__device__ __forceinline__ Ids fresh_ids() {
    Ids i;
    const int lane = __builtin_amdgcn_mbcnt_hi(~0u, __builtin_amdgcn_mbcnt_lo(~0u, 0u));
    int wv = __builtin_amdgcn_readfirstlane(threadIdx.x >> 6);
    i.tid = wv * 64 + lane; i.bid = blockIdx.x;
    asm volatile("" : "+v"(i.tid), "+s"(i.bid));
    return i;
}
#define XB_TMO      128
#define XB_XCNT(j)  (256  + 64 * (j))
#define XB_XSUB(j)  (1280 + 64 * (j))
#define XB_XGEN(j)  (2304 + 64 * (j))
#define XB_TOP      3328
#define XB_TOPGEN   3392
#define XCD_BAR_WORDS 3456
#define XB_SPIN_CAP (1u << 20)
__device__ __forceinline__ unsigned xb_ld(unsigned* p) { return __hip_atomic_load(p, __ATOMIC_RELAXED, __HIP_MEMORY_SCOPE_AGENT); }
__device__ __forceinline__ unsigned xb_add(unsigned* p, unsigned v) { return __hip_atomic_fetch_add(p, v, __ATOMIC_RELAXED, __HIP_MEMORY_SCOPE_AGENT); }
__device__ __forceinline__ unsigned xb_xcc_id() { return (unsigned)__builtin_amdgcn_s_getreg((3 << 11) | 20) & 0xFu; }
#define XB_SPIN(cond, bar) do { unsigned _sp = 0; while (cond) { __builtin_amdgcn_s_sleep(1); \
    if ((++_sp & 255u) == 0u) { if (xb_ld(&(bar)[XB_TMO])) break; if (_sp > XB_SPIN_CAP) { atomicAdd(&(bar)[XB_TMO], 1u); break; } } } } while (0)
__device__ __forceinline__ void xcd_barrier_complete(unsigned* bar, unsigned x, unsigned& nloc, unsigned& nx) {
    const unsigned G = gridDim.x;
    unsigned sum, cnt, mine, sp = 0u;
    for (;;) {
        sum = 0u; cnt = 0u; mine = 0u;
#pragma unroll
        for (unsigned j = 0; j < 16; ++j) { const unsigned c = xb_ld(&bar[XB_XCNT(j)]); sum += c; cnt += (c > 0u) ? 1u : 0u; mine = (j == x) ? c : mine; }
        if (sum == G) break;
        __builtin_amdgcn_s_sleep(1);
        if ((++sp & 255u) == 0u) { if (xb_ld(&bar[XB_TMO])) break; if (sp > XB_SPIN_CAP) { atomicAdd(&bar[XB_TMO], 1u); break; } }
    }
    nloc = mine > 0u ? mine : 1u; nx = cnt > 0u ? cnt : 1u;
}
__device__ __forceinline__ void grid_barrier(unsigned* bar, volatile unsigned* st) {
    asm volatile("s_waitcnt vmcnt(0)" ::: "memory");
    __syncthreads();
    const Ids ids = fresh_ids();
    if (ids.tid == 0) {
        const unsigned x = xb_xcc_id();
        __builtin_amdgcn_s_waitcnt(0);
        unsigned nloc = st[0], nx = st[1];
        if (nloc == 0u) { xcd_barrier_complete(bar, x, nloc, nx); st[0] = nloc; st[1] = nx; }
        const unsigned old = xb_add(&bar[XB_XSUB(x)], 1u);
        const unsigned gen = old / nloc;
        if (old + 1u == (gen + 1u) * nloc) {
            __builtin_amdgcn_fence(__ATOMIC_RELEASE, "agent");
            asm volatile("s_waitcnt vmcnt(0)" ::: "memory");
            const unsigned og = xb_add(&bar[XB_TOP], 1u);
            const unsigned tg = og / nx;
            if (og + 1u == (tg + 1u) * nx) xb_add(&bar[XB_TOPGEN], 1u);
            else XB_SPIN(xb_ld(&bar[XB_TOPGEN]) == tg, bar);
            __builtin_amdgcn_fence(__ATOMIC_ACQUIRE, "agent");
            xb_add(&bar[XB_XGEN(x)], 1u);
            asm volatile("s_waitcnt vmcnt(0)" ::: "memory");
        } else {
            XB_SPIN(xb_ld(&bar[XB_XGEN(x)]) == gen, bar);
            __builtin_amdgcn_fence(__ATOMIC_ACQUIRE, "agent");
            asm volatile("s_waitcnt vmcnt(0)" ::: "memory");
        }
    }
    __syncthreads();
}

template <bool FRAG = false>
__device__ __forceinline__ void transpose_tile(const float* W, int K, int N, const float* kscale, bf16_t* Wt, int k0, int n0, float* t, int lane) {
    const int n = n0 + lane;
    float wv[64];
#pragma unroll
    for (int kk = 0; kk < 64; ++kk) wv[kk] = (n < N) ? W[(size_t)(k0 + kk) * N + n] : 0.f;
    __builtin_amdgcn_sched_barrier(0);
    if (kscale) {
        const float ks = kscale[k0 + lane];
#pragma unroll
        for (int kk = 0; kk < 64; ++kk) wv[kk] *= shf(ks, kk);
    }
#pragma unroll
    for (int kk = 0; kk < 64; ++kk) t[kk * 65 + lane] = wv[kk];
    LDS_FENCE();
    const int r = lane >> 3, c8 = lane & 7;
#pragma unroll
    for (int it = 0; it < 8; ++it) {
        const int nn = it * 8 + r;
        const float* src = t + (c8 * 8) * 65 + nn;
        u32x4 o;
        o.x = pk2(src[0], src[65]); o.y = pk2(src[2 * 65], src[3 * 65]); o.z = pk2(src[4 * 65], src[5 * 65]); o.w = pk2(src[6 * 65], src[7 * 65]);
        if (FRAG) { const int n_ = n0 + nn, k_ = k0 + c8 * 8; *(u32x4*)(Wt + ((size_t)(((n_ >> 4) * (K >> 5) + (k_ >> 5)) * 4 + ((k_ >> 3) & 3)) * 16 + (n_ & 15)) * 8) = o; }
        else *(u32x4*)(Wt + (size_t)(n0 + nn) * K + k0 + c8 * 8) = o;
    }
    LDS_FENCE();
}

__device__ __forceinline__ void xrow_item(const float* xr, bf16_t* xb, float* rstd, int lane) {
    const f32x4* p = (const f32x4*)xr;
    f32x4 v[4];
    float s = 0.f;
#pragma unroll
    for (int j = 0; j < 4; ++j) { v[j] = p[j * 64 + lane]; s += v[j].x * v[j].x + v[j].y * v[j].y + v[j].z * v[j].z + v[j].w * v[j].w; }
#pragma unroll
    for (int o = 1; o < 64; o <<= 1) s += shf(s, lane ^ o);
    u32x2* q = (u32x2*)xb;
#pragma unroll
    for (int j = 0; j < 4; ++j) { u32x2 w; w.x = pk2(v[j].x, v[j].y); w.y = pk2(v[j].z, v[j].w); q[j * 64 + lane] = w; }
    if (lane == 0) *rstd = 1.0f / sqrtf(s * (1.0f / DM) + EPS);
}

__device__ __forceinline__ void phase_xprep(const Params& p, const float* xin) {
    const Ids ids = fresh_ids();
    const int lane = ids.tid & 63, gw = ids.bid * NWAVE + (ids.tid >> 6), nw = gridDim.x * NWAVE;
    bf16_t* xb = (bf16_t*)(p.ws + WS_XB);
    float* rstd = (float*)(p.ws + WS_RSTD);
    for (int r = gw; r < NT; r += nw) xrow_item(xin + (size_t)r * DM, xb + (size_t)r * DM, rstd + r, lane);
}

__device__ __forceinline__ void phase_prologue(const Params& p, unsigned char* lds) {
    const Ids ids = fresh_ids();
    const int gtid = ids.bid * NTHR + ids.tid, gth = gridDim.x * NTHR;
    const int wid = ids.tid >> 6, lane = ids.tid & 63, gw = ids.bid * NWAVE + wid, nw = gridDim.x * NWAVE;
    {
        float* t = (float*)(lds + wid * 17408);
        constexpr int T_IN = 16 * 48, T_OUT = 16 * 16, T_W1 = 32 * 2, T_L = T_IN + T_OUT + 2 * T_W1, N_B1 = DEPTH * 2 * 2 * 16;
        for (int it = gw; it < DEPTH * T_L + N_B1; it += nw) {
            if (it < DEPTH * T_L) {
                const int l = it / T_L; int r = it % T_L;
                if (r < T_IN) { transpose_tile(p.w_in + (size_t)l * DM * NIN, DM, NIN, p.norm_g + l * DM, (bf16_t*)(p.ws + WS_WTIN) + (size_t)l * ZW * DM, (r / 48) * 64, (r % 48) * 64, t, lane); continue; }
                r -= T_IN;
                if (r < T_OUT) { transpose_tile(p.w_out + (size_t)l * DM * DM, DM, DM, nullptr, (bf16_t*)(p.ws + WS_WTOUT) + (size_t)l * DM * DM, (r / 16) * 64, (r % 16) * 64, t, lane); continue; }
                r -= T_OUT;
                const int kv = r / T_W1; r %= T_W1;
                transpose_tile<true>((kv ? p.w1_v : p.w1_k) + (size_t)l * 2048 * 128, 2048, 128, nullptr, (bf16_t*)(p.ws + WS_W1T) + (size_t)(l * 2 + kv) * 128 * 2048, (r / 2) * 64, (r % 2) * 64, t, lane);
            } else {
                const int r = it - DEPTH * T_L, ks = r & 15, hg = (r >> 4) & 1, kv = (r >> 5) & 1, l = r >> 6, hu = hg * 64 + lane;
                const float* pe = (kv ? p.pe_v : p.pe_k) + (size_t)l * 2048 + ks * 128;
                const float* w1 = (kv ? p.w1_v : p.w1_k) + (size_t)l * 2048 * 128 + (size_t)ks * 128 * 128 + hu;
                float sacc = 0.f;
#pragma unroll 32
                for (int k = 0; k < 128; ++k) sacc += pe[k] * w1[(size_t)k * 128];
                ((float*)(p.ws + WS_B1))[((l * 2 + kv) * 16 + ks) * 128 + hu] = sacc;
            }
        }
    }
    float* rope = (float*)(p.ws + WS_ROPE);
    for (int it = gtid; it < SEQ * 8; it += gth) {
        const int pos = it >> 3, i = it & 7;
        const float inv = powf(500000.0f, -(float)i / 8.0f);
        const float ang = (float)pos * inv;
        float sn, cs;
        sincosf(ang, &sn, &cs);
        rope[pos * 16 + i] = cs;
        rope[pos * 16 + 8 + i] = sn;
    }
    bf16_t* w2p = (bf16_t*)(p.ws + WS_W2P);
    for (int it = gtid; it < DEPTH * 2 * 8192; it += gth) {
        const int jj = it & 7, quad = (it >> 3) & 3, r = (it >> 5) & 15, dt = (it >> 9) & 3, s = (it >> 11) & 3, kv = (it >> 13) & 1, l = it >> 14;
        const int hu = 16 * (2 * s + (jj >> 2)) + 4 * quad + (jj & 3), d = 16 * dt + r;
        const float* w2 = (kv ? p.w2_v : p.w2_k) + (size_t)l * 128 * 64;
        w2p[it] = f2bf(w2[hu * 64 + d]);
    }
    bf16_t* rgw = (bf16_t*)(p.ws + WS_RGW);
    for (int it = gtid; it < DEPTH * 2 * 8 * 4096; it += gth) {
        const int in = it & 63, out = (it >> 6) & 63, n = (it >> 12) & 7, gate = (it >> 15) & 1, l = it >> 16;
        const float* w = (gate ? p.rg_wi : p.rg_wr) + (size_t)l * 8 * 4096 + n * 4096;
        rgw[it] = f2bf(w[in * 64 + out]);
    }
    float* sp = (float*)(p.ws + WS_SP);
    for (int it = gtid; it < DEPTH * 512; it += gth) {
        const float v = -p.rg_lam[it];
        sp[it] = (v > 20.f) ? v : log1pf(expf(v));
    }
    if (gw < DEPTH * 4) {
        const int l = gw >> 2, br = gw & 3;
        float mq = fabsf(p.q_g[l * 64 + lane]), mk = (br < 3) ? fabsf(p.k_g[(l * 3 + br) * 64 + lane]) : 0.f;
#pragma unroll
        for (int o = 1; o < 64; o <<= 1) { mq = fmaxf(mq, shf(mq, lane ^ o)); mk = fmaxf(mk, shf(mk, lane ^ o)); }
        if (lane == 0) ((float*)(p.ws + WS_MB))[gw] = 8.0f * mq * mk * LOG2E * 1.0001f;
    }
    phase_xprep(p, p.x);
}

namespace pg8 {
#define PG8_LAS __attribute__((address_space(3)))
constexpr int BM = 256, BK = 64, HALF = 128, HTB = HALF * BK * 2, STAGE_BYTES = 8 * HTB, NXCD = 8, WGM = 8;
__host__ __device__ __forceinline__ int lds_byte(int r, int c) { const int st = (r >> 4) * 2 + (c >> 5), rr = r & 15, cc = c & 31, ob = rr * 64 + cc * 2; return st * 1024 + (ob ^ (((ob >> 9) & 1) << 5)); }
__host__ __device__ __forceinline__ void stage_rc(int b, int& R, int& C) { const int st = b / 1024, sb = b % 1024, swz = sb ^ (((sb >> 9) & 1) << 5); R = (st >> 1) * 16 + swz / 64; C = (st & 1) * 32 + (swz % 64) / 2; }
__host__ __device__ __forceinline__ int perm32(int rho) { const int n = rho >> 4, i = rho & 15; return 8 * (i >> 2) + 4 * n + (i & 3); }
struct Unit { int pm, pn; };
struct Gemm { const bf16_t* A; const bf16_t* Bt; int M, N, K; };
struct StaticOrder {
    int nM, nN, nwg, G, c;
    __host__ __device__ void init(int M, int N, int G_, int c_) { nM = M / BM; nN = N / BM; nwg = nM * nN; G = G_; c = c_; }
    __host__ __device__ bool next(int i, Unit& u) const {
        const long L = (long)i * G + c; if (L >= nwg) return false;
        int wgid = (int)L; { const int q = nwg / NXCD, r = nwg % NXCD, xcd = wgid % NXCD, off = wgid / NXCD; wgid = (xcd < r ? xcd * (q + 1) : r * (q + 1) + (xcd - r) * q) + off; }
        const int nig = WGM * nN, gid = wgid / nig, fm = gid * WGM, gsz = (nM - fm) < WGM ? (nM - fm) : WGM;
        u.pm = fm + ((wgid % nig) % gsz); u.pn = (wgid % nig) / gsz; return true;
    }
    __device__ __forceinline__ void a_ready(const Unit&) const {}
    __device__ __forceinline__ void done(const Unit&) const {}
};
struct EpiZ {
    static constexpr bool PERM = true, AFTER_DRAIN = false;
    bf16_t* O; int ldc; const float* rstd;
    __device__ __forceinline__ void operator()(const f32x4 (&acc)[2][2][4][2], const Unit& u, int wr, int wc, int fr, int fq) const {
        const int row0 = u.pm * BM + wr * 64 + fr, col0 = u.pn * BM + wc * 32 + 8 * fq;
#pragma unroll
        for (int ai = 0; ai < 2; ++ai)
#pragma unroll
            for (int m = 0; m < 4; ++m) {
                const int row = row0 + ai * HALF + m * 16;
                const float rs = rstd[row];
                bf16_t* rowp = O + (size_t)row * ldc + col0;
#pragma unroll
                for (int bj = 0; bj < 2; ++bj) {
                    const f32x4 v0 = acc[ai][bj][m][0] * rs, v1 = acc[ai][bj][m][1] * rs;
                    u32x4 w; w.x = pk2(v0[0], v0[1]); w.y = pk2(v0[2], v0[3]); w.z = pk2(v1[0], v1[1]); w.w = pk2(v1[2], v1[3]);
                    *(u32x4*)(rowp + bj * HALF) = w;
                }
            }
    }
};
template <bool NEXT, bool XBF> struct EpiRes {
    static constexpr bool PERM = false, AFTER_DRAIN = false;
    const float* X; float* C; int ldc; bf16_t* XB; float* rowp;
    __device__ __forceinline__ void operator()(const f32x4 (&acc)[2][2][4][2], const Unit& u, int wr, int wc, int fr, int fq) const {
        const int row0 = u.pm * BM + wr * 64 + fr, col0 = u.pn * BM + wc * 32 + 4 * fq, lane = fq * 16 + fr;
#pragma unroll
        for (int ai = 0; ai < 2; ++ai)
#pragma unroll
            for (int m = 0; m < 4; ++m) {
                const int row = row0 + ai * HALF + m * 16;
                const size_t off = (size_t)row * ldc + col0;
                float ss = 0.f;
#pragma unroll
                for (int bj = 0; bj < 2; ++bj)
#pragma unroll
                    for (int n = 0; n < 2; ++n) {
                        f32x4 xv;
                        if (XBF) { const u32x2 xw = *(const u32x2*)(XB + off + bj * HALF + n * 16); xv = (f32x4){bflo(xw.x), bfhi(xw.x), bflo(xw.y), bfhi(xw.y)}; }
                        else xv = *(const f32x4*)(X + off + bj * HALF + n * 16);
                        const f32x4 v = xv + acc[ai][bj][m][n];
                        if (NEXT) {
                            ss += (v.x * v.x + v.y * v.y) + (v.z * v.z + v.w * v.w);
                            u32x2 w; w.x = pk2(v.x, v.y); w.y = pk2(v.z, v.w);
                            *(u32x2*)(XB + off + bj * HALF + n * 16) = w;
                        } else {
                            *(f32x4*)(C + off + bj * HALF + n * 16) = v;
                        }
                    }
                if (NEXT) {
                    ss += shf(ss, lane ^ 16); ss += shf(ss, lane ^ 32);
                    if (fq == 0) rowp[(size_t)row * 16 + u.pn * 4 + wc] = ss;
                }
            }
    }
};
template <class Epi, class Sched, bool ALIGN_EPI = false, bool SP2 = false>
__device__ __forceinline__ void gemm_phase(PG8_LAS unsigned char* lds, const Gemm g, const Sched& S, const Epi& E, const int tid) {
    const int wid = __builtin_amdgcn_readfirstlane(tid >> 6), lane = tid & 63, wr = wid >> 2, wc = wid & 3, fr = lane & 15, fq = lane >> 4;
    const int K = g.K, nt = K / BK;
    unsigned voffA[2], voffB[2];
#pragma unroll
    for (int i = 0; i < 2; ++i) { int R, C; stage_rc(tid * 16 + i * 8192, R, C); const int Rb = Epi::PERM ? ((R & ~31) + perm32(R & 31)) : R;
        voffA[i] = (unsigned)(R * K + C) * 2u; voffB[i] = (unsigned)(Rb * K + C) * 2u; }
    const size_t kstep = (size_t)(BK * 2);
    const size_t hstep = (size_t)HALF * K * 2;
    const size_t tstep = 2 * hstep;
    const unsigned ldsw = (unsigned)wid * 1024u;
    const int aoff = lds_byte(wr * 64 + fr, fq * 8), boff = lds_byte(wc * 32 + fr, fq * 8);
#define PG8_SA(b, h) (((b) * 2 + (h)) * HTB)
#define PG8_SB(b, h) ((4 + (b) * 2 + (h)) * HTB)
#define PG8_STAGE(bufoff, gbase, voff) do { _Pragma("unroll") for (int _i = 0; _i < 2; ++_i) \
        __builtin_amdgcn_global_load_lds((const unsigned*)((const char*)(gbase) + (voff)[_i]), (PG8_LAS unsigned*)(lds + (bufoff) + ldsw + _i * 8192), 16, 0, 0); } while (0)
#define PG8_LDA(dst, b, h) do { _Pragma("unroll") for (int m = 0; m < 4; ++m) _Pragma("unroll") for (int k = 0; k < 2; ++k) dst[m][k] = *(const PG8_LAS bf16x8*)(lds + PG8_SA(b, h) + aoff + m * 2048 + k * 1024); } while (0)
#define PG8_LDB(dst, b, h) do { _Pragma("unroll") for (int n = 0; n < 2; ++n) _Pragma("unroll") for (int k = 0; k < 2; ++k) dst[n][k] = *(const PG8_LAS bf16x8*)(lds + PG8_SB(b, h) + boff + n * 2048 + k * 1024); } while (0)
#define PG8_MMA(ai, bj, At, Bt) do { __builtin_amdgcn_s_setprio(1); _Pragma("unroll") for (int m = 0; m < 4; ++m) _Pragma("unroll") for (int n = 0; n < 2; ++n) _Pragma("unroll") for (int k = 0; k < 2; ++k) \
        acc[ai][bj][m][n] = __builtin_amdgcn_mfma_f32_16x16x32_bf16(Bt[n][k], At[m][k], acc[ai][bj][m][n], 0, 0, 0); __builtin_amdgcn_s_setprio(0); } while (0)
#define PG8_WAIT_V(n) asm volatile("s_waitcnt vmcnt(" #n ")" ::: "memory")
#define PG8_WAIT_L(n) asm volatile("s_waitcnt lgkmcnt(" #n ")" ::: "memory")
#define PG8_BAR __builtin_amdgcn_s_barrier()
#define PG8_SCHED __builtin_amdgcn_sched_barrier(0)
    Unit cur, nxt; int ui = 0;
    if (!S.next(0, cur)) return;
    f32x4 acc[2][2][4][2];
#pragma unroll
    for (int a = 0; a < 2; ++a)
#pragma unroll
        for (int b = 0; b < 2; ++b)
#pragma unroll
            for (int m = 0; m < 4; ++m)
#pragma unroll
                for (int n = 0; n < 2; ++n) acc[a][b][m][n] = (f32x4){0.f, 0.f, 0.f, 0.f};
    bf16x8 At[4][2], B0[2][2], B1[2][2];
    const char* cA = (const char*)g.A + (size_t)cur.pm * tstep; const char* cB = (const char*)g.Bt + (size_t)cur.pn * tstep;
    S.a_ready(cur);
    if constexpr (SP2) {
        PG8_STAGE(PG8_SB(0, 0), cB, voffB); PG8_STAGE(PG8_SB(0, 1), cB + hstep, voffB); PG8_STAGE(PG8_SA(0, 0), cA, voffA); PG8_STAGE(PG8_SA(0, 1), cA + hstep, voffA);
        if (wr == 1) PG8_BAR;
        PG8_WAIT_V(2); PG8_BAR;
        PG8_STAGE(PG8_SB(1, 0), cB + kstep, voffB); PG8_STAGE(PG8_SA(1, 0), cA + kstep, voffA); PG8_STAGE(PG8_SB(1, 1), cB + hstep + kstep, voffB);
        PG8_WAIT_V(6); PG8_BAR;
    } else {
        PG8_STAGE(PG8_SB(0, 0), cB, voffB); PG8_STAGE(PG8_SA(0, 0), cA, voffA); PG8_STAGE(PG8_SB(0, 1), cB + hstep, voffB); PG8_STAGE(PG8_SA(0, 1), cA + hstep, voffA);
        if (wr == 1) PG8_BAR;
        PG8_WAIT_V(4); PG8_BAR;
        PG8_STAGE(PG8_SB(1, 0), cB + kstep, voffB); PG8_STAGE(PG8_SA(1, 0), cA + kstep, voffA); PG8_STAGE(PG8_SB(1, 1), cB + hstep + kstep, voffB);
        PG8_WAIT_V(6); PG8_BAR;
    }
    for (;;) {
        const bool has_next = S.next(ui + 1, nxt);
        const char* nA = has_next ? (const char*)g.A + (size_t)nxt.pm * tstep : cA; const char* nB = has_next ? (const char*)g.Bt + (size_t)nxt.pn * tstep : cB;
        for (int t = 0; t < nt; t += 2) {
            const bool last = (t == nt - 2);
            const char* a1 = cA + (size_t)(t + 1) * kstep;
            const char* a2 = last ? nA : cA + (size_t)(t + 2) * kstep; const char* b2 = last ? nB : cB + (size_t)(t + 2) * kstep;
            const char* a3 = a2 + kstep; const char* b3 = b2 + kstep;
            if (last && has_next) S.a_ready(nxt);
            if constexpr (SP2) {
            PG8_LDB(B0, 0, 0); PG8_LDB(B1, 0, 1); PG8_SCHED; PG8_LDA(At, 0, 0); PG8_STAGE(PG8_SA(1, 1), a1 + hstep, voffA);
            PG8_WAIT_V(8); PG8_WAIT_L(0); PG8_BAR; PG8_MMA(0, 0, At, B0); PG8_MMA(0, 1, At, B1); PG8_BAR; PG8_SCHED;
            PG8_LDA(At, 0, 1); PG8_STAGE(PG8_SB(0, 0), b2, voffB); PG8_STAGE(PG8_SB(0, 1), b2 + hstep, voffB); PG8_STAGE(PG8_SA(0, 0), a2, voffA);
            PG8_WAIT_V(8); PG8_WAIT_L(0); PG8_BAR; PG8_MMA(1, 0, At, B0); PG8_MMA(1, 1, At, B1); PG8_BAR; PG8_SCHED;
            PG8_LDB(B0, 1, 0); PG8_LDB(B1, 1, 1); PG8_SCHED; PG8_LDA(At, 1, 0); PG8_STAGE(PG8_SA(0, 1), a2 + hstep, voffA);
            PG8_WAIT_V(8); PG8_WAIT_L(0); PG8_BAR; PG8_MMA(0, 0, At, B0); PG8_MMA(0, 1, At, B1); PG8_BAR; PG8_SCHED;
            PG8_LDA(At, 1, 1); PG8_STAGE(PG8_SB(1, 0), b3, voffB); PG8_STAGE(PG8_SB(1, 1), b3 + hstep, voffB); PG8_STAGE(PG8_SA(1, 0), a3, voffA);
            PG8_WAIT_V(8); PG8_WAIT_L(0); PG8_BAR; PG8_MMA(1, 0, At, B0); PG8_MMA(1, 1, At, B1); PG8_BAR; PG8_SCHED;
            } else {
            PG8_LDB(B0, 0, 0); PG8_SCHED; PG8_LDA(At, 0, 0); PG8_STAGE(PG8_SA(1, 1), a1 + hstep, voffA);
            PG8_WAIT_L(8); PG8_BAR; PG8_WAIT_L(0); PG8_MMA(0, 0, At, B0); PG8_BAR; PG8_SCHED;
            PG8_LDB(B1, 0, 1); PG8_STAGE(PG8_SB(0, 0), b2, voffB);
            PG8_BAR; PG8_WAIT_L(0); PG8_MMA(0, 1, At, B1); PG8_BAR;
            PG8_LDA(At, 0, 1); PG8_STAGE(PG8_SA(0, 0), a2, voffA);
            PG8_BAR; PG8_WAIT_L(0); PG8_MMA(1, 0, At, B0); PG8_BAR; PG8_SCHED;
            PG8_STAGE(PG8_SB(0, 1), b2 + hstep, voffB);
            PG8_WAIT_V(6); PG8_BAR; PG8_MMA(1, 1, At, B1); PG8_BAR;
            PG8_LDB(B0, 1, 0); PG8_SCHED; PG8_LDA(At, 1, 0); PG8_STAGE(PG8_SA(0, 1), a2 + hstep, voffA);
            PG8_WAIT_L(8); PG8_BAR; PG8_WAIT_L(0); PG8_MMA(0, 0, At, B0); PG8_BAR; PG8_SCHED;
            PG8_LDB(B1, 1, 1); PG8_STAGE(PG8_SB(1, 0), b3, voffB);
            PG8_BAR; PG8_WAIT_L(0); PG8_MMA(0, 1, At, B1); PG8_BAR;
            PG8_LDA(At, 1, 1); PG8_STAGE(PG8_SA(1, 0), a3, voffA);
            PG8_BAR; PG8_WAIT_L(0); PG8_MMA(1, 0, At, B0); PG8_BAR; PG8_SCHED;
            PG8_STAGE(PG8_SB(1, 1), b3 + hstep, voffB);
            PG8_WAIT_V(6); PG8_BAR; PG8_MMA(1, 1, At, B1); PG8_BAR;
            }
        }
        if constexpr (ALIGN_EPI) { if (wr == 0) PG8_BAR; }
        if constexpr (!Epi::AFTER_DRAIN) { E(acc, cur, wr, wc, fr, fq); S.done(cur); }
        if (!has_next) break;
#pragma unroll
        for (int a = 0; a < 2; ++a)
#pragma unroll
            for (int b = 0; b < 2; ++b)
#pragma unroll
                for (int m = 0; m < 4; ++m)
#pragma unroll
                    for (int n = 0; n < 2; ++n) acc[a][b][m][n] = (f32x4){0.f, 0.f, 0.f, 0.f};
        cur = nxt; cA = nA; cB = nB; ++ui;
        if constexpr (ALIGN_EPI) { if (wr == 1) PG8_BAR; }
    }
    PG8_WAIT_V(0);
    if constexpr (!ALIGN_EPI) { if (wr == 0) PG8_BAR; }
    PG8_BAR;
    if constexpr (Epi::AFTER_DRAIN) { E.fused(acc, cur, wr, wc, fr, fq, lds, wid, lane); S.done(cur); }
#undef PG8_SA
#undef PG8_SB
#undef PG8_STAGE
#undef PG8_LDA
#undef PG8_LDB
#undef PG8_MMA
#undef PG8_WAIT_V
#undef PG8_WAIT_L
#undef PG8_BAR
#undef PG8_SCHED
}
}

__device__ __forceinline__ void phase_gemm_in(const Params& p, int l, unsigned char* lds) {
    const Ids ids = fresh_ids();
    pg8::Gemm g{(const bf16_t*)(p.ws + WS_XB), (const bf16_t*)(p.ws + WS_WTIN) + (size_t)l * ZW * DM, NT, ZW, DM};
    pg8::StaticOrder S; S.init(NT, ZW, gridDim.x, ids.bid);
    if (l > 0) {
        pg8::Unit u;
        bool have = S.next(0, u);
        const f32x4 zz = (f32x4){0.f, 0.f, 0.f, 0.f};
        f32x4 a0 = zz, a1 = zz, a2 = zz, a3 = zz;
        int row = 0;
        if (have && ids.tid < 256) {
            row = u.pm * 256 + ids.tid;
            const f32x4* pp = (const f32x4*)((const float*)(p.ws + WS_ROWP) + (size_t)row * 16);
            a0 = pp[0]; a1 = pp[1]; a2 = pp[2]; a3 = pp[3];
        }
        for (int i = 1; have; ++i) {
            pg8::Unit un;
            const bool hn = S.next(i, un);
            f32x4 n0 = zz, n1 = zz, n2 = zz, n3 = zz;
            int rown = 0;
            if (hn && ids.tid < 256) {
                rown = un.pm * 256 + ids.tid;
                const f32x4* pp = (const f32x4*)((const float*)(p.ws + WS_ROWP) + (size_t)rown * 16);
                n0 = pp[0]; n1 = pp[1]; n2 = pp[2]; n3 = pp[3];
            }
            __builtin_amdgcn_sched_barrier(0);
            if (ids.tid < 256) {
                const float ssum = (((a0.x + a0.y) + (a0.z + a0.w)) + ((a1.x + a1.y) + (a1.z + a1.w))) + (((a2.x + a2.y) + (a2.z + a2.w)) + ((a3.x + a3.y) + (a3.z + a3.w)));
                ((float*)(p.ws + WS_RSTD))[row] = 1.0f / sqrtf(ssum * (1.0f / DM) + EPS);
            }
            a0 = n0; a1 = n1; a2 = n2; a3 = n3; row = rown; have = hn;
        }
        asm volatile("s_waitcnt vmcnt(0)" ::: "memory");
        __syncthreads();
    }
    pg8::EpiZ E{(bf16_t*)(p.ws + WS_Z), ZW, (const float*)(p.ws + WS_RSTD)};
    pg8::gemm_phase<pg8::EpiZ, pg8::StaticOrder, true, true>((PG8_LAS unsigned char*)lds, g, S, E, ids.tid);
}
__device__ __forceinline__ void phase_gemm_out(const Params& p, int l, unsigned char* lds, const float* xin, float* xout) {
    const Ids ids = fresh_ids();
    pg8::Gemm g{(const bf16_t*)(p.ws + WS_Y), (const bf16_t*)(p.ws + WS_WTOUT) + (size_t)l * DM * DM, NT, DM, DM};
    pg8::StaticOrder S; S.init(NT, DM, gridDim.x, ids.bid);
    bf16_t* xb = (bf16_t*)(p.ws + WS_XB); float* rowp = (float*)(p.ws + WS_ROWP);
    if (l + 1 < DEPTH) {
        if (l == 0) { pg8::EpiRes<true, false> E{xin, xout, DM, xb, rowp}; pg8::gemm_phase<pg8::EpiRes<true, false>, pg8::StaticOrder, true, true>((PG8_LAS unsigned char*)lds, g, S, E, ids.tid); }
        else        { pg8::EpiRes<true, true>  E{xin, xout, DM, xb, rowp}; pg8::gemm_phase<pg8::EpiRes<true, true>,  pg8::StaticOrder, true, true>((PG8_LAS unsigned char*)lds, g, S, E, ids.tid); }
    } else {
        if (l == 0) { pg8::EpiRes<false, false> E{xin, xout, DM, xb, rowp}; pg8::gemm_phase<pg8::EpiRes<false, false>, pg8::StaticOrder, true, true>((PG8_LAS unsigned char*)lds, g, S, E, ids.tid); }
        else        { pg8::EpiRes<false, true>  E{xin, xout, DM, xb, rowp}; pg8::gemm_phase<pg8::EpiRes<false, true>,  pg8::StaticOrder, true, true>((PG8_LAS unsigned char*)lds, g, S, E, ids.tid); }
    }
}

__device__ __forceinline__ void qkv_item(const Params& p, int l, int tt, int slot, unsigned char* wlds  , int lane) {
    const bf16_t* z = (const bf16_t*)(p.ws + WS_Z);
    const int t = tt * 64 + lane, b = t / SEQ, s = t % SEQ;
    int col; const float* gp = nullptr;
    if (slot < 8) { col = C_Q + slot * 64; gp = p.q_g + l * 64; }
    else if (slot < 10) { col = C_KS + (slot - 8) * 64; gp = p.k_g + (l * 3 + 1) * 64; }
    else if (slot < 12) { col = C_KW + (slot - 10) * 64; gp = p.k_g + (l * 3 + 2) * 64; }
    else if (slot < 14) { col = C_VS + (slot - 12) * 64; }
    else { col = C_VW + (slot - 14) * 64; }
    const u32x4* zr = (const u32x4*)(z + (size_t)t * ZW + col);
    u32x4 raw[8];
#pragma unroll
    for (int i = 0; i < 8; ++i) raw[i] = zr[i];
    if (slot < 12) {
        float* gl = (float*)(wlds + 9216);
        const float gmine = gp[lane];
        const f32x4* rp = (const f32x4*)((const float*)(p.ws + WS_ROPE) + s * 16);
        const f32x4 c0 = rp[0], c1 = rp[1], s0 = rp[2], s1 = rp[3];
        gl[lane] = gmine;
        LDS_FENCE();
        float ss = 0.f;
#pragma unroll
        for (int i = 0; i < 8; ++i) {
            const unsigned w[4] = {raw[i].x, raw[i].y, raw[i].z, raw[i].w};
#pragma unroll
            for (int k = 0; k < 4; ++k) { const float lo = bflo(w[k]), hi = bfhi(w[k]); ss += lo * lo + hi * hi; }
        }
        const float rinv = (1.0f / sqrtf(ss * (1.0f / 64.0f) + EPS)) * ((slot < 8) ? 0.125f * LOG2E : 1.0f);
        bf16_t* dst;
        if (slot < 8) dst = (bf16_t*)(p.ws + WS_QN) + (size_t)t * 512 + slot * 64;
        else if (slot < 10) dst = (bf16_t*)(p.ws + WS_KS) + ((size_t)(b * 2 + (slot - 8)) * SEQ + s) * 64;
        else dst = (bf16_t*)(p.ws + WS_KW) + ((size_t)(b * 2 + (slot - 10)) * SEQ + s) * 64;
        const bool tiled = (slot == 8 || slot == 9);
        const int kk = s & 63, st = kk >> 5, r = kk & 31, cidx = ((r >> 3) << 2) | (r & 3), T = (r >> 2) & 1;
        bf16_t* tb = (bf16_t*)(p.ws + WS_KS2) + ((size_t)(b * 2 + (slot - 8)) * (SEQ / 64) + (s >> 6)) * 4096;
        auto chunk = [&](int i, float (&v)[8]) {
            const unsigned w[4] = {raw[i].x, raw[i].y, raw[i].z, raw[i].w};
            const f32x4 g0 = *(const f32x4*)(gl + 8 * i), g1 = *(const f32x4*)(gl + 8 * i + 4);
            v[0] = bflo(w[0]) * rinv * g0.x; v[1] = bfhi(w[0]) * rinv * g0.y; v[2] = bflo(w[1]) * rinv * g0.z; v[3] = bfhi(w[1]) * rinv * g0.w;
            v[4] = bflo(w[2]) * rinv * g1.x; v[5] = bfhi(w[2]) * rinv * g1.y; v[6] = bflo(w[3]) * rinv * g1.z; v[7] = bfhi(w[3]) * rinv * g1.w;
        };
        auto emit = [&](int i, const float (&v)[8]) {
            u32x4 o; o.x = pk2(v[0], v[1]); o.y = pk2(v[2], v[3]); o.z = pk2(v[4], v[5]); o.w = pk2(v[6], v[7]);
            ((u32x4*)dst)[i] = o;
            if (tiled) *(u32x4*)(tb + ((((st * 2 + T) * 2 + (i >> 2)) * 64 + (i & 3) * 16 + cidx) * 8)) = o;
        };
        {
            float v0[8], v1[8];
            chunk(0, v0); chunk(1, v1);
            const float cs[8] = {c0.x, c0.y, c0.z, c0.w, c1.x, c1.y, c1.z, c1.w};
            const float sn[8] = {s0.x, s0.y, s0.z, s0.w, s1.x, s1.y, s1.z, s1.w};
#pragma unroll
            for (int i = 0; i < 8; ++i) { const float x1 = v0[i], x2 = v1[i]; v0[i] = x1 * cs[i] - x2 * sn[i]; v1[i] = x2 * cs[i] + x1 * sn[i]; }
            emit(0, v0); emit(1, v1);
        }
#pragma unroll
        for (int i = 2; i < 8; ++i) { float v[8]; chunk(i, v); emit(i, v); }
    } else {
#pragma unroll
        for (int i = 0; i < 8; ++i) *(u32x4*)(wlds + lane * 144 + i * 16) = raw[i];
        LDS_FENCE();
        bf16_t* dstb = (slot < 14) ? (bf16_t*)(p.ws + WS_VST) + ((size_t)(b * 2 + (slot - 12)) * 64) * SEQ
                                   : (bf16_t*)(p.ws + WS_VWT) + ((size_t)(b * 2 + (slot - 14)) * 64) * SEQ;
        const int dr = lane >> 3, c8 = lane & 7, sbase = (tt * 64) % SEQ;
#pragma unroll
        for (int pd = 0; pd < 8; ++pd) {
            const int d = 8 * pd + dr;
            unsigned e[8];
#pragma unroll
            for (int k = 0; k < 8; ++k) e[k] = *(const unsigned short*)(wlds + (8 * c8 + k) * 144 + d * 2);
            u32x4 o; o.x = e[0] | (e[1] << 16); o.y = e[2] | (e[3] << 16); o.z = e[4] | (e[5] << 16); o.w = e[6] | (e[7] << 16);
            *(u32x4*)(dstb + (size_t)d * SEQ + sbase + 8 * c8) = o;
            if (slot < 14) *(u32x4*)((bf16_t*)(p.ws + WS_VST2) + ((size_t)(b * 2 + (slot - 12)) * (SEQ / 64) + (sbase >> 6)) * 4096 + (((c8 >> 2) * 4 + (d >> 4)) * 64 + (c8 & 3) * 16 + (d & 15)) * 8) = o;
        }
        LDS_FENCE();
    }
}

__device__ __forceinline__ void rg_item(const Params& p, int l, int b, int ch, int n, float* xcf, int lane) {
    const bf16_t* z = (const bf16_t*)(p.ws + WS_Z);
    const int fr = lane & 15, quad = lane >> 4;
    const size_t t0 = (size_t)b * SEQ + (size_t)ch * 64;
    {
        const int r = lane >> 3, c8 = lane & 7, cc = n * 64 + c8 * 8;
        float w[4][8], cb[8];
#pragma unroll
        for (int k = 0; k < 4; ++k) {
            const f32x4 a0 = *(const f32x4*)(p.conv_w + (l * 4 + k) * 512 + cc), a1 = *(const f32x4*)(p.conv_w + (l * 4 + k) * 512 + cc + 4);
            w[k][0] = a0.x; w[k][1] = a0.y; w[k][2] = a0.z; w[k][3] = a0.w; w[k][4] = a1.x; w[k][5] = a1.y; w[k][6] = a1.z; w[k][7] = a1.w;
        }
        { const f32x4 a0 = *(const f32x4*)(p.conv_b + l * 512 + cc), a1 = *(const f32x4*)(p.conv_b + l * 512 + cc + 4);
          cb[0] = a0.x; cb[1] = a0.y; cb[2] = a0.z; cb[3] = a0.w; cb[4] = a1.x; cb[5] = a1.y; cb[6] = a1.z; cb[7] = a1.w; }
        const bf16_t* zc = z + t0 * ZW + C_RGX + cc;
        u32x4 xr[11];
#pragma unroll
        for (int k = 0; k < 11; ++k) {
            const int ts = r * 8 - 3 + k;
            const bool ok = (ts >= 0) || (ch > 0);
            xr[k] = ok ? *(const u32x4*)(zc + (ptrdiff_t)ts * ZW) : (u32x4){0u, 0u, 0u, 0u};
        }
        float xf[4][8];
#pragma unroll
        for (int k = 0; k < 3; ++k) {
            const unsigned ww[4] = {xr[k].x, xr[k].y, xr[k].z, xr[k].w};
#pragma unroll
            for (int q = 0; q < 4; ++q) { xf[k][2 * q] = bflo(ww[q]); xf[k][2 * q + 1] = bfhi(ww[q]); }
        }
#pragma unroll
        for (int i = 0; i < 8; ++i) {
            { const unsigned ww[4] = {xr[i + 3].x, xr[i + 3].y, xr[i + 3].z, xr[i + 3].w};
#pragma unroll
              for (int q = 0; q < 4; ++q) { xf[(i + 3) & 3][2 * q] = bflo(ww[q]); xf[(i + 3) & 3][2 * q + 1] = bfhi(ww[q]); } }
            float o[8];
#pragma unroll
            for (int e = 0; e < 8; ++e) o[e] = cb[e];
#pragma unroll
            for (int k = 0; k < 4; ++k)
#pragma unroll
                for (int e = 0; e < 8; ++e) o[e] += w[k][e] * xf[(i + k) & 3][e];
            f32x4* dst = (f32x4*)(xcf + (r * 8 + i) * 68 + c8 * 8);
            dst[0] = (f32x4){o[0], o[1], o[2], o[3]}; dst[1] = (f32x4){o[4], o[5], o[6], o[7]};
        }
    }
    LDS_FENCE();
    bf16x8 af[4][2];
#pragma unroll
    for (int m = 0; m < 4; ++m)
#pragma unroll
        for (int ks = 0; ks < 2; ++ks) {
            const f32x4* src = (const f32x4*)(xcf + (16 * m + fr) * 68 + 32 * ks + 8 * quad);
            const f32x4 a = src[0], c = src[1];
            u32x4 w; w.x = pk2(a.x, a.y); w.y = pk2(a.z, a.w); w.z = pk2(c.x, c.y); w.w = pk2(c.z, c.w);
            af[m][ks] = as_bf16x8(w);
        }
    const bf16_t* wr_ = (const bf16_t*)(p.ws + WS_RGW) + ((size_t)(l * 2 + 0) * 8 + n) * 4096;
    const bf16_t* wi_ = (const bf16_t*)(p.ws + WS_RGW) + ((size_t)(l * 2 + 1) * 8 + n) * 4096;
    bf16x8 brC[2], biC[2]; float brvC, bivC, spvC;
    auto ldw = [&](int nt, bf16x8 (&br)[2], bf16x8 (&bi)[2], float& brv, float& biv, float& spv) {
        const int c = n * 64 + 16 * nt + fr;
#pragma unroll
        for (int ks = 0; ks < 2; ++ks) {
            br[ks] = *(const bf16x8*)(wr_ + (16 * nt + fr) * 64 + 32 * ks + 8 * quad);
            bi[ks] = *(const bf16x8*)(wi_ + (16 * nt + fr) * 64 + 32 * ks + 8 * quad);
        }
        brv = p.rg_br[l * 512 + c]; biv = p.rg_bi[l * 512 + c]; spv = ((const float*)(p.ws + WS_SP))[l * 512 + c];
    };
    ldw(0, brC, biC, brvC, bivC, spvC);
#pragma unroll 1
    for (int nt = 0; nt < 4; ++nt) {
        const int c = n * 64 + 16 * nt + fr;
        bf16x8 brN[2], biN[2]; float brvN, bivN, spvN;
        ldw(nt < 3 ? nt + 1 : 3, brN, biN, brvN, bivN, spvN);
        __builtin_amdgcn_sched_barrier(0);
        f32x4 ar[4], ai[4];
#pragma unroll
        for (int m = 0; m < 4; ++m) { ar[m] = (f32x4){0.f, 0.f, 0.f, 0.f}; ai[m] = (f32x4){0.f, 0.f, 0.f, 0.f}; }
#pragma unroll
        for (int ks = 0; ks < 2; ++ks) {
#pragma unroll
            for (int m = 0; m < 4; ++m) { ar[m] = MFMA16(af[m][ks], brC[ks], ar[m]); ai[m] = MFMA16(af[m][ks], biC[ks], ai[m]); }
        }
        const float brv = brvC, biv = bivC, spv = spvC;
        float Am = 1.f, Hm = 0.f;
#pragma unroll
        for (int m = 0; m < 4; ++m) {
            float Pl[4], hl[4];
            float pa = 1.f, ph = 0.f;
#pragma unroll
            for (int j = 0; j < 4; ++j) {
                const float xcv = xcf[(16 * m + 4 * quad + j) * 68 + 16 * nt + fr];
                const float r = sigmoidf_(ar[m][j] + brv), ig = sigmoidf_(ai[m][j] + biv);
                const float la = -8.0f * r * spv;
                const float a = __expf(la);
                const float em = 1.0f - a * a;
                const float u = __builtin_amdgcn_sqrtf(em) * (ig * xcv);
                pa = pa * a; ph = a * ph + u;
                Pl[j] = pa; hl[j] = ph;
            }
            float Ai = pa, Hi = ph;
            {
                const float a1 = shf(Ai, lane - 16), h1 = shf(Hi, lane - 16);
                if (quad >= 1) { Hi = Ai * h1 + Hi; Ai = a1 * Ai; }
                const float a2 = shf(Ai, lane - 32), h2 = shf(Hi, lane - 32);
                if (quad >= 2) { Hi = Ai * h2 + Hi; Ai = a2 * Ai; }
            }
            float Ae = shf(Ai, lane - 16), He = shf(Hi, lane - 16);
            if (quad == 0) { Ae = 1.f; He = 0.f; }
            const float Pin = Am * Ae, Hin = Ae * Hm + He;
#pragma unroll
            for (int j = 0; j < 4; ++j)
                ((unsigned*)xcf)[(16 * m + 4 * quad + j) * 68 + 16 * nt + fr] = pk2(hl[j] + Pl[j] * Hin, Pl[j] * Pin);
            const float A3 = shf(Ai, 48 + fr), H3 = shf(Hi, 48 + fr);
            Hm = A3 * Hm + H3; Am = Am * A3;
        }
        if (quad == 0) {
            ((float*)(p.ws + WS_SUMH))[((size_t)b * NCH + ch) * 512 + c] = Hm;
            ((float*)(p.ws + WS_SUMP))[((size_t)b * NCH + ch) * 512 + c] = Am;
        }
        brC[0] = brN[0]; brC[1] = brN[1]; biC[0] = biN[0]; biC[1] = biN[1]; brvC = brvN; bivC = bivN; spvC = spvN;
    }
    LDS_FENCE();
    {
        const int r = lane >> 3, c8 = lane & 7, cc = n * 64 + c8 * 8;
        bf16_t* hloc = (bf16_t*)(p.ws + WS_HLOC) + (t0 + r) * 512 + cc;
        bf16_t* pc = (bf16_t*)(p.ws + WS_PC) + (t0 + r) * 512 + cc;
#pragma unroll
        for (int it = 0; it < 8; ++it) {
            const u32x4* src = (const u32x4*)(xcf + (it * 8 + r) * 68 + c8 * 8);
            const u32x4 v0 = src[0], v1 = src[1];
            u32x4 hh, pp;
            hh.x = (v0.x & 0xffffu) | (v0.y << 16); hh.y = (v0.z & 0xffffu) | (v0.w << 16); hh.z = (v1.x & 0xffffu) | (v1.y << 16); hh.w = (v1.z & 0xffffu) | (v1.w << 16);
            pp.x = (v0.x >> 16) | (v0.y & 0xffff0000u); pp.y = (v0.z >> 16) | (v0.w & 0xffff0000u); pp.z = (v1.x >> 16) | (v1.y & 0xffff0000u); pp.w = (v1.z >> 16) | (v1.w & 0xffff0000u);
            *(u32x4*)(hloc + (size_t)it * 8 * 512) = hh;
            *(u32x4*)(pc + (size_t)it * 8 * 512) = pp;
        }
    }
    LDS_FENCE();
}

__device__ __forceinline__ void cmp_block_item(const Params& p, int l, int kv, int bg, int blk32, unsigned char* lds, int tid) {
    const bf16_t* z = (const bf16_t*)(p.ws + WS_Z);
    const int wid = __builtin_amdgcn_readfirstlane(tid >> 6), lane = tid & 63, fr = lane & 15, quad = lane >> 4, b = bg >> 1, g = bg & 1;
    const int i0 = blk32 * 32;
    const bf16_t* w1t = (const bf16_t*)(p.ws + WS_W1T) + (size_t)(l * 2 + kv) * 128 * 2048;
    const int colbase = (kv ? C_VC : C_KC) + g * 64;
    f32x4 acc[8][2];
#pragma unroll
    for (int mt = 0; mt < 8; ++mt) { acc[mt][0] = (f32x4){0.f, 0.f, 0.f, 0.f}; acc[mt][1] = (f32x4){0.f, 0.f, 0.f, 0.f}; }
    const bf16_t* arow = w1t + lane * 8;
    const int blkA = i0 + fr, blkB = i0 + 16 + fr;
    auto ldstep = [&](int kq, bf16x8 (&af)[8], bf16x8 (&bf)[2]) {
        const int kk = wid * 8 + kq;
        const int j = kk >> 1, d = 32 * (kk & 1) + 8 * quad;
        int tokA = 16 * blkA + j, tokB = 16 * blkB + j;
        tokA = tokA < SEQ ? tokA : SEQ - 1; tokB = tokB < SEQ ? tokB : SEQ - 1;
        bf[0] = *(const bf16x8*)(z + ((size_t)b * SEQ + tokA) * ZW + colbase + d);
        bf[1] = *(const bf16x8*)(z + ((size_t)b * SEQ + tokB) * ZW + colbase + d);
#pragma unroll
        for (int mt = 0; mt < 8; ++mt) af[mt] = *(const bf16x8*)(arow + (size_t)(mt * 64 + kk) * 512);
    };
    {
        bf16x8 aC[8], bC[2], aN[8], bN[2];
        ldstep(0, aC, bC);
#pragma unroll
        for (int kq = 0; kq < 8; ++kq) {
            if (kq + 1 < 8) ldstep(kq + 1, aN, bN);
            __builtin_amdgcn_sched_barrier(0);
#pragma unroll
            for (int mt = 0; mt < 8; ++mt) {
                acc[mt][0] = MFMA16(aC[mt], bC[0], acc[mt][0]);
                acc[mt][1] = MFMA16(aC[mt], bC[1], acc[mt][1]);
            }
            __builtin_amdgcn_sched_barrier(0);
#pragma unroll
            for (int mt = 0; mt < 8; ++mt) aC[mt] = aN[mt];
            bC[0] = bN[0]; bC[1] = bN[1];
        }
    }
    __syncthreads();
    f32x4* red = (f32x4*)lds;
#pragma unroll
    for (int mt = 0; mt < 8; ++mt) { red[((wid * 8 + mt) * 2 + 0) * 64 + lane] = acc[mt][0]; red[((wid * 8 + mt) * 2 + 1) * 64 + lane] = acc[mt][1]; }
    __syncthreads();
    {
        const float* b1p = (const float*)(p.ws + WS_B1) + (size_t)(l * 2 + kv) * 16 * 128 + 16 * wid + 4 * quad;
        float b1[4] = {0.f, 0.f, 0.f, 0.f};
#pragma unroll
        for (int ks = 0; ks < 16; ++ks) { const f32x4 v = *(const f32x4*)(b1p + ks * 128); b1[0] += v.x; b1[1] += v.y; b1[2] += v.z; b1[3] += v.w; }
        unsigned char* hid = lds + 131072;
#pragma unroll
        for (int ct = 0; ct < 2; ++ct) {
            f32x4 sum = red[((0 * 8 + wid) * 2 + ct) * 64 + lane];
#pragma unroll
            for (int w2 = 1; w2 < 8; ++w2) sum += red[((w2 * 8 + wid) * 2 + ct) * 64 + lane];
            u32x2 w; w.x = pk2(siluf_(sum.x + b1[0]), siluf_(sum.y + b1[1])); w.y = pk2(siluf_(sum.z + b1[2]), siluf_(sum.w + b1[3]));
            *(u32x2*)(hid + ((((ct * 4 + (wid >> 1)) * 16 + fr) * 4 + quad) * 16) + (wid & 1) * 8) = w;
        }
    }
    __syncthreads();
    const int ct = wid & 1, dt = wid >> 1;
    f32x4 o = (f32x4){0.f, 0.f, 0.f, 0.f};
    {
        const bf16_t* w2p = (const bf16_t*)(p.ws + WS_W2P) + (size_t)(l * 2 + kv) * 8192;
        const unsigned char* hid = lds + 131072;
#pragma unroll
        for (int s = 0; s < 4; ++s) {
            const bf16x8 a = *(const bf16x8*)(w2p + ((((s * 4 + dt) * 16 + fr) * 4 + quad) * 8));
            const bf16x8 hf = *(const bf16x8*)(hid + ((((ct * 4 + s) * 16 + fr) * 4 + quad) * 16));
            o = MFMA16(a, hf, o);
        }
    }
    float* ssb = (float*)lds;
    {
        float ss = o.x * o.x + o.y * o.y + o.z * o.z + o.w * o.w;
        ss += shf(ss, lane ^ 16); ss += shf(ss, lane ^ 32);
        if (quad == 0) ssb[(ct * 4 + dt) * 16 + fr] = ss;
    }
    __syncthreads();
    const int blk = i0 + 16 * ct + fr;
    const bool valid = blk < 511;
    if (kv == 0) {
        const float ss = ssb[(ct * 4 + 0) * 16 + fr] + ssb[(ct * 4 + 1) * 16 + fr] + ssb[(ct * 4 + 2) * 16 + fr] + ssb[(ct * 4 + 3) * 16 + fr];
        const float rinv = 1.0f / sqrtf(ss * (1.0f / 64.0f) + EPS);
        const float* kg = p.k_g + (l * 3 + 0) * 64 + 16 * dt + 4 * quad;
        float v[4] = {o.x * rinv * kg[0], o.y * rinv * kg[1], o.z * rinv * kg[2], o.w * rinv * kg[3]};
        if (dt == 0) {
            const int pos = 16 * (valid ? blk : 0) + 31;
            const float* rp = (const float*)(p.ws + WS_ROPE) + pos * 16;
#pragma unroll
            for (int j = 0; j < 4; ++j) {
                const float own = v[j], oth = shf(own, lane ^ 32);
                const int i = 4 * (quad & 1) + j;
                const float cs = rp[i], sn = rp[8 + i];
                v[j] = (quad < 2) ? (own * cs - oth * sn) : (own * cs + oth * sn);
            }
        }
        u32x2 w; w.x = valid ? pk2(v[0], v[1]) : 0u; w.y = valid ? pk2(v[2], v[3]) : 0u;
        *(u32x2*)((bf16_t*)(p.ws + WS_KC) + ((size_t)bg * 512 + blk) * 64 + 16 * dt + 4 * quad) = w;
    } else {
        bf16_t* dst = (bf16_t*)(p.ws + WS_VCT) + ((size_t)bg * 64 + 16 * dt + 4 * quad) * 512 + blk;
#pragma unroll
        for (int j = 0; j < 4; ++j) dst[(size_t)j * 512] = valid ? f2bf(o[j]) : (bf16_t)0;
    }
}

__device__ __forceinline__ void phase_post(const Params& p, int l, unsigned char* lds) {
    const Ids ids = fresh_ids();
    const int wid = ids.tid >> 6, lane = ids.tid & 63, gw = ids.bid * NWAVE + wid, nw = gridDim.x * NWAVE;
    constexpr int N_CMP = 2 * 8 * 16, N_RG = NB * NCH * 8, N_QKV = (NT / 64) * 16;
    for (int it = ids.bid; it < N_CMP; it += gridDim.x) cmp_block_item(p, l, it & 1, (it >> 1) & 7, it >> 4, lds, ids.tid);
    __syncthreads();
    float* xcf = (float*)(lds + wid * 17408);
    for (int it = gw; it < N_RG + N_QKV; it += nw) {
        if (it < N_RG) { rg_item(p, l, it / (NCH * 8), (it / 8) % NCH, it & 7, xcf, lane); }
        else { const int r = it - N_RG; qkv_item(p, l, r >> 4, r & 15, (unsigned char*)xcf, lane); }
    }
}

constexpr int AT_WAVE_OFF = 66560, AT_WAVE_STRIDE = 4352, NCG = 2;
constexpr int AT_OACC = 0, AT_QS = AT_WAVE_OFF + 8 * AT_WAVE_STRIDE, AT_LACC = AT_QS + 32768, AT_SELM = AT_LACC + 1024, AT_QUEUE = AT_SELM + 1024, AT_END = AT_QUEUE + 16;
__device__ __forceinline__ int kswz(int row) { return ((row >> 1) & 1) | (((row >> 3) & 3) << 1); }

struct AttnCtx {
    int c, quad, lane, wid, tid;
    int tq0;
    int kb0, kb1, vb0, vb1;
    int ksrc, vsrc, vrow;
    bf16x8 qf[NCG][2];
};

#define AT_LAS __attribute__((address_space(3)))
__device__ __forceinline__ void stage_issue(const AttnCtx& a, AT_LAS unsigned char* ldsb, int bufoff, const bf16_t* Kb, const bf16_t* Vt, int NK, int kb) {
    const int wv = __builtin_amdgcn_readfirstlane(a.wid);
    __builtin_amdgcn_global_load_lds((const unsigned*)(Kb + (size_t)kb * 64 + a.ksrc), (AT_LAS unsigned*)(ldsb + bufoff + wv * 1024), 16, 0, 0);
    __builtin_amdgcn_global_load_lds((const unsigned*)(Vt + (size_t)a.vrow * NK + kb + a.vsrc), (AT_LAS unsigned*)(ldsb + bufoff + 8192 + wv * 1024), 16, 0, 0);
}
__device__ __forceinline__ void stage_wait_barrier(int rem) {
    if (rem >= 2) asm volatile("s_waitcnt vmcnt(4)" ::: "memory");
    else if (rem == 1) asm volatile("s_waitcnt vmcnt(2)" ::: "memory");
    else asm volatile("s_waitcnt vmcnt(0)" ::: "memory");
    asm volatile("s_waitcnt lgkmcnt(0)" ::: "memory");
    __builtin_amdgcn_s_barrier();
    asm volatile("" ::: "memory");
}
template <class KBF, class BODY, class NEXT>
__device__ __forceinline__ int tile_stream(const AttnCtx& a, unsigned char* lds, int nt, const bf16_t* Ksrc, const bf16_t* Vsrc, int NK, KBF kbf, BODY body,
                                           int base, bool primed, NEXT next) {
    AT_LAS unsigned char* ldsb = (AT_LAS unsigned char*)lds;
    if (!primed) {
        asm volatile("s_waitcnt lgkmcnt(0)" ::: "memory"); __builtin_amdgcn_s_barrier(); asm volatile("" ::: "memory");
        if (nt > 0) stage_issue(a, ldsb, (base & 1) * 32768, Ksrc, Vsrc, NK, kbf(0));
        if (nt > 1) stage_issue(a, ldsb, (base & 1) * 32768 + 16384, Ksrc, Vsrc, NK, kbf(1));
    }
    const int np = (nt + 1) >> 1;
    for (int P = 0; P < np; ++P) {
        stage_wait_barrier(0);
        const int nb = 2 * P + 2, sb = ((P + 1 + base) & 1) * 32768;
        if (nb < nt) stage_issue(a, ldsb, sb, Ksrc, Vsrc, NK, kbf(nb));
        if (nb + 1 < nt) stage_issue(a, ldsb, sb + 16384, Ksrc, Vsrc, NK, kbf(nb + 1));
        if (P + 1 == np) next(sb);
#pragma unroll 1
        for (int h = 0; h < 2; ++h) {
            const int i = 2 * P + h;
            if (i < nt) body(lds + ((P + base) & 1) * 32768 + h * 16384, i);
        }
    }
    return (base + np) & 1;
}
template <class KBF, class BODY>
__device__ __forceinline__ void tile_stream(const AttnCtx& a, unsigned char* lds, int nt, const bf16_t* Ksrc, const bf16_t* Vsrc, int NK, KBF kbf, BODY body) {
    (void)tile_stream(a, lds, nt, Ksrc, Vsrc, NK, kbf, body, 0, false, [](int) {});
}

template <bool DO_PV, bool IMP, int MM>
__device__ __forceinline__ void tile_step(const AttnCtx& a, const unsigned char* buf, int st, int kabs  ,
                                          unsigned act  , f32x4 (&O)[4][NCG], f32x4 (&L)[NCG],
                                          unsigned selbits  , float mb, float (&imp3)[NCG][3]) {
    bf16x8 kf[2][2];
#pragma unroll
    for (int T = 0; T < 2; ++T) {
        kf[T][0] = *(const bf16x8*)(buf + a.kb0 + st * 4096 + T * 512);
        kf[T][1] = *(const bf16x8*)(buf + a.kb1 + st * 4096 + T * 512);
    }
    bf16x8 vf[4];
    if (DO_PV) {
#pragma unroll
        for (int dt = 0; dt < 4; ++dt) vf[dt] = *(const bf16x8*)(buf + (st ? a.vb1 : a.vb0) + dt * 2048);
    }
    const int k0 = kabs + 8 * a.quad;
    const bf16x8 ones = {(short)0x3F80, (short)0x3F80, (short)0x3F80, (short)0x3F80, (short)0x3F80, (short)0x3F80, (short)0x3F80, (short)0x3F80};
#pragma unroll
    for (int cg = 0; cg < NCG; ++cg) {
        if (!((act >> cg) & 1u)) continue;
        const f32x4 c0 = (f32x4){-mb, -mb, -mb, -mb};
        f32x4 s0 = MFMA16(kf[0][0], a.qf[cg][0], c0);
        f32x4 s1 = MFMA16(kf[1][0], a.qf[cg][0], c0);
        s0 = MFMA16(kf[0][1], a.qf[cg][1], s0);
        s1 = MFMA16(kf[1][1], a.qf[cg][1], s1);
        const int tq = a.tq0 + 4 * cg;
        int hi = tq, lo = -1;
        if (MM == 1) lo = tq - 512;
        if (MM == 4) hi = ((tq + 1) >> 4) - 2;
        const bool sel = (selbits >> cg) & 1u;
        float pv[8];
#pragma unroll
        for (int e = 0; e < 8; ++e) {
            float v = __builtin_amdgcn_exp2f((e < 4) ? s0[e & 3] : s1[e & 3]);
            if (MM == 1) { const int k = k0 + e; v = (k > lo && k <= hi) ? v : 0.f; }
            if (MM == 3 || MM == 4) { const int k = k0 + e; v = (k <= hi) ? v : 0.f; }
            if (MM == 2) v = sel ? v : 0.f;
            pv[e] = v;
        }
        if (IMP) {
            imp3[cg][0] = pv[0] + pv[1] + pv[2] + 0.5f * pv[3];
            imp3[cg][1] = pv[4] + pv[5] + pv[6] + 0.5f * pv[7] + 0.5f * pv[3];
            imp3[cg][2] = 0.5f * pv[7];
        }
        u32x4 w; w.x = pk2(pv[0], pv[1]); w.y = pk2(pv[2], pv[3]); w.z = pk2(pv[4], pv[5]); w.w = pk2(pv[6], pv[7]);
        const bf16x8 pf = as_bf16x8(w);
        L[cg] = MFMA16(ones, pf, L[cg]);
        if (DO_PV) {
#pragma unroll
            for (int dt = 0; dt < 4; ++dt) O[dt][cg] = MFMA16(vf[dt], pf, O[dt][cg]);
        }
    }
}

template <bool DO_PV, bool IMP, int MM, int CGM>
__device__ __forceinline__ void tile_compute(const AttnCtx& a, const bf16x8 (&kf)[2][2][2], const bf16x8 (&vf)[2][4], int kabs  ,
                                             f32x4 (&O)[4][NCG], f32x4 (&L)[NCG], unsigned selbits, float mb, float (&imp3)[2][NCG][3]) {
    const bf16x8 ones = {(short)0x3F80, (short)0x3F80, (short)0x3F80, (short)0x3F80, (short)0x3F80, (short)0x3F80, (short)0x3F80, (short)0x3F80};
    const f32x4 c0 = (f32x4){-mb, -mb, -mb, -mb};
    f32x4 sc[2][NCG][2];
#pragma unroll
    for (int st = 0; st < 2; ++st)
#pragma unroll
        for (int cg = 0; cg < NCG; ++cg) {
            if (!((CGM >> cg) & 1)) continue;
            sc[st][cg][0] = MFMA16(kf[st][0][0], a.qf[cg][0], c0);
            sc[st][cg][1] = MFMA16(kf[st][1][0], a.qf[cg][0], c0);
        }
#pragma unroll
    for (int st = 0; st < 2; ++st)
#pragma unroll
        for (int cg = 0; cg < NCG; ++cg) {
            if (!((CGM >> cg) & 1)) continue;
            sc[st][cg][0] = MFMA16(kf[st][0][1], a.qf[cg][1], sc[st][cg][0]);
            sc[st][cg][1] = MFMA16(kf[st][1][1], a.qf[cg][1], sc[st][cg][1]);
        }
    bf16x8 pf[2][NCG];
#pragma unroll
    for (int st = 0; st < 2; ++st)
#pragma unroll
        for (int cg = 0; cg < NCG; ++cg) {
            if (!((CGM >> cg) & 1)) continue;
            const int k0 = kabs + 32 * st + 8 * a.quad;
            const int tq = a.tq0 + 4 * cg;
            int hi = tq, lo = -1;
            if (MM == 1) lo = tq - 512;
            if (MM == 4) hi = ((tq + 1) >> 4) - 2;
            const bool sel = (selbits >> cg) & 1u;
            float pv[8];
#pragma unroll
            for (int e = 0; e < 8; ++e) {
                float v = __builtin_amdgcn_exp2f(sc[st][cg][e >> 2][e & 3]);
                if (MM == 1) { const int k = k0 + e; v = (k > lo && k <= hi) ? v : 0.f; }
                if (MM == 3 || MM == 4) { const int k = k0 + e; v = (k <= hi) ? v : 0.f; }
                if (MM == 2) v = sel ? v : 0.f;
                pv[e] = v;
            }
            if (IMP) {
                imp3[st][cg][0] = pv[0] + pv[1] + pv[2] + 0.5f * pv[3];
                imp3[st][cg][1] = pv[4] + pv[5] + pv[6] + 0.5f * pv[7] + 0.5f * pv[3];
                imp3[st][cg][2] = 0.5f * pv[7];
            }
            u32x4 w; w.x = pk2(pv[0], pv[1]); w.y = pk2(pv[2], pv[3]); w.z = pk2(pv[4], pv[5]); w.w = pk2(pv[6], pv[7]);
            pf[st][cg] = as_bf16x8(w);
        }
#pragma unroll
    for (int st = 0; st < 2; ++st)
#pragma unroll
        for (int cg = 0; cg < NCG; ++cg) {
            if (!((CGM >> cg) & 1)) continue;
            L[cg] = MFMA16(ones, pf[st][cg], L[cg]);
            if (DO_PV) {
#pragma unroll
                for (int dt = 0; dt < 4; ++dt) O[dt][cg] = MFMA16(vf[st][dt], pf[st][cg], O[dt][cg]);
            }
        }
}

template <bool DO_PV, bool IMP, int MM, int CGM>
__device__ __forceinline__ void tile_full(const AttnCtx& a, const unsigned char* buf, int kabs, f32x4 (&O)[4][NCG], f32x4 (&L)[NCG], unsigned selbits, float mb,
                                          float (&imp3)[2][NCG][3]) {
    bf16x8 kf[2][2][2], vf[2][4];
#pragma unroll
    for (int st = 0; st < 2; ++st)
#pragma unroll
        for (int T = 0; T < 2; ++T) {
            kf[st][T][0] = *(const bf16x8*)(buf + a.kb0 + st * 4096 + T * 512);
            kf[st][T][1] = *(const bf16x8*)(buf + a.kb1 + st * 4096 + T * 512);
        }
    if (DO_PV) {
#pragma unroll
        for (int dt = 0; dt < 4; ++dt) { vf[0][dt] = *(const bf16x8*)(buf + a.vb0 + dt * 2048); vf[1][dt] = *(const bf16x8*)(buf + a.vb1 + dt * 2048); }
    }
    tile_compute<DO_PV, IMP, MM, CGM>(a, kf, vf, kabs, O, L, selbits, mb, imp3);
}
__device__ __forceinline__ void frags_tiled(const AttnCtx& a, const bf16_t* Kt, const bf16_t* Vtt, int tile, bf16x8 (&kf)[2][2][2], bf16x8 (&vf)[2][4]) {
    const bf16_t* kp = Kt + (size_t)tile * 4096 + a.lane * 8;
    const bf16_t* vp = Vtt + (size_t)tile * 4096 + a.lane * 8;
#pragma unroll
    for (int st = 0; st < 2; ++st) {
#pragma unroll
        for (int T = 0; T < 2; ++T) { kf[st][T][0] = *(const bf16x8*)(kp + ((st * 2 + T) * 2 + 0) * 512); kf[st][T][1] = *(const bf16x8*)(kp + ((st * 2 + T) * 2 + 1) * 512); }
#pragma unroll
        for (int dt = 0; dt < 4; ++dt) vf[st][dt] = *(const bf16x8*)(vp + (st * 4 + dt) * 512);
    }
}
__device__ __forceinline__ void frags_global(const AttnCtx& a, const bf16_t* Kb, const bf16_t* Vt, int kb, bf16x8 (&kf)[2][2][2], bf16x8 (&vf)[2][4]) {
#pragma unroll
    for (int st = 0; st < 2; ++st) {
#pragma unroll
        for (int T = 0; T < 2; ++T) {
            const bf16_t* kp = Kb + (size_t)(kb + 32 * st + (a.c >> 2) * 8 + T * 4 + (a.c & 3)) * 64 + 8 * a.quad;
            kf[st][T][0] = *(const bf16x8*)kp; kf[st][T][1] = *(const bf16x8*)(kp + 32);
        }
#pragma unroll
        for (int dt = 0; dt < 4; ++dt) vf[st][dt] = *(const bf16x8*)(Vt + (size_t)(16 * dt + a.c) * SEQ + kb + 32 * st + 8 * a.quad);
    }
}

typedef __fp16 h2v_ __attribute__((ext_vector_type(2)));
__device__ __forceinline__ unsigned pkh2(float lo, float hi) { return __builtin_bit_cast(unsigned, __builtin_amdgcn_cvt_pkrtz(lo, hi)); }
__device__ __forceinline__ float h2lo(unsigned u) { return (float)__builtin_bit_cast(h2v_, u)[0]; }
__device__ __forceinline__ float h2hi(unsigned u) { return (float)__builtin_bit_cast(h2v_, u)[1]; }
__device__ __forceinline__ float dpp_swap1(float v) {
    return __builtin_bit_cast(float, __builtin_amdgcn_mov_dpp(__builtin_bit_cast(int, v), 0xB1, 0xF, 0xF, true));
}
__device__ __forceinline__ float dpp_quad_sum(float v) {
    int x = __builtin_bit_cast(int, v);
    float t = v + __builtin_bit_cast(float, __builtin_amdgcn_mov_dpp(x, 0xB1, 0xF, 0xF, true));
    x = __builtin_bit_cast(int, t);
    return t + __builtin_bit_cast(float, __builtin_amdgcn_mov_dpp(x, 0x4E, 0xF, 0xF, true));
}

__device__ __forceinline__ void attn_block_item(const Params& p, int l, int bg, int qi, unsigned char* lds, int tid, bool primed_c, bool prime_next, int& sbase) {
    asm volatile("" : "+v"(tid));
    const bf16_t* z = (const bf16_t*)(p.ws + WS_Z);
    AttnCtx a;
    a.tid = tid; a.wid = tid >> 6; a.lane = tid & 63; a.c = a.lane & 15; a.quad = a.lane >> 4;
    const int b = bg >> 1, g = bg & 1, s0 = qi * 64, sw = s0 + 8 * a.wid, hd = a.c & 3;
    float* wl = (float*)(lds + AT_WAVE_OFF + a.wid * AT_WAVE_STRIDE);
    unsigned short* selm = (unsigned short*)(lds + AT_SELM) + a.wid * 64;
    a.tq0 = sw + (a.c >> 2);
    {
        const int swc = ((a.c >> 1) & 1) | ((a.c >> 2) << 1);
        const int rowb = (a.c >> 2) * 1024 + (a.c & 3) * 128;
        a.kb0 = rowb + ((a.quad ^ swc) << 4); a.kb1 = rowb + (((4 + a.quad) ^ swc) << 4);
        const int swv = (a.c >> 1) & 7;
        a.vb0 = 8192 + a.c * 128 + ((a.quad ^ swv) << 4); a.vb1 = 8192 + a.c * 128 + (((4 + a.quad) ^ swv) << 4);
        const int row = tid >> 3, cp = tid & 7;
        a.ksrc = row * 64 + ((cp ^ kswz(row)) << 3); a.vrow = row; a.vsrc = (cp ^ ((row >> 1) & 7)) << 3;
        asm volatile("" : "+v"(a.kb0), "+v"(a.kb1), "+v"(a.vb0), "+v"(a.vb1), "+v"(a.ksrc), "+v"(a.vsrc));
    }
#define TROW(cg) ((size_t)b * SEQ + (size_t)(a.tq0 + 4 * (cg)))
#pragma unroll
    for (int cg = 0; cg < NCG; ++cg) {
        const bf16_t* qp = (const bf16_t*)(p.ws + WS_QN) + TROW(cg) * 512 + (4 * g + hd) * 64 + 8 * a.quad;
        a.qf[cg][0] = *(const bf16x8*)qp; a.qf[cg][1] = *(const bf16x8*)(qp + 32);
    }
    float gv[NCG];
#pragma unroll
    for (int cg = 0; cg < NCG; ++cg) gv[cg] = sigmoidf_(bf2f(z[TROW(cg) * ZW + C_BG + 12 * g + 3 * hd + (a.quad < 2 ? a.quad : 2)]));
#define GATE(cg, br) shf(gv[cg], a.c + 16 * (br))
    const float* mbp = (const float*)(p.ws + WS_MB) + l * 4;
    f32x4 O[4][NCG], L[NCG];
    float invl[NCG], imp3[2][NCG][3];
    AT_LAS unsigned char* ldsb = (AT_LAS unsigned char*)lds;
#define ZERO_ACC() { _Pragma("unroll") for (int h_ = 0; h_ < NCG; ++h_) L[h_] = (f32x4){0.f, 0.f, 0.f, 0.f}; \
                     _Pragma("unroll") for (int dt_ = 0; dt_ < 4; ++dt_) _Pragma("unroll") for (int h_ = 0; h_ < NCG; ++h_) O[dt_][h_] = (f32x4){0.f, 0.f, 0.f, 0.f}; }
    {
        const bf16_t* kc = (const bf16_t*)(p.ws + WS_KC) + (size_t)bg * 512 * 64;
        const bf16_t* vct = (const bf16_t*)(p.ws + WS_VCT) + (size_t)bg * 64 * 512;
        const int nmax_b = ((s0 + 64) >> 4) - 1;
        const int nct = (nmax_b + 63) >> 6;
        const int nmax_w = ((sw + 8) >> 4) - 1;
        const int nmin_w = ((sw + 1) >> 4) - 1;
        const float mb_c = mbp[0];
        const float isc = __builtin_amdgcn_exp2f(fminf(floorf(mb_c) - 2.0f, 100.0f));
        unsigned* rawp = (unsigned*)((hd < 2) ? (unsigned char*)wl : lds + AT_QS + a.wid * 4096);
        ZERO_ACC();
        float co_prev[NCG] = {0.f, 0.f};
        (void)tile_stream(a, lds, nct, kc, vct, 512, [](int i) { return i * 64; }, [&](const unsigned char* buf, int i_) {
            const int kb = i_ * 64;
            if (kb < nmax_w) {
                if (kb + 63 >= nmin_w) tile_full<true, true, 4, 3>(a, buf, kb, O, L, 0u, mb_c, imp3);
                else tile_full<true, true, 0, 3>(a, buf, kb, O, L, 0u, mb_c, imp3);
#pragma unroll
                for (int st = 0; st < 2; ++st) {
                    const int j0 = ((kb + 32 * st) >> 2) + 2 * a.quad;
#pragma unroll
                    for (int cg = 0; cg < NCG; ++cg) {
                        float X0 = imp3[st][cg][0], X1 = imp3[st][cg][1];
                        const float co = imp3[st][cg][2];
                        const float send = (a.quad == 3) ? co_prev[cg] : co;
                        X0 += shf(send, (a.lane + 48) & 63);
                        co_prev[cg] = co;
                        X0 *= isc; X1 *= isc;
                        const float Y0 = dpp_swap1(X0), Y1 = dpp_swap1(X1);
                        if (!(hd & 1)) { const int q = 4 * cg + (a.c >> 2); rawp[j0 * 8 + q] = pkh2(X0, Y0); rawp[(j0 + 1) * 8 + q] = pkh2(X1, Y1); }
                    }
                }
            }
        }, sbase, primed_c, [](int) {});
#pragma unroll
        for (int cg = 0; cg < NCG; ++cg) {
            invl[cg] = L[cg].x > 0.f ? 1.0f / L[cg].x : 0.f;
            if (a.quad == 0) wl[1024 + (4 * cg + (a.c >> 2)) * 4 + hd] = invl[cg];
        }
    }
    LDS_FENCE();
    const int bt = s0 >> 6;
    {
        const int q = a.lane & 7, part = a.lane >> 3;
        unsigned mymask = 0u;
        if (bt >= 16) {
            unsigned key[16];
            const unsigned* r01 = (const unsigned*)wl + (16 * part) * 8 + q;
            const unsigned* r23 = (const unsigned*)(lds + AT_QS + a.wid * 4096) + (16 * part) * 8 + q;
            const f32x4 il = *(const f32x4*)(wl + 1024 + q * 4);
            const int ilo = 1 - 16 * part, ihi = bt - 2 - 16 * part, jrev = 127 - 16 * part;
#pragma unroll
            for (int i = 0; i < 16; ++i) {
                const unsigned u0 = r01[i * 8], u1 = r23[i * 8];
                const unsigned bits = __float_as_uint((h2lo(u0) * il.x + h2hi(u0) * il.y) + (h2lo(u1) * il.z + h2hi(u1) * il.w));
                key[i] = (i >= ilo && i <= ihi) ? ((bits & ~127u) | (unsigned)(jrev - i)) : 0u;
            }
            for (int it = 0; it < 13; ++it) {
                unsigned m = 0u;
#pragma unroll
                for (int i = 0; i < 16; ++i) m = key[i] > m ? key[i] : m;
                { const unsigned o = (unsigned)__builtin_amdgcn_update_dpp(0, (int)m, 0x128, 0xF, 0xF, false); m = o > m ? o : m; }
                { const auto r = __builtin_amdgcn_permlane16_swap(m, m, false, false); m = r[0] > r[1] ? r[0] : r[1]; }
                { const auto r = __builtin_amdgcn_permlane32_swap(m, m, false, false); m = r[0] > r[1] ? r[0] : r[1]; }
                const int jsel = 127 - (int)(m & 127u);
                if ((jsel >> 4) == part) mymask |= 1u << (jsel & 15);
#pragma unroll
                for (int i = 0; i < 16; ++i) key[i] = (key[i] == m) ? 0u : key[i];
            }
            if (part == 0) mymask |= 1u;
            if (((bt - 1) >> 4) == part) mymask |= 1u << ((bt - 1) & 15);
            if ((bt >> 4) == part) mymask |= 1u << (bt & 15);
        } else {
            if (part == 0) mymask = (2u << bt) - 1u;
        }
        selm[q * 8 + part] = (unsigned short)mymask;
    }
    LDS_FENCE();
#define PARK_ADDR(cg, dt) ((unsigned char*)wl + (16 * (cg) + a.c) * 128 + (((4 * (dt) + a.quad) ^ (((16 * (cg) + a.c) >> 1) & 7)) << 3))
#pragma unroll
    for (int cg = 0; cg < NCG; ++cg) {
        const float gc = GATE(cg, 0) * invl[cg];
#pragma unroll
        for (int dt = 0; dt < 4; ++dt) {
            u32x2 w; w.x = pk2(gc * O[dt][cg].x, gc * O[dt][cg].y); w.y = pk2(gc * O[dt][cg].z, gc * O[dt][cg].w);
            *(u32x2*)PARK_ADDR(cg, dt) = w;
        }
    }
    const bf16_t* kwb = (const bf16_t*)(p.ws + WS_KW) + (size_t)bg * SEQ * 64;
    const bf16_t* vwt = (const bf16_t*)(p.ws + WS_VWT) + (size_t)bg * 64 * SEQ;
    int t0w = s0 - 511; t0w = t0w < 0 ? 0 : t0w; t0w >>= 6;
    const int t1w = (s0 + 63) >> 6;
    auto prime_window = [&](int sb) {
        stage_issue(a, ldsb, sb, kwb, vwt, SEQ, t0w * 64);
        if (t1w > t0w) stage_issue(a, ldsb, sb + 16384, kwb, vwt, SEQ, (t0w + 1) * 64);
    };
    int wbase = 0;
    {
        const bf16_t* ksb = (const bf16_t*)(p.ws + WS_KS) + (size_t)bg * SEQ * 64;
        const bf16_t* vst = (const bf16_t*)(p.ws + WS_VST) + (size_t)bg * 64 * SEQ;
        const float mb_s = mbp[1];
        const bf16_t* ks2 = (const bf16_t*)(p.ws + WS_KS2) + (size_t)bg * SEQ * 64;
        const bf16_t* vs2 = (const bf16_t*)(p.ws + WS_VST2) + (size_t)bg * 64 * SEQ;
        if (bt < 16) {
            ZERO_ACC();
            wbase = tile_stream(a, lds, bt + 1, ksb, vst, SEQ, [](int i) { return i * 64; }, [&](const unsigned char* buf, int i_) {
                if (i_ == bt) tile_full<true, false, 3, 3>(a, buf, i_ * 64, O, L, 3u, mb_s, imp3);
                else tile_full<true, false, 0, 3>(a, buf, i_ * 64, O, L, 3u, mb_s, imp3);
            }, 0, false, prime_window);
        } else {
            const int wv = __builtin_amdgcn_readfirstlane(a.wid);
            asm volatile("s_waitcnt lgkmcnt(0)" ::: "memory"); __builtin_amdgcn_s_barrier(); asm volatile("" ::: "memory");
#pragma unroll
            for (int cg = 0; cg < NCG; ++cg) {
                const int row = (8 * wv + 4 * cg + (a.c >> 2)) * 4 + hd, qs = ((row >> 1) & 1) | (((row >> 2) & 3) << 1);
                *(bf16x8*)(lds + AT_QS + row * 128 + (((0 + a.quad) ^ qs) << 4)) = a.qf[cg][0];
                *(bf16x8*)(lds + AT_QS + row * 128 + (((4 + a.quad) ^ qs) << 4)) = a.qf[cg][1];
            }
            { u32x4 zz = (u32x4){0u, 0u, 0u, 0u}; asm volatile("" : "+v"(zz));
              for (int i = tid; i < (256 * 65 * 4) / 16; i += NTHR) *(u32x4*)(lds + AT_OACC + i * 16) = zz; }
            if (tid < 256) ((float*)(lds + AT_LACC))[tid] = 0.f;
            if (tid == 0) *(unsigned*)(lds + AT_QUEUE) = 1u;
            asm volatile("s_waitcnt lgkmcnt(0)" ::: "memory"); __builtin_amdgcn_s_barrier(); asm volatile("" ::: "memory");
            {
                const u32x4 mq = *(const u32x4*)(lds + AT_SELM + a.lane * 16);
                const bf16x8 ones = {(short)0x3F00, (short)0x3F00, (short)0x3F00, (short)0x3F00, (short)0x3F00, (short)0x3F00, (short)0x3F00, (short)0x3F00};
                const float cb = 22.0f - mb_s;
                const f32x4 c0 = (f32x4){cb, cb, cb, cb};
                float* oacc = (float*)(lds + AT_OACC);
                float* lacc = (float*)(lds + AT_LACC);
                unsigned* queue = (unsigned*)(lds + AT_QUEUE);
                auto next_blk = [&](unsigned long long& qm) -> int {
                    for (;;) {
                        int j = 0;
                        if (a.lane == 0) j = (int)__hip_atomic_fetch_add(queue, 1u, __ATOMIC_RELAXED, __HIP_MEMORY_SCOPE_WORKGROUP);
                        j = __builtin_amdgcn_readfirstlane(j);
                        if (j > bt - 2) { qm = 0ull; return -1; }
                        const unsigned wsel = (j < 32) ? mq.x : (j < 64) ? mq.y : (j < 96) ? mq.z : mq.w;
                        qm = __ballot((wsel >> (j & 31)) & 1u);
                        if (qm != 0ull) return j;
                    }
                };
                auto groups = [&](const bf16x8 (&kf)[2][2][2], const bf16x8 (&vf)[2][4], unsigned long long qm) {
#pragma unroll 1
                    while (qm != 0ull) {
                        const int q0 = __builtin_ctzll(qm); qm &= qm - 1ull;
                        int q1 = -1, q2 = -1, q3 = -1;
                        if (qm != 0ull) { q1 = __builtin_ctzll(qm); qm &= qm - 1ull; }
                        if (qm != 0ull) { q2 = __builtin_ctzll(qm); qm &= qm - 1ull; }
                        if (qm != 0ull) { q3 = __builtin_ctzll(qm); qm &= qm - 1ull; }
                        const int qi = a.c >> 2;
                        int myq = (qi == 0) ? q0 : (qi == 1) ? q1 : (qi == 2) ? q2 : q3;
                        const bool valid = myq >= 0;
                        myq = valid ? myq : q0;
                        const int row = myq * 4 + hd, qs = ((row >> 1) & 1) | (((row >> 2) & 3) << 1);
                        const unsigned char* qrow = lds + AT_QS + row * 128;
                        const bf16x8 qa = *(const bf16x8*)(qrow + (((0 + a.quad) ^ qs) << 4)), qb = *(const bf16x8*)(qrow + (((4 + a.quad) ^ qs) << 4));
                        f32x4 sa[2][2];
#pragma unroll
                        for (int st = 0; st < 2; ++st)
#pragma unroll
                            for (int T = 0; T < 2; ++T) sa[st][T] = MFMA16(kf[st][T][0], qa, c0);
#pragma unroll
                        for (int st = 0; st < 2; ++st)
#pragma unroll
                            for (int T = 0; T < 2; ++T) sa[st][T] = MFMA16(kf[st][T][1], qb, sa[st][T]);
                        bf16x8 pf[2];
#pragma unroll
                        for (int st = 0; st < 2; ++st) {
                            float pv[8];
#pragma unroll
                            for (int e = 0; e < 8; ++e) pv[e] = __builtin_amdgcn_exp2f(sa[st][e >> 2][e & 3]);
                            u32x4 w; w.x = pk2(pv[0], pv[1]); w.y = pk2(pv[2], pv[3]); w.z = pk2(pv[4], pv[5]); w.w = pk2(pv[6], pv[7]);
                            pf[st] = as_bf16x8(w);
                        }
                        f32x4 Lc = MFMA16(ones, pf[0], ((f32x4){0.f, 0.f, 0.f, 0.f}));
                        Lc = MFMA16(ones, pf[1], Lc);
                        f32x4 Oc[4];
#pragma unroll
                        for (int dt = 0; dt < 4; ++dt) { Oc[dt] = MFMA16(vf[0][dt], pf[0], ((f32x4){0.f, 0.f, 0.f, 0.f})); Oc[dt] = MFMA16(vf[1][dt], pf[1], Oc[dt]); }
                        if (valid) {
                            float* ob = oacc + row * 65 + 4 * a.quad;
#pragma unroll
                            for (int dt = 0; dt < 4; ++dt)
#pragma unroll
                                for (int e = 0; e < 4; ++e) (void)__hip_atomic_fetch_add((int*)(ob + 16 * dt + e), (int)Oc[dt][e], __ATOMIC_RELAXED, __HIP_MEMORY_SCOPE_WORKGROUP);
                            if (a.quad == 0) (void)__hip_atomic_fetch_add((int*)(lacc + row), (int)Lc.x, __ATOMIC_RELAXED, __HIP_MEMORY_SCOPE_WORKGROUP);
                        }
                    }
                };
                bf16x8 kfA[2][2][2], vfA[2][4], kfB[2][2][2], vfB[2][4];
                unsigned long long qmA = 0ull, qmB = 0ull;
                int jA = next_blk(qmA);
                if (jA >= 0) frags_tiled(a, ks2, vs2, jA, kfA, vfA);
#pragma unroll 1
                while (jA >= 0) {
                    const int jB = next_blk(qmB);
                    if (jB >= 0) frags_tiled(a, ks2, vs2, jB, kfB, vfB);
                    groups(kfA, vfA, qmA);
                    if (jB < 0) break;
                    jA = next_blk(qmA);
                    if (jA >= 0) frags_tiled(a, ks2, vs2, jA, kfA, vfA);
                    groups(kfB, vfB, qmB);
                }
            }
            asm volatile("s_waitcnt lgkmcnt(0)" ::: "memory"); __builtin_amdgcn_s_barrier(); asm volatile("" ::: "memory");
            asm volatile("" : "+v"(a.tq0));
#pragma unroll
            for (int cg = 0; cg < NCG; ++cg) {
                const int row = (8 * wv + 4 * cg + (a.c >> 2)) * 4 + hd;
                { const int qs = ((row >> 1) & 1) | (((row >> 2) & 3) << 1);
                  a.qf[cg][0] = *(const bf16x8*)(lds + AT_QS + row * 128 + (((0 + a.quad) ^ qs) << 4));
                  a.qf[cg][1] = *(const bf16x8*)(lds + AT_QS + row * 128 + (((4 + a.quad) ^ qs) << 4)); }
                const int* ob = (const int*)(lds + AT_OACC) + row * 65 + 4 * a.quad;
                const float lv = (float)((const int*)(lds + AT_LACC))[row] * (1.0f / 2097152.0f);
                L[cg] = (f32x4){lv, lv, lv, lv};
#pragma unroll
                for (int dt = 0; dt < 4; ++dt)
#pragma unroll
                    for (int e = 0; e < 4; ++e) O[dt][cg][e] = (float)ob[16 * dt + e] * (1.0f / 4194304.0f);
            }
            wbase = tile_stream(a, lds, 3, ksb, vst, SEQ, [bt](int i) { return ((i == 0) ? 0 : bt - 2 + i) * 64; }, [&](const unsigned char* buf, int i_) {
                if (i_ == 2) tile_full<true, false, 3, 3>(a, buf, bt * 64, O, L, 3u, mb_s, imp3);
                else tile_full<true, false, 0, 3>(a, buf, ((i_ == 0) ? 0 : bt - 1) * 64, O, L, 3u, mb_s, imp3);
            }, 0, false, prime_window);
        }
#pragma unroll
        for (int cg = 0; cg < NCG; ++cg) {
            const float coef = L[cg].x > 0.f ? GATE(cg, 1) / L[cg].x : 0.f;
#pragma unroll
            for (int dt = 0; dt < 4; ++dt) {
                u32x2* pa = (u32x2*)PARK_ADDR(cg, dt);
                const u32x2 o = *pa;
                u32x2 w;
                w.x = pk2(bflo(o.x) + coef * O[dt][cg].x, bfhi(o.x) + coef * O[dt][cg].y);
                w.y = pk2(bflo(o.y) + coef * O[dt][cg].z, bfhi(o.y) + coef * O[dt][cg].w);
                *pa = w;
            }
        }
    }
    {
        const float mb_w = mbp[2];
        ZERO_ACC();
        {
            const int wv = __builtin_amdgcn_readfirstlane(a.wid);
#pragma unroll
            for (int i = 0; i < 4; ++i) {
                const int r = i * 8 + (a.lane >> 3), ch = a.lane & 7;
                const bf16_t* src = z + ((size_t)b * SEQ + sw + (r >> 2)) * ZW + C_NG + (4 * g + (r & 3)) * 64 + ((ch ^ (r & 7)) << 3);
                __builtin_amdgcn_global_load_lds((const unsigned*)src, (AT_LAS unsigned*)(ldsb + AT_QS + wv * 4096 + i * 1024), 16, 0, 0);
            }
        }
        sbase = tile_stream(a, lds, t1w - t0w + 1, kwb, vwt, SEQ, [t0w](int i) { return (t0w + i) * 64; }, [&](const unsigned char* buf, int i_) {
            const int kb = (t0w + i_) * 64;
            if (kb + 63 > sw - 512 && kb <= sw + 7) {
                if ((kb > sw + 7 - 512) && (kb + 63 <= sw)) tile_full<true, false, 0, 3>(a, buf, kb, O, L, 0u, mb_w, imp3);
                else tile_full<true, false, 1, 3>(a, buf, kb, O, L, 0u, mb_w, imp3);
            }
        }, wbase, true, [&](int sb) {
            if (prime_next) {
                const bf16_t* kc = (const bf16_t*)(p.ws + WS_KC) + (size_t)bg * 512 * 64;
                const bf16_t* vct = (const bf16_t*)(p.ws + WS_VCT) + (size_t)bg * 64 * 512;
                stage_issue(a, ldsb, sb, kc, vct, 512, 0);
                stage_issue(a, ldsb, sb + 16384, kc, vct, 512, 64);
            }
        });
        u32x2 gwv[NCG][4];
        asm volatile("" ::: "memory");
#pragma unroll
        for (int cg = 0; cg < NCG; ++cg) {
            const int row = (4 * cg + (a.c >> 2)) * 4 + hd;
            const unsigned char* ngl = lds + AT_QS + a.wid * 4096 + row * 128 + (a.quad & 1) * 8;
#pragma unroll
            for (int dt = 0; dt < 4; ++dt) gwv[cg][dt] = *(const u32x2*)(ngl + (((2 * dt + (a.quad >> 1)) ^ (row & 7)) << 4));
        }
#pragma unroll
        for (int cg = 0; cg < NCG; ++cg) {
            const float coef = L[cg].x > 0.f ? GATE(cg, 2) / L[cg].x : 0.f;
            bf16_t* yo = (bf16_t*)(p.ws + WS_Y) + TROW(cg) * DM + 512 + (4 * g + hd) * 64 + 4 * a.quad;
#pragma unroll
            for (int dt = 0; dt < 4; ++dt) {
                const u32x2 o = *(const u32x2*)PARK_ADDR(cg, dt);
                const u32x2 gw = gwv[cg][dt];
                float r0 = bflo(o.x) + coef * O[dt][cg].x, r1 = bfhi(o.x) + coef * O[dt][cg].y, r2 = bflo(o.y) + coef * O[dt][cg].z, r3 = bfhi(o.y) + coef * O[dt][cg].w;
                r0 *= siluf_(bflo(gw.x)); r1 *= siluf_(bfhi(gw.x)); r2 *= siluf_(bflo(gw.y)); r3 *= siluf_(bfhi(gw.y));
                u32x2 w; w.x = pk2(r0, r1); w.y = pk2(r2, r3);
                *(u32x2*)(yo + 16 * dt) = w;
            }
        }
    }
    LDS_FENCE();
#undef GATE
#undef TROW
#undef ZERO_ACC
#undef PARK_ADDR
}

template <int NCK>
__device__ __forceinline__ void rgfin_item(const Params& p, int b, int ch, int n, float* wsc  , int lane) {
    const bf16_t* z = (const bf16_t*)(p.ws + WS_Z);
    float hc[NCK];
    {
        const int c = n * 64 + lane;
        const float* sh = (const float*)(p.ws + WS_SUMH) + (size_t)b * NCH * 512 + c;
        const float* sp = (const float*)(p.ws + WS_SUMP) + (size_t)b * NCH * 512 + c;
        float h = 0.f;
        int j = 0;
        for (; j + 32 <= ch; j += 32) {
            float pv[32], hv[32];
#pragma unroll
            for (int u = 0; u < 32; ++u) { pv[u] = sp[(size_t)(j + u) * 512]; hv[u] = sh[(size_t)(j + u) * 512]; }
#pragma unroll
            for (int u = 0; u < 32; ++u) h = pv[u] * h + hv[u];
        }
        {
            float pv[32], hv[32];
#pragma unroll
            for (int u = 0; u < 32; ++u) { const bool ok = j + u < ch; pv[u] = ok ? sp[(size_t)(j + u) * 512] : 1.f; hv[u] = ok ? sh[(size_t)(j + u) * 512] : 0.f; }
#pragma unroll
            for (int u = 0; u < 32; ++u) h = pv[u] * h + hv[u];
        }
        float pn[NCK], hn[NCK];
#pragma unroll
        for (int i = 0; i + 1 < NCK; ++i) { pn[i] = sp[(size_t)(ch + i) * 512]; hn[i] = sh[(size_t)(ch + i) * 512]; }
        hc[0] = h;
#pragma unroll
        for (int i = 0; i + 1 < NCK; ++i) hc[i + 1] = pn[i] * hc[i] + hn[i];
    }
#pragma unroll
    for (int half = 0; half < NCK; ++half, ++ch) {
    wsc[lane] = hc[half];
    LDS_FENCE();
    const int r = lane >> 3, c8 = lane & 7;
    float cr[8];
    { const f32x4 c0 = *(const f32x4*)(wsc + c8 * 8), c1 = *(const f32x4*)(wsc + c8 * 8 + 4); cr[0] = c0.x; cr[1] = c0.y; cr[2] = c0.z; cr[3] = c0.w; cr[4] = c1.x; cr[5] = c1.y; cr[6] = c1.z; cr[7] = c1.w; }
    const size_t t0 = (size_t)b * SEQ + (size_t)ch * 64 + r;
    const int cc = n * 64 + c8 * 8;
    const bf16_t* hl = (const bf16_t*)(p.ws + WS_HLOC) + t0 * 512 + cc;
    const bf16_t* pc = (const bf16_t*)(p.ws + WS_PC) + t0 * 512 + cc;
    const bf16_t* zg = z + t0 * ZW + C_RGG + cc;
    bf16_t* y = (bf16_t*)(p.ws + WS_Y) + t0 * DM + cc;
    u32x4 hwN = *(const u32x4*)hl, pwN = *(const u32x4*)pc, gwN = *(const u32x4*)zg;
#pragma unroll
    for (int it = 0; it < 8; ++it) {
        const u32x4 hw = hwN, pw = pwN, gw = gwN;
        if (it + 1 < 8) {
            hwN = *(const u32x4*)(hl + (size_t)(it + 1) * 8 * 512);
            pwN = *(const u32x4*)(pc + (size_t)(it + 1) * 8 * 512);
            gwN = *(const u32x4*)(zg + (size_t)(it + 1) * 8 * ZW);
        }
        __builtin_amdgcn_sched_barrier(0);
        const unsigned hh[4] = {hw.x, hw.y, hw.z, hw.w}, pp[4] = {pw.x, pw.y, pw.z, pw.w}, gg[4] = {gw.x, gw.y, gw.z, gw.w};
        unsigned o[4];
#pragma unroll
        for (int k = 0; k < 4; ++k) {
            const float v0 = (bflo(hh[k]) + bflo(pp[k]) * cr[2 * k]) * siluf_(bflo(gg[k]));
            const float v1 = (bfhi(hh[k]) + bfhi(pp[k]) * cr[2 * k + 1]) * siluf_(bfhi(gg[k]));
            o[k] = pk2(v0, v1);
        }
        u32x4 ow; ow.x = o[0]; ow.y = o[1]; ow.z = o[2]; ow.w = o[3];
        *(u32x4*)(y + (size_t)it * 8 * DM) = ow;
    }
    LDS_FENCE();
    }
}

__device__ __forceinline__ void phase_attn(const Params& p, int l, unsigned char* lds) {
    const Ids ids = fresh_ids();
    const int wid = ids.tid >> 6, lane = ids.tid & 63, gw = ids.bid * NWAVE + wid, nw = gridDim.x * NWAVE;
    const bool chain = (gridDim.x & 7) == 0;
    int sbase = 0;
    for (int it = ids.bid; it < 1024; it += gridDim.x) {
        const int bg = it & 7, k = it >> 3;
        attn_block_item(p, l, bg, (k < 64) ? 127 - k : k - 64, lds, ids.tid, chain && it != ids.bid, chain && it + (int)gridDim.x < 1024, sbase);
    }
    constexpr int N_RG = NB * NCH * 8;
    float* wsc = (float*)(lds + AT_WAVE_OFF + wid * AT_WAVE_STRIDE);
    if (gridDim.x == 256) { if (ids.bid < 128) rgfin_item<4>(p, gw / (NCH * 2), 4 * ((gw / 8) % (NCH / 4)), gw & 7, wsc, lane); }
    else for (int r = gw; r < N_RG / 2; r += nw) rgfin_item<2>(p, r / (NCH * 4), 2 * ((r / 8) % (NCH / 2)), r & 7, wsc, lane);
}

constexpr int LDS_BYTES = NWAVE * 17408;
static_assert(LDS_BYTES >= pg8::STAGE_BYTES && LDS_BYTES >= AT_END && 256 * 65 * 4 <= AT_WAVE_OFF, "lds");

__global__ void __launch_bounds__(512) k_mega(Params p) {
    extern __shared__ __attribute__((aligned(16))) unsigned char lds[];
    unsigned* bar = (unsigned*)(p.ws + WS_BAR);
    volatile unsigned* st = (volatile unsigned*)(lds + LDS_BYTES);
    {
        const Ids ids = fresh_ids();
        if (ids.tid == 0) { st[0] = 0u; st[1] = 0u; (void)xb_add(&bar[XB_XCNT(xb_xcc_id())], 1u); }
    }
    __syncthreads();
    phase_prologue(p, lds);
    grid_barrier(bar, st);
#pragma unroll 1
    for (int l = 0; l < DEPTH; ++l) {
        phase_gemm_in(p, l, lds);
        grid_barrier(bar, st);
        phase_post(p, l, lds);
        grid_barrier(bar, st);
        phase_attn(p, l, lds);
        grid_barrier(bar, st);
        phase_gemm_out(p, l, lds, (l == 0) ? p.x : p.out, p.out);
        if (l + 1 < DEPTH) grid_barrier(bar, st);
    }
}

extern "C" void kernel_launch(void* const* d_in, const int* in_sizes, int n_in, void* d_out, int out_size, void* d_ws, size_t ws_size,
                              hipStream_t stream) {
    static int grid = 0;
    if (grid == 0) {
        if (n_in != 19 || ws_size < WS_END) { fprintf(stderr, "kernel_launch: unexpected n_in %d / ws_size %zu (need %zu)\n", n_in, ws_size, (size_t)WS_END); grid = -1; return; }
        (void)hipFuncSetAttribute((const void*)k_mega, hipFuncAttributeMaxDynamicSharedMemorySize, LDS_BYTES + 16);
        int dev = 0, cus = 0, per_cu = 0;
        (void)hipGetDevice(&dev);
        (void)hipDeviceGetAttribute(&cus, hipDeviceAttributeMultiprocessorCount, dev);
        (void)hipOccupancyMaxActiveBlocksPerMultiprocessor(&per_cu, (const void*)k_mega, NTHR, LDS_BYTES + 16);
        if (per_cu < 1) { fprintf(stderr, "kernel_launch: occupancy query says %d blocks per CU\n", per_cu); grid = -1; return; }
        per_cu = 1;
        grid = cus * per_cu;
    }
    if (grid < 0) return;
    Params p{};
    const float** dst = (const float**)&p;
    for (int i = 0; i < 19; ++i) dst[i] = (const float*)d_in[i];
    p.out = (float*)d_out;
    p.ws = (unsigned char*)d_ws;
    (void)hipMemsetAsync((unsigned char*)d_ws + WS_BAR, 0, 16384, stream);
    hipLaunchKernelGGL(k_mega, dim3(grid), dim3(NTHR), LDS_BYTES + 16, stream, p);
}
```

```cpp
#include <hip/hip_runtime.h>
#include <stdint.h>
#include <stdio.h>

typedef unsigned short bf16_t;
typedef short bf16x8 __attribute__((ext_vector_type(8)));
typedef float f32x4 __attribute__((ext_vector_type(4)));
typedef unsigned u32x4 __attribute__((ext_vector_type(4)));
typedef unsigned u32x2 __attribute__((ext_vector_type(2)));

constexpr int NB = 4, SEQ = 8192, NT = NB * SEQ, DM = 1024, DEPTH = 2;
constexpr int NIN = 2840, ZW = 3072;
constexpr int NTHR = 512, NWAVE = 8;
constexpr int C_RGX = 0, C_RGG = 512, C_Q = 1024, C_KC = 1536, C_VC = 1664, C_KS = 1792, C_VS = 1920, C_KW = 2048, C_VW = 2176,
              C_NG = 2304, C_BG = 2816;
constexpr int NCH = SEQ / 64;
constexpr float EPS = 1e-6f;
constexpr float LOG2E = 1.4426950408889634f;

constexpr size_t AL(size_t x) { return (x + 255) & ~(size_t)255; }
constexpr size_t WS_WTIN = 0;
constexpr size_t WS_WTOUT = WS_WTIN + AL((size_t)DEPTH * ZW * DM * 2);
constexpr size_t WS_ROPE = WS_WTOUT + AL((size_t)DEPTH * DM * DM * 2);
constexpr size_t WS_W1T = WS_ROPE + AL((size_t)SEQ * 16 * 4);
constexpr size_t WS_B1 = WS_W1T + AL((size_t)DEPTH * 2 * 128 * 2048 * 2);
constexpr size_t WS_W2P = WS_B1 + AL((size_t)DEPTH * 2 * 16 * 128 * 4);
constexpr size_t WS_RGW = WS_W2P + AL((size_t)DEPTH * 2 * 8192 * 2);
constexpr size_t WS_SP = WS_RGW + AL((size_t)DEPTH * 2 * 8 * 4096 * 2);
constexpr size_t WS_MB = WS_SP + AL((size_t)DEPTH * 512 * 4);
constexpr size_t WS_XB = WS_MB + AL(256);
constexpr size_t WS_RSTD = WS_XB + AL((size_t)NT * DM * 2);
constexpr size_t WS_Z = WS_RSTD + AL((size_t)NT * 4);
constexpr size_t WS_QN = WS_Z + AL((size_t)NT * ZW * 2);
constexpr size_t WS_KS = WS_QN + AL((size_t)NT * 512 * 2);
constexpr size_t WS_KW = WS_KS + AL((size_t)NT * 128 * 2);
constexpr size_t WS_VST = WS_KW + AL((size_t)NT * 128 * 2);
constexpr size_t WS_VWT = WS_VST + AL((size_t)NT * 128 * 2);
constexpr size_t WS_KC = WS_VWT + AL((size_t)NT * 128 * 2);
constexpr size_t WS_VCT = WS_KC + AL((size_t)8 * 512 * 64 * 2);
constexpr size_t WS_HLOC = WS_VCT + AL((size_t)8 * 512 * 64 * 2);
constexpr size_t WS_PC = WS_HLOC + AL((size_t)NT * 512 * 2);
constexpr size_t WS_SUMH = WS_PC + AL((size_t)NT * 512 * 2);
constexpr size_t WS_SUMP = WS_SUMH + AL((size_t)NB * NCH * 512 * 4);
constexpr size_t WS_Y = WS_SUMP + AL((size_t)NB * NCH * 512 * 4);
constexpr size_t WS_BAR = WS_Y + AL((size_t)NT * DM * 2);
constexpr size_t WS_ROWP = WS_BAR + 16384;
constexpr size_t WS_KS2 = WS_ROWP + AL((size_t)NT * 16 * 4);
constexpr size_t WS_VST2 = WS_KS2 + AL((size_t)NT * 128 * 2);
constexpr size_t WS_END = WS_VST2 + AL((size_t)NT * 128 * 2);

struct Params {
    const float *x, *norm_g, *w_in, *conv_w, *conv_b, *rg_wr, *rg_br, *rg_wi, *rg_bi, *rg_lam, *q_g, *k_g, *pe_k, *w1_k, *w2_k, *pe_v,
        *w1_v, *w2_v, *w_out;
    float* out;
    unsigned char* ws;
};

typedef float f32x2v_ __attribute__((ext_vector_type(2)));
typedef __bf16 bf16x2v_ __attribute__((ext_vector_type(2)));
__device__ __forceinline__ unsigned pk2(float lo, float hi) {
    const f32x2v_ v = {lo, hi};
    return __builtin_bit_cast(unsigned, __builtin_convertvector(v, bf16x2v_));
}
__device__ __forceinline__ bf16_t f2bf(float f) { return (bf16_t)(pk2(f, 0.f) & 0xffffu); }
__device__ __forceinline__ float bf2f(unsigned h) { return __uint_as_float(h << 16); }
__device__ __forceinline__ float bflo(unsigned w) { return __uint_as_float(w << 16); }
__device__ __forceinline__ float bfhi(unsigned w) { return __uint_as_float(w & 0xffff0000u); }
__device__ __forceinline__ float sigmoidf_(float v) { return __builtin_amdgcn_rcpf(1.f + __expf(-v)); }
__device__ __forceinline__ float siluf_(float v) { return v * __builtin_amdgcn_rcpf(1.f + __expf(-v)); }
__device__ __forceinline__ bf16x8 as_bf16x8(u32x4 v) { return __builtin_bit_cast(bf16x8, v); }
__device__ __forceinline__ float shf(float v, int src) { return __builtin_bit_cast(float, __builtin_amdgcn_ds_bpermute(src << 2, __builtin_bit_cast(int, v))); }
__device__ __forceinline__ unsigned shu(unsigned v, int src) { return (unsigned)__builtin_amdgcn_ds_bpermute(src << 2, (int)v); }
#define MFMA16(a, b, c) __builtin_amdgcn_mfma_f32_16x16x32_bf16((a), (b), (c), 0, 0, 0)
#define LDS_FENCE() asm volatile("s_waitcnt lgkmcnt(0)" ::: "memory")
struct Ids { int tid, bid; };
__device__ __forceinline__ Ids fresh_ids() {
    Ids i;
    const int lane = __builtin_amdgcn_mbcnt_hi(~0u, __builtin_amdgcn_mbcnt_lo(~0u, 0u));
    int wv = __builtin_amdgcn_readfirstlane(threadIdx.x >> 6);
    i.tid = wv * 64 + lane; i.bid = blockIdx.x;
    asm volatile("" : "+v"(i.tid), "+s"(i.bid));
    return i;
}
#define XB_TMO      128
#define XB_XCNT(j)  (256  + 64 * (j))
#define XB_XSUB(j)  (1280 + 64 * (j))
#define XB_XGEN(j)  (2304 + 64 * (j))
#define XB_TOP      3328
#define XB_TOPGEN   3392
#define XCD_BAR_WORDS 3456
#define XB_SPIN_CAP (1u << 20)
__device__ __forceinline__ unsigned xb_ld(unsigned* p) { return __hip_atomic_load(p, __ATOMIC_RELAXED, __HIP_MEMORY_SCOPE_AGENT); }
__device__ __forceinline__ unsigned xb_add(unsigned* p, unsigned v) { return __hip_atomic_fetch_add(p, v, __ATOMIC_RELAXED, __HIP_MEMORY_SCOPE_AGENT); }
__device__ __forceinline__ unsigned xb_xcc_id() { return (unsigned)__builtin_amdgcn_s_getreg((3 << 11) | 20) & 0xFu; }
#define XB_SPIN(cond, bar) do { unsigned _sp = 0; while (cond) { __builtin_amdgcn_s_sleep(1); \
    if ((++_sp & 255u) == 0u) { if (xb_ld(&(bar)[XB_TMO])) break; if (_sp > XB_SPIN_CAP) { atomicAdd(&(bar)[XB_TMO], 1u); break; } } } } while (0)
__device__ __forceinline__ void xcd_barrier_complete(unsigned* bar, unsigned x, unsigned& nloc, unsigned& nx) {
    const unsigned G = gridDim.x;
    unsigned sum, cnt, mine, sp = 0u;
    for (;;) {
        sum = 0u; cnt = 0u; mine = 0u;
#pragma unroll
        for (unsigned j = 0; j < 16; ++j) { const unsigned c = xb_ld(&bar[XB_XCNT(j)]); sum += c; cnt += (c > 0u) ? 1u : 0u; mine = (j == x) ? c : mine; }
        if (sum == G) break;
        __builtin_amdgcn_s_sleep(1);
        if ((++sp & 255u) == 0u) { if (xb_ld(&bar[XB_TMO])) break; if (sp > XB_SPIN_CAP) { atomicAdd(&bar[XB_TMO], 1u); break; } }
    }
    nloc = mine > 0u ? mine : 1u; nx = cnt > 0u ? cnt : 1u;
}
__device__ __forceinline__ void grid_barrier(unsigned* bar, volatile unsigned* st) {
    asm volatile("s_waitcnt vmcnt(0)" ::: "memory");
    __syncthreads();
    const Ids ids = fresh_ids();
    if (ids.tid == 0) {
        const unsigned x = xb_xcc_id();
        __builtin_amdgcn_s_waitcnt(0);
        unsigned nloc = st[0], nx = st[1];
        if (nloc == 0u) { xcd_barrier_complete(bar, x, nloc, nx); st[0] = nloc; st[1] = nx; }
        const unsigned old = xb_add(&bar[XB_XSUB(x)], 1u);
        const unsigned gen = old / nloc;
        if (old + 1u == (gen + 1u) * nloc) {
            __builtin_amdgcn_fence(__ATOMIC_RELEASE, "agent");
            asm volatile("s_waitcnt vmcnt(0)" ::: "memory");
            const unsigned og = xb_add(&bar[XB_TOP], 1u);
            const unsigned tg = og / nx;
            if (og + 1u == (tg + 1u) * nx) xb_add(&bar[XB_TOPGEN], 1u);
            else XB_SPIN(xb_ld(&bar[XB_TOPGEN]) == tg, bar);
            __builtin_amdgcn_fence(__ATOMIC_ACQUIRE, "agent");
            xb_add(&bar[XB_XGEN(x)], 1u);
            asm volatile("s_waitcnt vmcnt(0)" ::: "memory");
        } else {
            XB_SPIN(xb_ld(&bar[XB_XGEN(x)]) == gen, bar);
            __builtin_amdgcn_fence(__ATOMIC_ACQUIRE, "agent");
            asm volatile("s_waitcnt vmcnt(0)" ::: "memory");
        }
    }
    __syncthreads();
}

template <bool FRAG = false>
__device__ __forceinline__ void transpose_tile(const float* W, int K, int N, const float* kscale, bf16_t* Wt, int k0, int n0, float* t, int lane) {
    const int n = n0 + lane;
    float wv[64];
#pragma unroll
    for (int kk = 0; kk < 64; ++kk) wv[kk] = (n < N) ? W[(size_t)(k0 + kk) * N + n] : 0.f;
    __builtin_amdgcn_sched_barrier(0);
    if (kscale) {
        const float ks = kscale[k0 + lane];
#pragma unroll
        for (int kk = 0; kk < 64; ++kk) wv[kk] *= shf(ks, kk);
    }
#pragma unroll
    for (int kk = 0; kk < 64; ++kk) t[kk * 65 + lane] = wv[kk];
    LDS_FENCE();
    const int r = lane >> 3, c8 = lane & 7;
#pragma unroll
    for (int it = 0; it < 8; ++it) {
        const int nn = it * 8 + r;
        const float* src = t + (c8 * 8) * 65 + nn;
        u32x4 o;
        o.x = pk2(src[0], src[65]); o.y = pk2(src[2 * 65], src[3 * 65]); o.z = pk2(src[4 * 65], src[5 * 65]); o.w = pk2(src[6 * 65], src[7 * 65]);
        if (FRAG) { const int n_ = n0 + nn, k_ = k0 + c8 * 8; *(u32x4*)(Wt + ((size_t)(((n_ >> 4) * (K >> 5) + (k_ >> 5)) * 4 + ((k_ >> 3) & 3)) * 16 + (n_ & 15)) * 8) = o; }
        else *(u32x4*)(Wt + (size_t)(n0 + nn) * K + k0 + c8 * 8) = o;
    }
    LDS_FENCE();
}

__device__ __forceinline__ void xrow_item(const float* xr, bf16_t* xb, float* rstd, int lane) {
    const f32x4* p = (const f32x4*)xr;
    f32x4 v[4];
    float s = 0.f;
#pragma unroll
    for (int j = 0; j < 4; ++j) { v[j] = __builtin_nontemporal_load(p + j * 64 + lane); s += v[j].x * v[j].x + v[j].y * v[j].y + v[j].z * v[j].z + v[j].w * v[j].w; }
#pragma unroll
    for (int o = 1; o < 64; o <<= 1) s += shf(s, lane ^ o);
    u32x2* q = (u32x2*)xb;
#pragma unroll
    for (int j = 0; j < 4; ++j) { u32x2 w; w.x = pk2(v[j].x, v[j].y); w.y = pk2(v[j].z, v[j].w); q[j * 64 + lane] = w; }
    if (lane == 0) *rstd = 1.0f / sqrtf(s * (1.0f / DM) + EPS);
}

__device__ __forceinline__ void phase_xprep(const Params& p, const float* xin) {
    const Ids ids = fresh_ids();
    const int lane = ids.tid & 63, gw = ids.bid * NWAVE + (ids.tid >> 6), nw = gridDim.x * NWAVE;
    bf16_t* xb = (bf16_t*)(p.ws + WS_XB);
    float* rstd = (float*)(p.ws + WS_RSTD);
    if (gridDim.x == 256) {
        const int xw = (ids.bid >> 3) * NWAVE + (ids.tid >> 6);
        for (int k = 0; k < 16; ++k) { const int r = 4096 * (ids.bid & 7) + xw + 256 * k; xrow_item(xin + (size_t)r * DM, xb + (size_t)r * DM, rstd + r, lane); }
    } else
    for (int r = gw; r < NT; r += nw) xrow_item(xin + (size_t)r * DM, xb + (size_t)r * DM, rstd + r, lane);
}

__device__ __forceinline__ void phase_prologue(const Params& p, unsigned char* lds) {
    const Ids ids = fresh_ids();
    const int gtid = ids.bid * NTHR + ids.tid, gth = gridDim.x * NTHR;
    const int wid = ids.tid >> 6, lane = ids.tid & 63, gw = ids.bid * NWAVE + wid, nw = gridDim.x * NWAVE;
    {
        float* t = (float*)(lds + wid * 17408);
        constexpr int T_IN = 16 * 48, T_OUT = 16 * 16, T_W1 = 32 * 2, T_L = T_IN + T_OUT + 2 * T_W1, N_B1 = DEPTH * 2 * 2 * 16;
        for (int it = gw; it < DEPTH * T_L + N_B1; it += nw) {
            if (it < DEPTH * T_L) {
                const int l = it / T_L; int r = it % T_L;
                if (r < T_IN) { transpose_tile(p.w_in + (size_t)l * DM * NIN, DM, NIN, p.norm_g + l * DM, (bf16_t*)(p.ws + WS_WTIN) + (size_t)l * ZW * DM, (r / 48) * 64, (r % 48) * 64, t, lane); continue; }
                r -= T_IN;
                if (r < T_OUT) { transpose_tile(p.w_out + (size_t)l * DM * DM, DM, DM, nullptr, (bf16_t*)(p.ws + WS_WTOUT) + (size_t)l * DM * DM, (r / 16) * 64, (r % 16) * 64, t, lane); continue; }
                r -= T_OUT;
                const int kv = r / T_W1; r %= T_W1;
                transpose_tile<true>((kv ? p.w1_v : p.w1_k) + (size_t)l * 2048 * 128, 2048, 128, nullptr, (bf16_t*)(p.ws + WS_W1T) + (size_t)(l * 2 + kv) * 128 * 2048, (r / 2) * 64, (r % 2) * 64, t, lane);
            } else {
                const int r = it - DEPTH * T_L, ks = r & 15, hg = (r >> 4) & 1, kv = (r >> 5) & 1, l = r >> 6, hu = hg * 64 + lane;
                const float* pe = (kv ? p.pe_v : p.pe_k) + (size_t)l * 2048 + ks * 128;
                const float* w1 = (kv ? p.w1_v : p.w1_k) + (size_t)l * 2048 * 128 + (size_t)ks * 128 * 128 + hu;
                float sacc = 0.f;
#pragma unroll 32
                for (int k = 0; k < 128; ++k) sacc += pe[k] * w1[(size_t)k * 128];
                ((float*)(p.ws + WS_B1))[((l * 2 + kv) * 16 + ks) * 128 + hu] = sacc;
            }
        }
    }
    float* rope = (float*)(p.ws + WS_ROPE);
    for (int it = gtid; it < SEQ * 8; it += gth) {
        const int pos = it >> 3, i = it & 7;
        const float inv = powf(500000.0f, -(float)i / 8.0f);
        const float ang = (float)pos * inv;
        float sn, cs;
        sincosf(ang, &sn, &cs);
        rope[pos * 16 + i] = cs;
        rope[pos * 16 + 8 + i] = sn;
    }
    bf16_t* w2p = (bf16_t*)(p.ws + WS_W2P);
    for (int it = gtid; it < DEPTH * 2 * 8192; it += gth) {
        const int jj = it & 7, quad = (it >> 3) & 3, r = (it >> 5) & 15, dt = (it >> 9) & 3, s = (it >> 11) & 3, kv = (it >> 13) & 1, l = it >> 14;
        const int hu = 16 * (2 * s + (jj >> 2)) + 4 * quad + (jj & 3), d = 16 * dt + r;
        const float* w2 = (kv ? p.w2_v : p.w2_k) + (size_t)l * 128 * 64;
        w2p[it] = f2bf(w2[hu * 64 + d]);
    }
    bf16_t* rgw = (bf16_t*)(p.ws + WS_RGW);
    for (int it = gtid; it < DEPTH * 2 * 8 * 4096; it += gth) {
        const int in = it & 63, out = (it >> 6) & 63, n = (it >> 12) & 7, gate = (it >> 15) & 1, l = it >> 16;
        const float* w = (gate ? p.rg_wi : p.rg_wr) + (size_t)l * 8 * 4096 + n * 4096;
        rgw[it] = f2bf(w[in * 64 + out]);
    }
    float* sp = (float*)(p.ws + WS_SP);
    for (int it = gtid; it < DEPTH * 512; it += gth) {
        const float v = -p.rg_lam[it];
        sp[it] = (v > 20.f) ? v : log1pf(expf(v));
    }
    if (gw < DEPTH * 4) {
        const int l = gw >> 2, br = gw & 3;
        float mq = fabsf(p.q_g[l * 64 + lane]), mk = (br < 3) ? fabsf(p.k_g[(l * 3 + br) * 64 + lane]) : 0.f;
#pragma unroll
        for (int o = 1; o < 64; o <<= 1) { mq = fmaxf(mq, shf(mq, lane ^ o)); mk = fmaxf(mk, shf(mk, lane ^ o)); }
        if (lane == 0) ((float*)(p.ws + WS_MB))[gw] = 8.0f * mq * mk * LOG2E * 1.0001f;
    }
    phase_xprep(p, p.x);
}

namespace pg8 {
#define PG8_LAS __attribute__((address_space(3)))
constexpr int BM = 256, BK = 64, HALF = 128, HTB = HALF * BK * 2, STAGE_BYTES = 8 * HTB, NXCD = 8, WGM = 4;
__host__ __device__ __forceinline__ int lds_byte(int r, int c) { const int st = (r >> 4) * 2 + (c >> 5), rr = r & 15, cc = c & 31, ob = rr * 64 + cc * 2; return st * 1024 + (ob ^ (((ob >> 9) & 1) << 5)); }
__host__ __device__ __forceinline__ void stage_rc(int b, int& R, int& C) { const int st = b / 1024, sb = b % 1024, swz = sb ^ (((sb >> 9) & 1) << 5); R = (st >> 1) * 16 + swz / 64; C = (st & 1) * 32 + (swz % 64) / 2; }
__host__ __device__ __forceinline__ int perm32(int rho) { const int n = rho >> 4, i = rho & 15; return 8 * (i >> 2) + 4 * n + (i & 3); }
struct Unit { int pm, pn; };
struct Gemm { const bf16_t* A; const bf16_t* Bt; int M, N, K; };
struct StaticOrder {
    int nM, nN, nwg, G, c;
    __host__ __device__ void init(int M, int N, int G_, int c_) { nM = M / BM; nN = N / BM; nwg = nM * nN; G = G_; c = c_; }
    __host__ __device__ bool next(int i, Unit& u) const {
        const long L = (long)i * G + c; if (L >= nwg) return false;
        int wgid = (int)L; { const int q = nwg / NXCD, r = nwg % NXCD, xcd = wgid % NXCD, off = wgid / NXCD; wgid = (xcd < r ? xcd * (q + 1) : r * (q + 1) + (xcd - r) * q) + off; }
        const int nig = WGM * nN, gid = wgid / nig, fm = gid * WGM, gsz = (nM - fm) < WGM ? (nM - fm) : WGM;
        u.pm = fm + ((wgid % nig) % gsz); u.pn = (wgid % nig) / gsz; return true;
    }
    __device__ __forceinline__ void a_ready(const Unit&) const {}
    __device__ __forceinline__ void done(const Unit&) const {}
};
struct EpiZ {
    static constexpr bool PERM = true, AFTER_DRAIN = false;
    bf16_t* O; int ldc; const float* rstd;
    __device__ __forceinline__ void operator()(const f32x4 (&acc)[2][2][4][2], const Unit& u, int wr, int wc, int fr, int fq) const {
        const int row0 = u.pm * BM + wr * 64 + fr, col0 = u.pn * BM + wc * 32 + 8 * fq;
        float rs8[8];
#pragma unroll
        for (int i = 0; i < 8; ++i) rs8[i] = rstd[row0 + (i >> 2) * HALF + (i & 3) * 16];
        __builtin_amdgcn_sched_barrier(0);
#pragma unroll
        for (int ai = 0; ai < 2; ++ai)
#pragma unroll
            for (int m = 0; m < 4; ++m) {
                const int row = row0 + ai * HALF + m * 16;
                const float rs = rs8[ai * 4 + m];
                bf16_t* rowp = O + (size_t)row * ldc + col0;
#pragma unroll
                for (int bj = 0; bj < 2; ++bj) {
                    const f32x4 v0 = acc[ai][bj][m][0] * rs, v1 = acc[ai][bj][m][1] * rs;
                    u32x4 w; w.x = pk2(v0[0], v0[1]); w.y = pk2(v0[2], v0[3]); w.z = pk2(v1[0], v1[1]); w.w = pk2(v1[2], v1[3]);
                    *(u32x4*)(rowp + bj * HALF) = w;
                }
            }
    }
};
template <bool NEXT, bool XBF> struct EpiRes {
    static constexpr bool PERM = true, AFTER_DRAIN = false;
    const float* X; float* C; int ldc; bf16_t* XB; float* rowp;
    struct RowIn { u32x4 h[2]; f32x4 f[4]; };
    __device__ __forceinline__ void load_row(RowIn& r, size_t off) const {
#pragma unroll
        for (int bj = 0; bj < 2; ++bj) {
            if (XBF) r.h[bj] = *(const u32x4*)(XB + off + bj * HALF);
            else { r.f[2 * bj] = *(const f32x4*)(X + off + bj * HALF); r.f[2 * bj + 1] = *(const f32x4*)(X + off + bj * HALF + 4); }
        }
    }
    __device__ __forceinline__ void operator()(const f32x4 (&acc)[2][2][4][2], const Unit& u, int wr, int wc, int fr, int fq) const {
        const int row0 = u.pm * BM + wr * 64 + fr, col0 = u.pn * BM + wc * 32 + 8 * fq, lane = fq * 16 + fr;
        constexpr int DEPTH = XBF ? 7 : 3;
        RowIn q[DEPTH + 1];
#pragma unroll
        for (int i = 0; i < DEPTH; ++i) load_row(q[i], (size_t)(row0 + (i >> 2) * HALF + (i & 3) * 16) * ldc + col0);
#pragma unroll
        for (int i = 0; i < 8; ++i) {
            const int ai = i >> 2, m = i & 3;
            const int row = row0 + ai * HALF + m * 16;
            const size_t off = (size_t)row * ldc + col0;
            if (i + DEPTH < 8) load_row(q[(i + DEPTH) % (DEPTH + 1)], (size_t)(row0 + ((i + DEPTH) >> 2) * HALF + ((i + DEPTH) & 3) * 16) * ldc + col0);
            __builtin_amdgcn_sched_barrier(0);
            const RowIn& cur = q[i % (DEPTH + 1)];
            float ss = 0.f;
#pragma unroll
            for (int bj = 0; bj < 2; ++bj) {
                f32x4 x0, x1;
                if (XBF) { const u32x4 xw = cur.h[bj];
                           x0 = (f32x4){bflo(xw.x), bfhi(xw.x), bflo(xw.y), bfhi(xw.y)}; x1 = (f32x4){bflo(xw.z), bfhi(xw.z), bflo(xw.w), bfhi(xw.w)}; }
                else { x0 = cur.f[2 * bj]; x1 = cur.f[2 * bj + 1]; }
                const f32x4 v0 = x0 + acc[ai][bj][m][0], v1 = x1 + acc[ai][bj][m][1];
                if (NEXT) {
                    ss += (v0.x * v0.x + v0.y * v0.y) + (v0.z * v0.z + v0.w * v0.w);
                    ss += (v1.x * v1.x + v1.y * v1.y) + (v1.z * v1.z + v1.w * v1.w);
                    u32x4 w; w.x = pk2(v0.x, v0.y); w.y = pk2(v0.z, v0.w); w.z = pk2(v1.x, v1.y); w.w = pk2(v1.z, v1.w);
                    *(u32x4*)(XB + off + bj * HALF) = w;
                } else {
                    *(f32x4*)(C + off + bj * HALF) = v0; *(f32x4*)(C + off + bj * HALF + 4) = v1;
                }
            }
            if (NEXT) {
                ss += shf(ss, lane ^ 16); ss += shf(ss, lane ^ 32);
                if (fq == 0) rowp[(size_t)row * 16 + u.pn * 4 + wc] = ss;
            }
            __builtin_amdgcn_sched_barrier(0);
        }
    }
};
template <class Epi, class Sched, bool ALIGN_EPI = false, bool SP2 = false>
__device__ __forceinline__ void gemm_phase(PG8_LAS unsigned char* lds, const Gemm g, const Sched& S, const Epi& E, const int tid) {
    const int wid = __builtin_amdgcn_readfirstlane(tid >> 6), lane = tid & 63, wr = wid >> 2, wc = wid & 3, fr = lane & 15, fq = lane >> 4;
    const int K = g.K, nt = K / BK;
    unsigned voffA[2], voffB[2];
#pragma unroll
    for (int i = 0; i < 2; ++i) { int R, C; stage_rc(tid * 16 + i * 8192, R, C); const int Rb = Epi::PERM ? ((R & ~31) + perm32(R & 31)) : R;
        voffA[i] = (unsigned)(R * K + C) * 2u; voffB[i] = (unsigned)(Rb * K + C) * 2u; }
    const size_t kstep = (size_t)(BK * 2);
    const size_t hstep = (size_t)HALF * K * 2;
    const size_t tstep = 2 * hstep;
    const unsigned ldsw = (unsigned)wid * 1024u;
    const int aoff = lds_byte(wr * 64 + fr, fq * 8), boff = lds_byte(wc * 32 + fr, fq * 8);
#define PG8_SA(b, h) (((b) * 2 + (h)) * HTB)
#define PG8_SB(b, h) ((4 + (b) * 2 + (h)) * HTB)
#define PG8_STAGE(bufoff, gbase, voff) do { _Pragma("unroll") for (int _i = 0; _i < 2; ++_i) \
        __builtin_amdgcn_global_load_lds((const unsigned*)((const char*)(gbase) + (voff)[_i]), (PG8_LAS unsigned*)(lds + (bufoff) + ldsw + _i * 8192), 16, 0, 0); } while (0)
#define PG8_LDA(dst, b, h) do { _Pragma("unroll") for (int m = 0; m < 4; ++m) _Pragma("unroll") for (int k = 0; k < 2; ++k) dst[m][k] = *(const PG8_LAS bf16x8*)(lds + PG8_SA(b, h) + aoff + m * 2048 + k * 1024); } while (0)
#define PG8_LDB(dst, b, h) do { _Pragma("unroll") for (int n = 0; n < 2; ++n) _Pragma("unroll") for (int k = 0; k < 2; ++k) dst[n][k] = *(const PG8_LAS bf16x8*)(lds + PG8_SB(b, h) + boff + n * 2048 + k * 1024); } while (0)
#define PG8_MMA(ai, bj, At, Bt) do { __builtin_amdgcn_s_setprio(1); _Pragma("unroll") for (int m = 0; m < 4; ++m) _Pragma("unroll") for (int n = 0; n < 2; ++n) _Pragma("unroll") for (int k = 0; k < 2; ++k) \
        acc[ai][bj][m][n] = __builtin_amdgcn_mfma_f32_16x16x32_bf16(Bt[n][k], At[m][k], acc[ai][bj][m][n], 0, 0, 0); __builtin_amdgcn_s_setprio(0); } while (0)
#define PG8_WAIT_V(n) asm volatile("s_waitcnt vmcnt(" #n ")" ::: "memory")
#define PG8_WAIT_L(n) asm volatile("s_waitcnt lgkmcnt(" #n ")" ::: "memory")
#define PG8_BAR __builtin_amdgcn_s_barrier()
#define PG8_SCHED __builtin_amdgcn_sched_barrier(0)
    Unit cur, nxt; int ui = 0;
    if (!S.next(0, cur)) return;
    f32x4 acc[2][2][4][2];
#pragma unroll
    for (int a = 0; a < 2; ++a)
#pragma unroll
        for (int b = 0; b < 2; ++b)
#pragma unroll
            for (int m = 0; m < 4; ++m)
#pragma unroll
                for (int n = 0; n < 2; ++n) acc[a][b][m][n] = (f32x4){0.f, 0.f, 0.f, 0.f};
    bf16x8 At[4][2], B0[2][2], B1[2][2];
    const char* cA = (const char*)g.A + (size_t)cur.pm * tstep; const char* cB = (const char*)g.Bt + (size_t)cur.pn * tstep;
    S.a_ready(cur);
    if constexpr (SP2) {
        PG8_STAGE(PG8_SB(0, 0), cB, voffB); PG8_STAGE(PG8_SB(0, 1), cB + hstep, voffB); PG8_STAGE(PG8_SA(0, 0), cA, voffA); PG8_STAGE(PG8_SA(0, 1), cA + hstep, voffA);
        if (wr == 1) PG8_BAR;
        PG8_WAIT_V(2); PG8_BAR;
        PG8_STAGE(PG8_SB(1, 0), cB + kstep, voffB); PG8_STAGE(PG8_SA(1, 0), cA + kstep, voffA); PG8_STAGE(PG8_SB(1, 1), cB + hstep + kstep, voffB);
        PG8_WAIT_V(6); PG8_BAR;
    } else {
        PG8_STAGE(PG8_SB(0, 0), cB, voffB); PG8_STAGE(PG8_SA(0, 0), cA, voffA); PG8_STAGE(PG8_SB(0, 1), cB + hstep, voffB); PG8_STAGE(PG8_SA(0, 1), cA + hstep, voffA);
        if (wr == 1) PG8_BAR;
        PG8_WAIT_V(4); PG8_BAR;
        PG8_STAGE(PG8_SB(1, 0), cB + kstep, voffB); PG8_STAGE(PG8_SA(1, 0), cA + kstep, voffA); PG8_STAGE(PG8_SB(1, 1), cB + hstep + kstep, voffB);
        PG8_WAIT_V(6); PG8_BAR;
    }
    for (;;) {
        const bool has_next = S.next(ui + 1, nxt);
        const char* nA = has_next ? (const char*)g.A + (size_t)nxt.pm * tstep : cA; const char* nB = has_next ? (const char*)g.Bt + (size_t)nxt.pn * tstep : cB;
        for (int t = 0; t < nt; t += 2) {
            const bool last = (t == nt - 2);
            const char* a1 = cA + (size_t)(t + 1) * kstep;
            const char* a2 = last ? nA : cA + (size_t)(t + 2) * kstep; const char* b2 = last ? nB : cB + (size_t)(t + 2) * kstep;
            const char* a3 = a2 + kstep; const char* b3 = b2 + kstep;
            if (last && has_next) S.a_ready(nxt);
            if constexpr (SP2) {
            PG8_LDB(B0, 0, 0); PG8_LDB(B1, 0, 1); PG8_SCHED; PG8_LDA(At, 0, 0); PG8_STAGE(PG8_SA(1, 1), a1 + hstep, voffA);
            PG8_WAIT_V(8); PG8_WAIT_L(0); PG8_BAR; PG8_MMA(0, 0, At, B0); PG8_MMA(0, 1, At, B1); PG8_BAR; PG8_SCHED;
            PG8_LDA(At, 0, 1); PG8_STAGE(PG8_SB(0, 0), b2, voffB); PG8_STAGE(PG8_SB(0, 1), b2 + hstep, voffB); PG8_STAGE(PG8_SA(0, 0), a2, voffA);
            PG8_WAIT_V(8); PG8_WAIT_L(0); PG8_BAR; PG8_MMA(1, 0, At, B0); PG8_MMA(1, 1, At, B1); PG8_BAR; PG8_SCHED;
            PG8_LDB(B0, 1, 0); PG8_LDB(B1, 1, 1); PG8_SCHED; PG8_LDA(At, 1, 0); PG8_STAGE(PG8_SA(0, 1), a2 + hstep, voffA);
            PG8_WAIT_V(8); PG8_WAIT_L(0); PG8_BAR; PG8_MMA(0, 0, At, B0); PG8_MMA(0, 1, At, B1); PG8_BAR; PG8_SCHED;
            PG8_LDA(At, 1, 1); PG8_STAGE(PG8_SB(1, 0), b3, voffB); PG8_STAGE(PG8_SB(1, 1), b3 + hstep, voffB); PG8_STAGE(PG8_SA(1, 0), a3, voffA);
            PG8_WAIT_V(8); PG8_WAIT_L(0); PG8_BAR; PG8_MMA(1, 0, At, B0); PG8_MMA(1, 1, At, B1); PG8_BAR; PG8_SCHED;
            } else {
            PG8_LDB(B0, 0, 0); PG8_SCHED; PG8_LDA(At, 0, 0); PG8_STAGE(PG8_SA(1, 1), a1 + hstep, voffA);
            PG8_WAIT_L(8); PG8_BAR; PG8_WAIT_L(0); PG8_MMA(0, 0, At, B0); PG8_BAR; PG8_SCHED;
            PG8_LDB(B1, 0, 1); PG8_STAGE(PG8_SB(0, 0), b2, voffB);
            PG8_BAR; PG8_WAIT_L(0); PG8_MMA(0, 1, At, B1); PG8_BAR;
            PG8_LDA(At, 0, 1); PG8_STAGE(PG8_SA(0, 0), a2, voffA);
            PG8_BAR; PG8_WAIT_L(0); PG8_MMA(1, 0, At, B0); PG8_BAR; PG8_SCHED;
            PG8_STAGE(PG8_SB(0, 1), b2 + hstep, voffB);
            PG8_WAIT_V(6); PG8_BAR; PG8_MMA(1, 1, At, B1); PG8_BAR;
            PG8_LDB(B0, 1, 0); PG8_SCHED; PG8_LDA(At, 1, 0); PG8_STAGE(PG8_SA(0, 1), a2 + hstep, voffA);
            PG8_WAIT_L(8); PG8_BAR; PG8_WAIT_L(0); PG8_MMA(0, 0, At, B0); PG8_BAR; PG8_SCHED;
            PG8_LDB(B1, 1, 1); PG8_STAGE(PG8_SB(1, 0), b3, voffB);
            PG8_BAR; PG8_WAIT_L(0); PG8_MMA(0, 1, At, B1); PG8_BAR;
            PG8_LDA(At, 1, 1); PG8_STAGE(PG8_SA(1, 0), a3, voffA);
            PG8_BAR; PG8_WAIT_L(0); PG8_MMA(1, 0, At, B0); PG8_BAR; PG8_SCHED;
            PG8_STAGE(PG8_SB(1, 1), b3 + hstep, voffB);
            PG8_WAIT_V(6); PG8_BAR; PG8_MMA(1, 1, At, B1); PG8_BAR;
            }
        }
        if constexpr (ALIGN_EPI) { if (wr == 0) PG8_BAR; }
        if constexpr (!Epi::AFTER_DRAIN) { E(acc, cur, wr, wc, fr, fq); S.done(cur); }
        if (!has_next) break;
#pragma unroll
        for (int a = 0; a < 2; ++a)
#pragma unroll
            for (int b = 0; b < 2; ++b)
#pragma unroll
                for (int m = 0; m < 4; ++m)
#pragma unroll
                    for (int n = 0; n < 2; ++n) acc[a][b][m][n] = (f32x4){0.f, 0.f, 0.f, 0.f};
        cur = nxt; cA = nA; cB = nB; ++ui;
        if constexpr (ALIGN_EPI) { if (wr == 1) PG8_BAR; }
    }
    PG8_WAIT_V(0);
    if constexpr (!ALIGN_EPI) { if (wr == 0) PG8_BAR; }
    PG8_BAR;
    if constexpr (Epi::AFTER_DRAIN) { E.fused(acc, cur, wr, wc, fr, fq, lds, wid, lane); S.done(cur); }
#undef PG8_SA
#undef PG8_SB
#undef PG8_STAGE
#undef PG8_LDA
#undef PG8_LDB
#undef PG8_MMA
#undef PG8_WAIT_V
#undef PG8_WAIT_L
#undef PG8_BAR
#undef PG8_SCHED
}
}

__device__ __forceinline__ void phase_gemm_in(const Params& p, int l, unsigned char* lds) {
    const Ids ids = fresh_ids();
    pg8::Gemm g{(const bf16_t*)(p.ws + WS_XB), (const bf16_t*)(p.ws + WS_WTIN) + (size_t)l * ZW * DM, NT, ZW, DM};
    pg8::StaticOrder S; S.init(NT, ZW, gridDim.x, ids.bid);
    if (l > 0) {
        pg8::Unit u;
        bool have = S.next(0, u);
        const f32x4 zz = (f32x4){0.f, 0.f, 0.f, 0.f};
        f32x4 a0 = zz, a1 = zz, a2 = zz, a3 = zz;
        int row = 0;
        if (have && ids.tid < 256) {
            row = u.pm * 256 + ids.tid;
            const f32x4* pp = (const f32x4*)((const float*)(p.ws + WS_ROWP) + (size_t)row * 16);
            a0 = pp[0]; a1 = pp[1]; a2 = pp[2]; a3 = pp[3];
        }
        for (int i = 1; have; ++i) {
            pg8::Unit un;
            const bool hn = S.next(i, un);
            f32x4 n0 = zz, n1 = zz, n2 = zz, n3 = zz;
            int rown = 0;
            if (hn && ids.tid < 256) {
                rown = un.pm * 256 + ids.tid;
                const f32x4* pp = (const f32x4*)((const float*)(p.ws + WS_ROWP) + (size_t)rown * 16);
                n0 = pp[0]; n1 = pp[1]; n2 = pp[2]; n3 = pp[3];
            }
            __builtin_amdgcn_sched_barrier(0);
            if (ids.tid < 256) {
                const float ssum = (((a0.x + a0.y) + (a0.z + a0.w)) + ((a1.x + a1.y) + (a1.z + a1.w))) + (((a2.x + a2.y) + (a2.z + a2.w)) + ((a3.x + a3.y) + (a3.z + a3.w)));
                ((float*)(p.ws + WS_RSTD))[row] = 1.0f / sqrtf(ssum * (1.0f / DM) + EPS);
            }
            a0 = n0; a1 = n1; a2 = n2; a3 = n3; row = rown; have = hn;
        }
        asm volatile("s_waitcnt vmcnt(0)" ::: "memory");
        __syncthreads();
    }
    pg8::EpiZ E{(bf16_t*)(p.ws + WS_Z), ZW, (const float*)(p.ws + WS_RSTD)};
    pg8::gemm_phase<pg8::EpiZ, pg8::StaticOrder, true, true>((PG8_LAS unsigned char*)lds, g, S, E, ids.tid);
}
__device__ __forceinline__ void phase_gemm_out(const Params& p, int l, unsigned char* lds, const float* xin, float* xout) {
    const Ids ids = fresh_ids();
    pg8::Gemm g{(const bf16_t*)(p.ws + WS_Y), (const bf16_t*)(p.ws + WS_WTOUT) + (size_t)l * DM * DM, NT, DM, DM};
    pg8::StaticOrder S; S.init(NT, DM, gridDim.x, ids.bid);
    bf16_t* xb = (bf16_t*)(p.ws + WS_XB); float* rowp = (float*)(p.ws + WS_ROWP);
    if (l + 1 < DEPTH) {
        { pg8::EpiRes<true, true>  E{xin, xout, DM, xb, rowp}; pg8::gemm_phase<pg8::EpiRes<true, true>,  pg8::StaticOrder, true, true>((PG8_LAS unsigned char*)lds, g, S, E, ids.tid); }
    } else {
        if (l == 0) { pg8::EpiRes<false, false> E{xin, xout, DM, xb, rowp}; pg8::gemm_phase<pg8::EpiRes<false, false>, pg8::StaticOrder, true, true>((PG8_LAS unsigned char*)lds, g, S, E, ids.tid); }
        else        { pg8::EpiRes<false, true>  E{xin, xout, DM, xb, rowp}; pg8::gemm_phase<pg8::EpiRes<false, true>,  pg8::StaticOrder, true, true>((PG8_LAS unsigned char*)lds, g, S, E, ids.tid); }
    }
}

__device__ __forceinline__ void qkv_item(const Params& p, int l, int tt, int slot, unsigned char* wlds  , int lane) {
    asm volatile("" : "+v"(lane));
    const bf16_t* z = (const bf16_t*)(p.ws + WS_Z);
    const int t = tt * 64 + lane, b = t / SEQ, s = t % SEQ;
    int col; const float* gp = nullptr;
    if (slot < 8) { col = C_Q + slot * 64; gp = p.q_g + l * 64; }
    else if (slot < 10) { col = C_KS + (slot - 8) * 64; gp = p.k_g + (l * 3 + 1) * 64; }
    else if (slot < 12) { col = C_KW + (slot - 10) * 64; gp = p.k_g + (l * 3 + 2) * 64; }
    else if (slot < 14) { col = C_VS + (slot - 12) * 64; }
    else { col = C_VW + (slot - 14) * 64; }
    const int lr = lane >> 3, lc = lane & 7;
    {
        const bf16_t* zt = z + (size_t)(tt * 64) * ZW + col + lc * 8;
        u32x4 ld[8];
#pragma unroll
        for (int i = 0; i < 8; ++i) ld[i] = *(const u32x4*)(zt + (size_t)(8 * i + lr) * ZW);
#pragma unroll
        for (int i = 0; i < 8; ++i) *(u32x4*)(wlds + (8 * i + lr) * 144 + lc * 16) = ld[i];
    }
    if (slot < 12) {
        float* gl = (float*)(wlds + 9216);
        const float gmine = gp[lane];
        const f32x4* rp = (const f32x4*)((const float*)(p.ws + WS_ROPE) + s * 16);
        const f32x4 c0 = rp[0], c1 = rp[1], s0 = rp[2], s1 = rp[3];
        gl[lane] = gmine;
        LDS_FENCE();
        u32x4 raw[8];
#pragma unroll
        for (int i = 0; i < 8; ++i) raw[i] = *(const u32x4*)(wlds + lane * 144 + i * 16);
        float ss = 0.f;
#pragma unroll
        for (int i = 0; i < 8; ++i) {
            const unsigned w[4] = {raw[i].x, raw[i].y, raw[i].z, raw[i].w};
#pragma unroll
            for (int k = 0; k < 4; ++k) { const float lo = bflo(w[k]), hi = bfhi(w[k]); ss += lo * lo + hi * hi; }
        }
        const float rinv = (1.0f / sqrtf(ss * (1.0f / 64.0f) + EPS)) * ((slot < 8) ? 0.125f * LOG2E : 1.0f);
        const bool tiled = (slot == 8 || slot == 9);
        const int bu = (tt * 64) / SEQ, su = (tt * 64) % SEQ;
        auto chunk = [&](int i, float (&v)[8]) {
            const unsigned w[4] = {raw[i].x, raw[i].y, raw[i].z, raw[i].w};
            const f32x4 g0 = *(const f32x4*)(gl + 8 * i), g1 = *(const f32x4*)(gl + 8 * i + 4);
            v[0] = bflo(w[0]) * rinv * g0.x; v[1] = bfhi(w[0]) * rinv * g0.y; v[2] = bflo(w[1]) * rinv * g0.z; v[3] = bfhi(w[1]) * rinv * g0.w;
            v[4] = bflo(w[2]) * rinv * g1.x; v[5] = bfhi(w[2]) * rinv * g1.y; v[6] = bflo(w[3]) * rinv * g1.z; v[7] = bfhi(w[3]) * rinv * g1.w;
        };
        auto emit = [&](int i, const float (&v)[8]) {
            u32x4 o; o.x = pk2(v[0], v[1]); o.y = pk2(v[2], v[3]); o.z = pk2(v[4], v[5]); o.w = pk2(v[6], v[7]);
            *(u32x4*)(wlds + lane * 144 + i * 16) = o;
        };
        {
            float v0[8], v1[8];
            chunk(0, v0); chunk(1, v1);
            const float cs[8] = {c0.x, c0.y, c0.z, c0.w, c1.x, c1.y, c1.z, c1.w};
            const float sn[8] = {s0.x, s0.y, s0.z, s0.w, s1.x, s1.y, s1.z, s1.w};
#pragma unroll
            for (int i = 0; i < 8; ++i) { const float x1 = v0[i], x2 = v1[i]; v0[i] = x1 * cs[i] - x2 * sn[i]; v1[i] = x2 * cs[i] + x1 * sn[i]; }
            emit(0, v0); emit(1, v1);
        }
#pragma unroll
        for (int i = 2; i < 8; ++i) { float v[8]; chunk(i, v); emit(i, v); }
        LDS_FENCE();
        bf16_t* dtile = tiled ? (bf16_t*)(p.ws + WS_KS2) + ((size_t)(bu * 2 + (slot - 8)) * (SEQ / 64) + (su >> 6)) * 4096
                              : (bf16_t*)(p.ws + WS_KW) + ((size_t)(bu * 2 + (slot - 10)) * SEQ + su) * 64;
#pragma unroll
        for (int i = 0; i < 8; ++i) {
            const int row = 8 * i + lr;
            const u32x4 o = *(const u32x4*)(wlds + row * 144 + lc * 16);
            if (tiled) { const int st_ = row >> 5, r_ = row & 31, cidx_ = ((r_ >> 3) << 2) | (r_ & 3), T_ = (r_ >> 2) & 1;
                         *(u32x4*)(dtile + ((((st_ * 2 + T_) * 2 + (lc >> 2)) * 64 + (lc & 3) * 16 + cidx_) * 8)) = o; }
            else *(u32x4*)(dtile + row * 64 + lc * 8) = o;
        }
        LDS_FENCE();
    } else {
        LDS_FENCE();
        bf16_t* dstb = (slot < 14) ? (bf16_t*)(p.ws + WS_VST) + ((size_t)(b * 2 + (slot - 12)) * 64) * SEQ
                                   : (bf16_t*)(p.ws + WS_VWT) + ((size_t)(b * 2 + (slot - 14)) * 64) * SEQ;
        const int dr = lane >> 3, c8 = lane & 7, sbase = (tt * 64) % SEQ;
#pragma unroll
        for (int pd = 0; pd < 8; ++pd) {
            const int d = 8 * pd + dr;
            unsigned e[8];
#pragma unroll
            for (int k = 0; k < 8; ++k) e[k] = *(const unsigned short*)(wlds + (8 * c8 + k) * 144 + d * 2);
            u32x4 o; o.x = e[0] | (e[1] << 16); o.y = e[2] | (e[3] << 16); o.z = e[4] | (e[5] << 16); o.w = e[6] | (e[7] << 16);
            if (slot >= 14) *(u32x4*)(dstb + (size_t)d * SEQ + sbase + 8 * c8) = o;
            if (slot < 14) *(u32x4*)((bf16_t*)(p.ws + WS_VST2) + ((size_t)(b * 2 + (slot - 12)) * (SEQ / 64) + (sbase >> 6)) * 4096 + (((c8 >> 2) * 4 + (d >> 4)) * 64 + (c8 & 3) * 16 + (d & 15)) * 8) = o;
        }
        LDS_FENCE();
    }
}

__device__ __forceinline__ void rg_item(const Params& p, int l, int b, int ch, int n, float* xcf, int lane) {
    const bf16_t* z = (const bf16_t*)(p.ws + WS_Z);
    const int fr = lane & 15, quad = lane >> 4;
    const size_t t0 = (size_t)b * SEQ + (size_t)ch * 64;
    {
        const int r = lane >> 3, c8 = lane & 7, cc = n * 64 + c8 * 8;
        float w[4][8], cb[8];
#pragma unroll
        for (int k = 0; k < 4; ++k) {
            const f32x4 a0 = *(const f32x4*)(p.conv_w + (l * 4 + k) * 512 + cc), a1 = *(const f32x4*)(p.conv_w + (l * 4 + k) * 512 + cc + 4);
            w[k][0] = a0.x; w[k][1] = a0.y; w[k][2] = a0.z; w[k][3] = a0.w; w[k][4] = a1.x; w[k][5] = a1.y; w[k][6] = a1.z; w[k][7] = a1.w;
        }
        { const f32x4 a0 = *(const f32x4*)(p.conv_b + l * 512 + cc), a1 = *(const f32x4*)(p.conv_b + l * 512 + cc + 4);
          cb[0] = a0.x; cb[1] = a0.y; cb[2] = a0.z; cb[3] = a0.w; cb[4] = a1.x; cb[5] = a1.y; cb[6] = a1.z; cb[7] = a1.w; }
        const bf16_t* zc = z + t0 * ZW + C_RGX + cc;
        u32x4 xr[11];
#pragma unroll
        for (int k = 0; k < 11; ++k) {
            const int ts = r * 8 - 3 + k;
            const bool ok = (ts >= 0) || (ch > 0);
            xr[k] = ok ? *(const u32x4*)(zc + (ptrdiff_t)ts * ZW) : (u32x4){0u, 0u, 0u, 0u};
        }
        float xf[4][8];
#pragma unroll
        for (int k = 0; k < 3; ++k) {
            const unsigned ww[4] = {xr[k].x, xr[k].y, xr[k].z, xr[k].w};
#pragma unroll
            for (int q = 0; q < 4; ++q) { xf[k][2 * q] = bflo(ww[q]); xf[k][2 * q + 1] = bfhi(ww[q]); }
        }
#pragma unroll
        for (int i = 0; i < 8; ++i) {
            { const unsigned ww[4] = {xr[i + 3].x, xr[i + 3].y, xr[i + 3].z, xr[i + 3].w};
#pragma unroll
              for (int q = 0; q < 4; ++q) { xf[(i + 3) & 3][2 * q] = bflo(ww[q]); xf[(i + 3) & 3][2 * q + 1] = bfhi(ww[q]); } }
            float o[8];
#pragma unroll
            for (int e = 0; e < 8; ++e) o[e] = cb[e];
#pragma unroll
            for (int k = 0; k < 4; ++k)
#pragma unroll
                for (int e = 0; e < 8; ++e) o[e] += w[k][e] * xf[(i + k) & 3][e];
            f32x4* dst = (f32x4*)(xcf + (r * 8 + i) * 68 + c8 * 8);
            dst[0] = (f32x4){o[0], o[1], o[2], o[3]}; dst[1] = (f32x4){o[4], o[5], o[6], o[7]};
        }
    }
    LDS_FENCE();
    bf16x8 af[4][2];
#pragma unroll
    for (int m = 0; m < 4; ++m)
#pragma unroll
        for (int ks = 0; ks < 2; ++ks) {
            const f32x4* src = (const f32x4*)(xcf + (16 * m + fr) * 68 + 32 * ks + 8 * quad);
            const f32x4 a = src[0], c = src[1];
            u32x4 w; w.x = pk2(a.x, a.y); w.y = pk2(a.z, a.w); w.z = pk2(c.x, c.y); w.w = pk2(c.z, c.w);
            af[m][ks] = as_bf16x8(w);
        }
    const bf16_t* wr_ = (const bf16_t*)(p.ws + WS_RGW) + ((size_t)(l * 2 + 0) * 8 + n) * 4096;
    const bf16_t* wi_ = (const bf16_t*)(p.ws + WS_RGW) + ((size_t)(l * 2 + 1) * 8 + n) * 4096;
    bf16x8 brC[2], biC[2]; float brvC, bivC, spvC;
    auto ldw = [&](int nt, bf16x8 (&br)[2], bf16x8 (&bi)[2], float& brv, float& biv, float& spv) {
        const int c = n * 64 + 16 * nt + fr;
#pragma unroll
        for (int ks = 0; ks < 2; ++ks) {
            br[ks] = *(const bf16x8*)(wr_ + (16 * nt + fr) * 64 + 32 * ks + 8 * quad);
            bi[ks] = *(const bf16x8*)(wi_ + (16 * nt + fr) * 64 + 32 * ks + 8 * quad);
        }
        brv = p.rg_br[l * 512 + c]; biv = p.rg_bi[l * 512 + c]; spv = ((const float*)(p.ws + WS_SP))[l * 512 + c];
    };
    ldw(0, brC, biC, brvC, bivC, spvC);
#pragma unroll 1
    for (int nt = 0; nt < 4; ++nt) {
        const int c = n * 64 + 16 * nt + fr;
        bf16x8 brN[2], biN[2]; float brvN, bivN, spvN;
        ldw(nt < 3 ? nt + 1 : 3, brN, biN, brvN, bivN, spvN);
        __builtin_amdgcn_sched_barrier(0);
        f32x4 ar[4], ai[4];
#pragma unroll
        for (int m = 0; m < 4; ++m) { ar[m] = (f32x4){0.f, 0.f, 0.f, 0.f}; ai[m] = (f32x4){0.f, 0.f, 0.f, 0.f}; }
#pragma unroll
        for (int ks = 0; ks < 2; ++ks) {
#pragma unroll
            for (int m = 0; m < 4; ++m) { ar[m] = MFMA16(af[m][ks], brC[ks], ar[m]); ai[m] = MFMA16(af[m][ks], biC[ks], ai[m]); }
        }
        const float brv = brvC, biv = bivC, spv = spvC;
        float Am = 1.f, Hm = 0.f;
#pragma unroll
        for (int m = 0; m < 4; ++m) {
            float Pl[4], hl[4];
            float pa = 1.f, ph = 0.f;
#pragma unroll
            for (int j = 0; j < 4; ++j) {
                const float xcv = xcf[(16 * m + 4 * quad + j) * 68 + 16 * nt + fr];
                const float r = sigmoidf_(ar[m][j] + brv), ig = sigmoidf_(ai[m][j] + biv);
                const float la = -8.0f * r * spv;
                const float a = __expf(la);
                const float em = 1.0f - a * a;
                const float u = __builtin_amdgcn_sqrtf(em) * (ig * xcv);
                pa = pa * a; ph = a * ph + u;
                Pl[j] = pa; hl[j] = ph;
            }
            float Ai = pa, Hi = ph;
            {
                const float a1 = shf(Ai, lane - 16), h1 = shf(Hi, lane - 16);
                if (quad >= 1) { Hi = Ai * h1 + Hi; Ai = a1 * Ai; }
                const float a2 = shf(Ai, lane - 32), h2 = shf(Hi, lane - 32);
                if (quad >= 2) { Hi = Ai * h2 + Hi; Ai = a2 * Ai; }
            }
            float Ae = shf(Ai, lane - 16), He = shf(Hi, lane - 16);
            if (quad == 0) { Ae = 1.f; He = 0.f; }
            const float Pin = Am * Ae, Hin = Ae * Hm + He;
#pragma unroll
            for (int j = 0; j < 4; ++j)
                ((unsigned*)xcf)[(16 * m + 4 * quad + j) * 68 + 16 * nt + fr] = pk2(hl[j] + Pl[j] * Hin, Pl[j] * Pin);
            const float A3 = shf(Ai, 48 + fr), H3 = shf(Hi, 48 + fr);
            Hm = A3 * Hm + H3; Am = Am * A3;
        }
        if (quad == 0) {
            ((float*)(p.ws + WS_SUMH))[((size_t)b * NCH + ch) * 512 + c] = Hm;
            ((float*)(p.ws + WS_SUMP))[((size_t)b * NCH + ch) * 512 + c] = Am;
        }
        brC[0] = brN[0]; brC[1] = brN[1]; biC[0] = biN[0]; biC[1] = biN[1]; brvC = brvN; bivC = bivN; spvC = spvN;
    }
    LDS_FENCE();
    {
        const int r = lane >> 3, c8 = lane & 7, cc = n * 64 + c8 * 8;
        bf16_t* hloc = (bf16_t*)(p.ws + WS_HLOC) + (t0 + r) * 512 + cc;
        bf16_t* pc = (bf16_t*)(p.ws + WS_PC) + (t0 + r) * 512 + cc;
#pragma unroll
        for (int it = 0; it < 8; ++it) {
            const u32x4* src = (const u32x4*)(xcf + (it * 8 + r) * 68 + c8 * 8);
            const u32x4 v0 = src[0], v1 = src[1];
            u32x4 hh, pp;
            hh.x = (v0.x & 0xffffu) | (v0.y << 16); hh.y = (v0.z & 0xffffu) | (v0.w << 16); hh.z = (v1.x & 0xffffu) | (v1.y << 16); hh.w = (v1.z & 0xffffu) | (v1.w << 16);
            pp.x = (v0.x >> 16) | (v0.y & 0xffff0000u); pp.y = (v0.z >> 16) | (v0.w & 0xffff0000u); pp.z = (v1.x >> 16) | (v1.y & 0xffff0000u); pp.w = (v1.z >> 16) | (v1.w & 0xffff0000u);
            __builtin_nontemporal_store(hh, (u32x4*)(hloc + (size_t)it * 8 * 512));
            __builtin_nontemporal_store(pp, (u32x4*)(pc + (size_t)it * 8 * 512));
        }
    }
    LDS_FENCE();
}

__device__ __forceinline__ void cmp_block_item(const Params& p, int l, int kv, int bg, int blk32, unsigned char* lds, int tid) {
    const bf16_t* z = (const bf16_t*)(p.ws + WS_Z);
    const int wid = __builtin_amdgcn_readfirstlane(tid >> 6), lane = tid & 63, fr = lane & 15, quad = lane >> 4, b = bg >> 1, g = bg & 1;
    const int i0 = blk32 * 32;
    const bf16_t* w1t = (const bf16_t*)(p.ws + WS_W1T) + (size_t)(l * 2 + kv) * 128 * 2048;
    const int colbase = (kv ? C_VC : C_KC) + g * 64;
    f32x4 acc[8][2];
#pragma unroll
    for (int mt = 0; mt < 8; ++mt) { acc[mt][0] = (f32x4){0.f, 0.f, 0.f, 0.f}; acc[mt][1] = (f32x4){0.f, 0.f, 0.f, 0.f}; }
    const bf16_t* arow = w1t + lane * 8;
    const int blkA = i0 + fr, blkB = i0 + 16 + fr;
    bf16x8 bAll[8][2];
#pragma unroll
    for (int kq = 0; kq < 8; ++kq) {
        const int kk = wid * 8 + kq;
        const int j = kk >> 1, d = 32 * (kk & 1) + 8 * quad;
        int tokA = 16 * blkA + j, tokB = 16 * blkB + j;
        tokA = tokA < SEQ ? tokA : SEQ - 1; tokB = tokB < SEQ ? tokB : SEQ - 1;
        bAll[kq][0] = *(const bf16x8*)(z + ((size_t)b * SEQ + tokA) * ZW + colbase + d);
        bAll[kq][1] = *(const bf16x8*)(z + ((size_t)b * SEQ + tokB) * ZW + colbase + d);
    }
    auto lda = [&](int kq, bf16x8 (&af)[8]) {
        const int kk = wid * 8 + kq;
#pragma unroll
        for (int mt = 0; mt < 8; ++mt) af[mt] = *(const bf16x8*)(arow + (size_t)(mt * 64 + kk) * 512);
    };
    {
        bf16x8 a0[8], a1[8];
        lda(0, a0);
#pragma unroll
        for (int kq = 0; kq < 8; ++kq) {
            if (kq + 1 < 8) lda(kq + 1, a1);
            __builtin_amdgcn_sched_barrier(0);
#pragma unroll
            for (int mt = 0; mt < 8; ++mt) {
                acc[mt][0] = MFMA16(a0[mt], bAll[kq][0], acc[mt][0]);
                acc[mt][1] = MFMA16(a0[mt], bAll[kq][1], acc[mt][1]);
            }
            __builtin_amdgcn_sched_barrier(0);
#pragma unroll
            for (int mt = 0; mt < 8; ++mt) a0[mt] = a1[mt];
        }
    }
    __syncthreads();
    f32x4* red = (f32x4*)lds;
#pragma unroll
    for (int mt = 0; mt < 8; ++mt) { red[((wid * 8 + mt) * 2 + 0) * 64 + lane] = acc[mt][0]; red[((wid * 8 + mt) * 2 + 1) * 64 + lane] = acc[mt][1]; }
    __syncthreads();
    {
        const float* b1p = (const float*)(p.ws + WS_B1) + (size_t)(l * 2 + kv) * 16 * 128 + 16 * wid + 4 * quad;
        float b1[4] = {0.f, 0.f, 0.f, 0.f};
#pragma unroll
        for (int ks = 0; ks < 16; ++ks) { const f32x4 v = *(const f32x4*)(b1p + ks * 128); b1[0] += v.x; b1[1] += v.y; b1[2] += v.z; b1[3] += v.w; }
        unsigned char* hid = lds + 131072;
#pragma unroll
        for (int ct = 0; ct < 2; ++ct) {
            f32x4 sum = red[((0 * 8 + wid) * 2 + ct) * 64 + lane];
#pragma unroll
            for (int w2 = 1; w2 < 8; ++w2) sum += red[((w2 * 8 + wid) * 2 + ct) * 64 + lane];
            u32x2 w; w.x = pk2(siluf_(sum.x + b1[0]), siluf_(sum.y + b1[1])); w.y = pk2(siluf_(sum.z + b1[2]), siluf_(sum.w + b1[3]));
            *(u32x2*)(hid + ((((ct * 4 + (wid >> 1)) * 16 + fr) * 4 + quad) * 16) + (wid & 1) * 8) = w;
        }
    }
    __syncthreads();
    const int ct = wid & 1, dt = wid >> 1;
    f32x4 o = (f32x4){0.f, 0.f, 0.f, 0.f};
    {
        const bf16_t* w2p = (const bf16_t*)(p.ws + WS_W2P) + (size_t)(l * 2 + kv) * 8192;
        const unsigned char* hid = lds + 131072;
#pragma unroll
        for (int s = 0; s < 4; ++s) {
            const bf16x8 a = *(const bf16x8*)(w2p + ((((s * 4 + dt) * 16 + fr) * 4 + quad) * 8));
            const bf16x8 hf = *(const bf16x8*)(hid + ((((ct * 4 + s) * 16 + fr) * 4 + quad) * 16));
            o = MFMA16(a, hf, o);
        }
    }
    float* ssb = (float*)lds;
    {
        float ss = o.x * o.x + o.y * o.y + o.z * o.z + o.w * o.w;
        ss += shf(ss, lane ^ 16); ss += shf(ss, lane ^ 32);
        if (quad == 0) ssb[(ct * 4 + dt) * 16 + fr] = ss;
    }
    __syncthreads();
    const int blk = i0 + 16 * ct + fr;
    const bool valid = blk < 511;
    if (kv == 0) {
        const float ss = ssb[(ct * 4 + 0) * 16 + fr] + ssb[(ct * 4 + 1) * 16 + fr] + ssb[(ct * 4 + 2) * 16 + fr] + ssb[(ct * 4 + 3) * 16 + fr];
        const float rinv = 1.0f / sqrtf(ss * (1.0f / 64.0f) + EPS);
        const float* kg = p.k_g + (l * 3 + 0) * 64 + 16 * dt + 4 * quad;
        float v[4] = {o.x * rinv * kg[0], o.y * rinv * kg[1], o.z * rinv * kg[2], o.w * rinv * kg[3]};
        if (dt == 0) {
            const int pos = 16 * (valid ? blk : 0) + 31;
            const float* rp = (const float*)(p.ws + WS_ROPE) + pos * 16;
#pragma unroll
            for (int j = 0; j < 4; ++j) {
                const float own = v[j], oth = shf(own, lane ^ 32);
                const int i = 4 * (quad & 1) + j;
                const float cs = rp[i], sn = rp[8 + i];
                v[j] = (quad < 2) ? (own * cs - oth * sn) : (own * cs + oth * sn);
            }
        }
        u32x2 w; w.x = valid ? pk2(v[0], v[1]) : 0u; w.y = valid ? pk2(v[2], v[3]) : 0u;
        *(u32x2*)((bf16_t*)(p.ws + WS_KC) + ((size_t)bg * 512 + blk) * 64 + 16 * dt + 4 * quad) = w;
    } else {
        bf16_t* dst = (bf16_t*)(p.ws + WS_VCT) + ((size_t)bg * 64 + 16 * dt + 4 * quad) * 512 + blk;
#pragma unroll
        for (int j = 0; j < 4; ++j) dst[(size_t)j * 512] = valid ? f2bf(o[j]) : (bf16_t)0;
    }
}

__device__ __forceinline__ void phase_post(const Params& p, int l, unsigned char* lds) {
    const Ids ids = fresh_ids();
    const int wid = ids.tid >> 6, lane = ids.tid & 63, gw = ids.bid * NWAVE + wid, nw = gridDim.x * NWAVE;
    constexpr int N_CMP = 2 * 8 * 16, N_RG = NB * NCH * 8, N_QKV = (NT / 64) * 8;
    for (int it = ids.bid; it < N_CMP; it += gridDim.x) cmp_block_item(p, l, it & 1, (it >> 1) & 7, it >> 4, lds, ids.tid);
    __syncthreads();
    float* xcf = (float*)(lds + wid * 17408);
    for (int it = gw; it < N_RG + N_QKV; it += nw) {
        if (it < N_RG) { rg_item(p, l, it / (NCH * 8), (it / 8) % NCH, it & 7, xcf, lane); }
        else { const int r = it - N_RG; qkv_item(p, l, r >> 3, 8 + (r & 7), (unsigned char*)xcf, lane); }
    }
}

constexpr int AT_WAVE_OFF = 66560, AT_WAVE_STRIDE = 4352, NCG = 2;
constexpr int AT_OACC = 0, AT_QS = AT_WAVE_OFF + 8 * AT_WAVE_STRIDE, AT_LACC = AT_QS + 32768, AT_SELM = AT_LACC + 1024, AT_QUEUE = AT_SELM + 1024, AT_END = AT_QUEUE + 16;
__device__ __forceinline__ int kswz(int row) { return ((row >> 1) & 1) | (((row >> 3) & 3) << 1); }

struct AttnCtx {
    int c, quad, lane, wid, tid;
    int tq0;
    int kb0, kb1, vb0, vb1;
    int ksrc, vsrc, vrow;
    bf16x8 qf[NCG][2];
};

#define AT_LAS __attribute__((address_space(3)))
__device__ __forceinline__ void stage_issue(const AttnCtx& a, AT_LAS unsigned char* ldsb, int bufoff, const bf16_t* Kb, const bf16_t* Vt, int NK, int kb) {
    const int wv = __builtin_amdgcn_readfirstlane(a.wid);
    if (NK == 0) {
        const size_t o = (size_t)(kb >> 6) * 4096 + wv * 512 + a.lane * 8;
        __builtin_amdgcn_global_load_lds((const unsigned*)(Kb + o), (AT_LAS unsigned*)(ldsb + bufoff + wv * 1024), 16, 0, 0);
        __builtin_amdgcn_global_load_lds((const unsigned*)(Vt + o), (AT_LAS unsigned*)(ldsb + bufoff + 8192 + wv * 1024), 16, 0, 0);
        return;
    }
    __builtin_amdgcn_global_load_lds((const unsigned*)(Kb + (size_t)kb * 64 + a.ksrc), (AT_LAS unsigned*)(ldsb + bufoff + wv * 1024), 16, 0, 0);
    __builtin_amdgcn_global_load_lds((const unsigned*)(Vt + (size_t)a.vrow * NK + kb + a.vsrc), (AT_LAS unsigned*)(ldsb + bufoff + 8192 + wv * 1024), 16, 0, 0);
}
__device__ __forceinline__ void stage_wait_barrier(int rem) {
    if (rem >= 2) asm volatile("s_waitcnt vmcnt(4)" ::: "memory");
    else if (rem == 1) asm volatile("s_waitcnt vmcnt(2)" ::: "memory");
    else asm volatile("s_waitcnt vmcnt(0)" ::: "memory");
    asm volatile("s_waitcnt lgkmcnt(0)" ::: "memory");
    __builtin_amdgcn_s_barrier();
    asm volatile("" ::: "memory");
}
template <class KBF, class BODY, class NEXT>
__device__ __forceinline__ int tile_stream(const AttnCtx& a, unsigned char* lds, int nt, const bf16_t* Ksrc, const bf16_t* Vsrc, int NK, KBF kbf, BODY body,
                                           int base, bool primed, NEXT next) {
    AT_LAS unsigned char* ldsb = (AT_LAS unsigned char*)lds;
    if (!primed) {
        asm volatile("s_waitcnt lgkmcnt(0)" ::: "memory"); __builtin_amdgcn_s_barrier(); asm volatile("" ::: "memory");
        if (nt > 0) stage_issue(a, ldsb, (base & 1) * 32768, Ksrc, Vsrc, NK, kbf(0));
        if (nt > 1) stage_issue(a, ldsb, (base & 1) * 32768 + 16384, Ksrc, Vsrc, NK, kbf(1));
    }
    const int np = (nt + 1) >> 1;
    for (int P = 0; P < np; ++P) {
        stage_wait_barrier(0);
        const int nb = 2 * P + 2, sb = ((P + 1 + base) & 1) * 32768;
        if (nb < nt) stage_issue(a, ldsb, sb, Ksrc, Vsrc, NK, kbf(nb));
        if (nb + 1 < nt) stage_issue(a, ldsb, sb + 16384, Ksrc, Vsrc, NK, kbf(nb + 1));
        if (P + 1 == np) next(sb);
#pragma unroll 1
        for (int h = 0; h < 2; ++h) {
            const int i = 2 * P + h;
            if (i < nt) body(lds + ((P + base) & 1) * 32768 + h * 16384, i);
        }
    }
    return (base + np) & 1;
}
template <class KBF, class BODY>
__device__ __forceinline__ void tile_stream(const AttnCtx& a, unsigned char* lds, int nt, const bf16_t* Ksrc, const bf16_t* Vsrc, int NK, KBF kbf, BODY body) {
    (void)tile_stream(a, lds, nt, Ksrc, Vsrc, NK, kbf, body, 0, false, [](int) {});
}

template <bool DO_PV, bool IMP, int MM>
__device__ __forceinline__ void tile_step(const AttnCtx& a, const unsigned char* buf, int st, int kabs  ,
                                          unsigned act  , f32x4 (&O)[4][NCG], f32x4 (&L)[NCG],
                                          unsigned selbits  , float mb, float (&imp3)[NCG][3]) {
    bf16x8 kf[2][2];
#pragma unroll
    for (int T = 0; T < 2; ++T) {
        kf[T][0] = *(const bf16x8*)(buf + a.kb0 + st * 4096 + T * 512);
        kf[T][1] = *(const bf16x8*)(buf + a.kb1 + st * 4096 + T * 512);
    }
    bf16x8 vf[4];
    if (DO_PV) {
#pragma unroll
        for (int dt = 0; dt < 4; ++dt) vf[dt] = *(const bf16x8*)(buf + (st ? a.vb1 : a.vb0) + dt * 2048);
    }
    const int k0 = kabs + 8 * a.quad;
    const bf16x8 ones = {(short)0x3F80, (short)0x3F80, (short)0x3F80, (short)0x3F80, (short)0x3F80, (short)0x3F80, (short)0x3F80, (short)0x3F80};
#pragma unroll
    for (int cg = 0; cg < NCG; ++cg) {
        if (!((act >> cg) & 1u)) continue;
        const f32x4 c0 = (f32x4){-mb, -mb, -mb, -mb};
        f32x4 s0 = MFMA16(kf[0][0], a.qf[cg][0], c0);
        f32x4 s1 = MFMA16(kf[1][0], a.qf[cg][0], c0);
        s0 = MFMA16(kf[0][1], a.qf[cg][1], s0);
        s1 = MFMA16(kf[1][1], a.qf[cg][1], s1);
        const int tq = a.tq0 + 4 * cg;
        int hi = tq, lo = -1;
        if (MM == 1) lo = tq - 512;
        if (MM == 4) hi = ((tq + 1) >> 4) - 2;
        const bool sel = (selbits >> cg) & 1u;
        float pv[8];
#pragma unroll
        for (int e = 0; e < 8; ++e) {
            float v = __builtin_amdgcn_exp2f((e < 4) ? s0[e & 3] : s1[e & 3]);
            if (MM == 1) { const int k = k0 + e; v = (k > lo && k <= hi) ? v : 0.f; }
            if (MM == 3 || MM == 4) { const int k = k0 + e; v = (k <= hi) ? v : 0.f; }
            if (MM == 2) v = sel ? v : 0.f;
            pv[e] = v;
        }
        if (IMP) {
            imp3[cg][0] = pv[0] + pv[1] + pv[2] + 0.5f * pv[3];
            imp3[cg][1] = pv[4] + pv[5] + pv[6] + 0.5f * pv[7] + 0.5f * pv[3];
            imp3[cg][2] = 0.5f * pv[7];
        }
        u32x4 w; w.x = pk2(pv[0], pv[1]); w.y = pk2(pv[2], pv[3]); w.z = pk2(pv[4], pv[5]); w.w = pk2(pv[6], pv[7]);
        const bf16x8 pf = as_bf16x8(w);
        L[cg] = MFMA16(ones, pf, L[cg]);
        if (DO_PV) {
#pragma unroll
            for (int dt = 0; dt < 4; ++dt) O[dt][cg] = MFMA16(vf[dt], pf, O[dt][cg]);
        }
    }
}

template <bool DO_PV, bool IMP, int MM, int CGM>
__device__ __forceinline__ void tile_compute(const AttnCtx& a, const bf16x8 (&kf)[2][2][2], const bf16x8 (&vf)[2][4], int kabs  ,
                                             f32x4 (&O)[4][NCG], f32x4 (&L)[NCG], unsigned selbits, float mb, float (&imp3)[2][NCG][3]) {
    const bf16x8 ones = {(short)0x3F80, (short)0x3F80, (short)0x3F80, (short)0x3F80, (short)0x3F80, (short)0x3F80, (short)0x3F80, (short)0x3F80};
    const f32x4 c0 = (f32x4){-mb, -mb, -mb, -mb};
    f32x4 sc[2][NCG][2];
#pragma unroll
    for (int st = 0; st < 2; ++st)
#pragma unroll
        for (int cg = 0; cg < NCG; ++cg) {
            if (!((CGM >> cg) & 1)) continue;
            sc[st][cg][0] = MFMA16(kf[st][0][0], a.qf[cg][0], c0);
            sc[st][cg][1] = MFMA16(kf[st][1][0], a.qf[cg][0], c0);
        }
#pragma unroll
    for (int st = 0; st < 2; ++st)
#pragma unroll
        for (int cg = 0; cg < NCG; ++cg) {
            if (!((CGM >> cg) & 1)) continue;
            sc[st][cg][0] = MFMA16(kf[st][0][1], a.qf[cg][1], sc[st][cg][0]);
            sc[st][cg][1] = MFMA16(kf[st][1][1], a.qf[cg][1], sc[st][cg][1]);
        }
    bf16x8 pf[2][NCG];
#pragma unroll
    for (int st = 0; st < 2; ++st)
#pragma unroll
        for (int cg = 0; cg < NCG; ++cg) {
            if (!((CGM >> cg) & 1)) continue;
            const int k0 = kabs + 32 * st + 8 * a.quad;
            const int tq = a.tq0 + 4 * cg;
            int hi = tq, lo = -1;
            if (MM == 1) lo = tq - 512;
            if (MM == 4) hi = ((tq + 1) >> 4) - 2;
            const bool sel = (selbits >> cg) & 1u;
            float pv[8];
#pragma unroll
            for (int e = 0; e < 8; ++e) {
                float v = __builtin_amdgcn_exp2f(sc[st][cg][e >> 2][e & 3]);
                if (MM == 1) { const int k = k0 + e; v = (k > lo && k <= hi) ? v : 0.f; }
                if (MM == 3 || MM == 4) { const int k = k0 + e; v = (k <= hi) ? v : 0.f; }
                if (MM == 2) v = sel ? v : 0.f;
                pv[e] = v;
            }
            if (IMP) {
                imp3[st][cg][0] = pv[0] + pv[1] + pv[2] + 0.5f * pv[3];
                imp3[st][cg][1] = pv[4] + pv[5] + pv[6] + 0.5f * pv[7] + 0.5f * pv[3];
                imp3[st][cg][2] = 0.5f * pv[7];
            }
            u32x4 w; w.x = pk2(pv[0], pv[1]); w.y = pk2(pv[2], pv[3]); w.z = pk2(pv[4], pv[5]); w.w = pk2(pv[6], pv[7]);
            pf[st][cg] = as_bf16x8(w);
        }
#pragma unroll
    for (int st = 0; st < 2; ++st)
#pragma unroll
        for (int cg = 0; cg < NCG; ++cg) {
            if (!((CGM >> cg) & 1)) continue;
            L[cg] = MFMA16(ones, pf[st][cg], L[cg]);
            if (DO_PV) {
#pragma unroll
                for (int dt = 0; dt < 4; ++dt) O[dt][cg] = MFMA16(vf[st][dt], pf[st][cg], O[dt][cg]);
            }
        }
}

template <bool DO_PV, bool IMP, int MM, int CGM>
__device__ __forceinline__ void tile_full(const AttnCtx& a, const unsigned char* buf, int kabs, f32x4 (&O)[4][NCG], f32x4 (&L)[NCG], unsigned selbits, float mb,
                                          float (&imp3)[2][NCG][3]) {
    bf16x8 kf[2][2][2], vf[2][4];
#pragma unroll
    for (int st = 0; st < 2; ++st)
#pragma unroll
        for (int T = 0; T < 2; ++T) {
            kf[st][T][0] = *(const bf16x8*)(buf + a.kb0 + st * 4096 + T * 512);
            kf[st][T][1] = *(const bf16x8*)(buf + a.kb1 + st * 4096 + T * 512);
        }
    if (DO_PV) {
#pragma unroll
        for (int dt = 0; dt < 4; ++dt) { vf[0][dt] = *(const bf16x8*)(buf + a.vb0 + dt * 2048); vf[1][dt] = *(const bf16x8*)(buf + a.vb1 + dt * 2048); }
    }
    tile_compute<DO_PV, IMP, MM, CGM>(a, kf, vf, kabs, O, L, selbits, mb, imp3);
}
template <bool DO_PV, bool IMP, int MM, int CGM>
__device__ __forceinline__ void tile_full_tiled(const AttnCtx& a, const unsigned char* buf, int kabs, f32x4 (&O)[4][NCG], f32x4 (&L)[NCG], unsigned selbits, float mb,
                                                float (&imp3)[2][NCG][3]) {
    bf16x8 kf[2][2][2], vf[2][4];
    const unsigned char* bl = buf + a.lane * 16;
#pragma unroll
    for (int st = 0; st < 2; ++st) {
#pragma unroll
        for (int T = 0; T < 2; ++T) { kf[st][T][0] = *(const bf16x8*)(bl + ((st * 2 + T) * 2 + 0) * 1024); kf[st][T][1] = *(const bf16x8*)(bl + ((st * 2 + T) * 2 + 1) * 1024); }
#pragma unroll
        for (int dt = 0; dt < 4; ++dt) vf[st][dt] = *(const bf16x8*)(bl + 8192 + (st * 4 + dt) * 1024);
    }
    tile_compute<DO_PV, IMP, MM, CGM>(a, kf, vf, kabs, O, L, selbits, mb, imp3);
}
__device__ __forceinline__ void frags_tiled(const AttnCtx& a, const bf16_t* Kt, const bf16_t* Vtt, int tile, bf16x8 (&kf)[2][2][2], bf16x8 (&vf)[2][4]) {
    const bf16_t* kp = Kt + (size_t)tile * 4096 + a.lane * 8;
    const bf16_t* vp = Vtt + (size_t)tile * 4096 + a.lane * 8;
#pragma unroll
    for (int st = 0; st < 2; ++st) {
#pragma unroll
        for (int T = 0; T < 2; ++T) { kf[st][T][0] = *(const bf16x8*)(kp + ((st * 2 + T) * 2 + 0) * 512); kf[st][T][1] = *(const bf16x8*)(kp + ((st * 2 + T) * 2 + 1) * 512); }
#pragma unroll
        for (int dt = 0; dt < 4; ++dt) vf[st][dt] = *(const bf16x8*)(vp + (st * 4 + dt) * 512);
    }
}
__device__ __forceinline__ void frags_global(const AttnCtx& a, const bf16_t* Kb, const bf16_t* Vt, int kb, bf16x8 (&kf)[2][2][2], bf16x8 (&vf)[2][4]) {
#pragma unroll
    for (int st = 0; st < 2; ++st) {
#pragma unroll
        for (int T = 0; T < 2; ++T) {
            const bf16_t* kp = Kb + (size_t)(kb + 32 * st + (a.c >> 2) * 8 + T * 4 + (a.c & 3)) * 64 + 8 * a.quad;
            kf[st][T][0] = *(const bf16x8*)kp; kf[st][T][1] = *(const bf16x8*)(kp + 32);
        }
#pragma unroll
        for (int dt = 0; dt < 4; ++dt) vf[st][dt] = *(const bf16x8*)(Vt + (size_t)(16 * dt + a.c) * SEQ + kb + 32 * st + 8 * a.quad);
    }
}

typedef __fp16 h2v_ __attribute__((ext_vector_type(2)));
__device__ __forceinline__ unsigned pkh2(float lo, float hi) { return __builtin_bit_cast(unsigned, __builtin_amdgcn_cvt_pkrtz(lo, hi)); }
__device__ __forceinline__ float h2lo(unsigned u) { return (float)__builtin_bit_cast(h2v_, u)[0]; }
__device__ __forceinline__ float h2hi(unsigned u) { return (float)__builtin_bit_cast(h2v_, u)[1]; }
__device__ __forceinline__ float dpp_swap1(float v) {
    return __builtin_bit_cast(float, __builtin_amdgcn_mov_dpp(__builtin_bit_cast(int, v), 0xB1, 0xF, 0xF, true));
}
__device__ __forceinline__ float dpp_quad_sum(float v) {
    int x = __builtin_bit_cast(int, v);
    float t = v + __builtin_bit_cast(float, __builtin_amdgcn_mov_dpp(x, 0xB1, 0xF, 0xF, true));
    x = __builtin_bit_cast(int, t);
    return t + __builtin_bit_cast(float, __builtin_amdgcn_mov_dpp(x, 0x4E, 0xF, 0xF, true));
}

__device__ __forceinline__ void attn_block_item(const Params& p, int l, int bg, int qi, unsigned char* lds, int tid, bool primed_c, bool prime_next, int& sbase) {
    asm volatile("" : "+v"(tid));
    const bf16_t* z = (const bf16_t*)(p.ws + WS_Z);
    AttnCtx a;
    a.tid = tid; a.wid = tid >> 6; a.lane = tid & 63; a.c = a.lane & 15; a.quad = a.lane >> 4;
    const int b = bg >> 1, g = bg & 1, s0 = qi * 64, sw = s0 + 8 * a.wid, hd = a.c & 3;
    float* wl = (float*)(lds + AT_WAVE_OFF + a.wid * AT_WAVE_STRIDE);
    unsigned short* selm = (unsigned short*)(lds + AT_SELM) + a.wid * 64;
    a.tq0 = sw + (a.c >> 2);
    {
        const int swc = ((a.c >> 1) & 1) | ((a.c >> 2) << 1);
        const int rowb = (a.c >> 2) * 1024 + (a.c & 3) * 128;
        a.kb0 = rowb + ((a.quad ^ swc) << 4); a.kb1 = rowb + (((4 + a.quad) ^ swc) << 4);
        const int swv = (a.c >> 1) & 7;
        a.vb0 = 8192 + a.c * 128 + ((a.quad ^ swv) << 4); a.vb1 = 8192 + a.c * 128 + (((4 + a.quad) ^ swv) << 4);
        const int row = tid >> 3, cp = tid & 7;
        a.ksrc = row * 64 + ((cp ^ kswz(row)) << 3); a.vrow = row; a.vsrc = (cp ^ ((row >> 1) & 7)) << 3;
        asm volatile("" : "+v"(a.kb0), "+v"(a.kb1), "+v"(a.vb0), "+v"(a.vb1), "+v"(a.ksrc), "+v"(a.vsrc));
    }
#define TROW(cg) ((size_t)b * SEQ + (size_t)(a.tq0 + 4 * (cg)))
    {
        const float* qg = p.q_g + l * 64 + 8 * a.quad;
        const f32x4 g0 = *(const f32x4*)qg, g1 = *(const f32x4*)(qg + 4), g2 = *(const f32x4*)(qg + 32), g3 = *(const f32x4*)(qg + 36);
        const float gg[16] = {g0.x, g0.y, g0.z, g0.w, g1.x, g1.y, g1.z, g1.w, g2.x, g2.y, g2.z, g2.w, g3.x, g3.y, g3.z, g3.w};
#pragma unroll
        for (int cg = 0; cg < NCG; ++cg) {
            const bf16_t* qp = z + TROW(cg) * ZW + C_Q + (4 * g + hd) * 64 + 8 * a.quad;
            const u32x4 r0 = *(const u32x4*)qp, r1 = *(const u32x4*)(qp + 32);
            const f32x4* rp = (const f32x4*)((const float*)(p.ws + WS_ROPE) + (a.tq0 + 4 * cg) * 16);
            const f32x4 c0 = rp[0], c1 = rp[1], s0 = rp[2], s1 = rp[3];
            const unsigned rw[8] = {r0.x, r0.y, r0.z, r0.w, r1.x, r1.y, r1.z, r1.w};
            float v[16];
#pragma unroll
            for (int i = 0; i < 8; ++i) { v[2 * i] = bflo(rw[i]); v[2 * i + 1] = bfhi(rw[i]); }
            float ss = 0.f;
#pragma unroll
            for (int i = 0; i < 16; ++i) ss += v[i] * v[i];
            ss += shf(ss, a.lane ^ 16); ss += shf(ss, a.lane ^ 32);
            const float rinv = (1.0f / sqrtf(ss * (1.0f / 64.0f) + EPS)) * (0.125f * LOG2E);
#pragma unroll
            for (int i = 0; i < 16; ++i) v[i] = v[i] * rinv * gg[i];
            const float cs[8] = {c0.x, c0.y, c0.z, c0.w, c1.x, c1.y, c1.z, c1.w};
            const float sn[8] = {s0.x, s0.y, s0.z, s0.w, s1.x, s1.y, s1.z, s1.w};
#pragma unroll
            for (int i = 0; i < 8; ++i) {
                const float oth = shf(v[i], a.lane ^ 16);
                const float rot = (a.quad == 0) ? v[i] * cs[i] - oth * sn[i] : v[i] * cs[i] + oth * sn[i];
                v[i] = (a.quad < 2) ? rot : v[i];
            }
            u32x4 w0, w1;
            w0.x = pk2(v[0], v[1]); w0.y = pk2(v[2], v[3]); w0.z = pk2(v[4], v[5]); w0.w = pk2(v[6], v[7]);
            w1.x = pk2(v[8], v[9]); w1.y = pk2(v[10], v[11]); w1.z = pk2(v[12], v[13]); w1.w = pk2(v[14], v[15]);
            a.qf[cg][0] = as_bf16x8(w0); a.qf[cg][1] = as_bf16x8(w1);
        }
    }
    float gv[NCG];
#pragma unroll
    for (int cg = 0; cg < NCG; ++cg) gv[cg] = sigmoidf_(bf2f(z[TROW(cg) * ZW + C_BG + 12 * g + 3 * hd + (a.quad < 2 ? a.quad : 2)]));
#define GATE(cg, br) shf(gv[cg], a.c + 16 * (br))
    const float* mbp = (const float*)(p.ws + WS_MB) + l * 4;
    f32x4 O[4][NCG], L[NCG];
    float invl[NCG], imp3[2][NCG][3];
    AT_LAS unsigned char* ldsb = (AT_LAS unsigned char*)lds;
#define ZERO_ACC() { _Pragma("unroll") for (int h_ = 0; h_ < NCG; ++h_) L[h_] = (f32x4){0.f, 0.f, 0.f, 0.f}; \
                     _Pragma("unroll") for (int dt_ = 0; dt_ < 4; ++dt_) _Pragma("unroll") for (int h_ = 0; h_ < NCG; ++h_) O[dt_][h_] = (f32x4){0.f, 0.f, 0.f, 0.f}; }
    {
        const bf16_t* kc = (const bf16_t*)(p.ws + WS_KC) + (size_t)bg * 512 * 64;
        const bf16_t* vct = (const bf16_t*)(p.ws + WS_VCT) + (size_t)bg * 64 * 512;
        const int nmax_b = ((s0 + 64) >> 4) - 1;
        const int nct = (nmax_b + 63) >> 6;
        const int nmax_w = ((sw + 8) >> 4) - 1;
        const int nmin_w = ((sw + 1) >> 4) - 1;
        const float mb_c = mbp[0];
        const float isc = __builtin_amdgcn_exp2f(fminf(floorf(mb_c) - 2.0f, 100.0f));
        unsigned* rawp = (unsigned*)((hd < 2) ? (unsigned char*)wl : lds + AT_QS + a.wid * 4096);
        ZERO_ACC();
        float co_prev[NCG] = {0.f, 0.f};
        (void)tile_stream(a, lds, nct, kc, vct, 512, [](int i) { return i * 64; }, [&](const unsigned char* buf, int i_) {
            const int kb = i_ * 64;
            if (kb < nmax_w) {
                if (kb + 63 >= nmin_w) tile_full<true, true, 4, 3>(a, buf, kb, O, L, 0u, mb_c, imp3);
                else tile_full<true, true, 0, 3>(a, buf, kb, O, L, 0u, mb_c, imp3);
#pragma unroll
                for (int st = 0; st < 2; ++st) {
                    const int j0 = ((kb + 32 * st) >> 2) + 2 * a.quad;
#pragma unroll
                    for (int cg = 0; cg < NCG; ++cg) {
                        float X0 = imp3[st][cg][0], X1 = imp3[st][cg][1];
                        const float co = imp3[st][cg][2];
                        const float send = (a.quad == 3) ? co_prev[cg] : co;
                        X0 += shf(send, (a.lane + 48) & 63);
                        co_prev[cg] = co;
                        X0 *= isc; X1 *= isc;
                        const float Y0 = dpp_swap1(X0), Y1 = dpp_swap1(X1);
                        if (!(hd & 1)) { const int q = 4 * cg + (a.c >> 2); rawp[j0 * 8 + q] = pkh2(X0, Y0); rawp[(j0 + 1) * 8 + q] = pkh2(X1, Y1); }
                    }
                }
            }
        }, sbase, primed_c, [](int) {});
#pragma unroll
        for (int cg = 0; cg < NCG; ++cg) {
            invl[cg] = L[cg].x > 0.f ? 1.0f / L[cg].x : 0.f;
            if (a.quad == 0) wl[1024 + (4 * cg + (a.c >> 2)) * 4 + hd] = invl[cg];
        }
    }
    LDS_FENCE();
    const int bt = s0 >> 6;
    {
        const int q = a.lane & 7, part = a.lane >> 3;
        unsigned mymask = 0u;
        if (bt >= 16) {
            unsigned key[16];
            const unsigned* r01 = (const unsigned*)wl + (16 * part) * 8 + q;
            const unsigned* r23 = (const unsigned*)(lds + AT_QS + a.wid * 4096) + (16 * part) * 8 + q;
            const f32x4 il = *(const f32x4*)(wl + 1024 + q * 4);
            const int ilo = 1 - 16 * part, ihi = bt - 2 - 16 * part, jrev = 127 - 16 * part;
#pragma unroll
            for (int i = 0; i < 16; ++i) {
                const unsigned u0 = r01[i * 8], u1 = r23[i * 8];
                const unsigned bits = __float_as_uint((h2lo(u0) * il.x + h2hi(u0) * il.y) + (h2lo(u1) * il.z + h2hi(u1) * il.w));
                key[i] = (i >= ilo && i <= ihi) ? ((bits & ~127u) | (unsigned)(jrev - i)) : 0u;
            }
            for (int it = 0; it < 13; ++it) {
                unsigned m = 0u;
#pragma unroll
                for (int i = 0; i < 16; ++i) m = key[i] > m ? key[i] : m;
                { const unsigned o = (unsigned)__builtin_amdgcn_update_dpp(0, (int)m, 0x128, 0xF, 0xF, false); m = o > m ? o : m; }
                { const auto r = __builtin_amdgcn_permlane16_swap(m, m, false, false); m = r[0] > r[1] ? r[0] : r[1]; }
                { const auto r = __builtin_amdgcn_permlane32_swap(m, m, false, false); m = r[0] > r[1] ? r[0] : r[1]; }
                const int jsel = 127 - (int)(m & 127u);
                if ((jsel >> 4) == part) mymask |= 1u << (jsel & 15);
#pragma unroll
                for (int i = 0; i < 16; ++i) key[i] = (key[i] == m) ? 0u : key[i];
            }
            if (part == 0) mymask |= 1u;
            if (((bt - 1) >> 4) == part) mymask |= 1u << ((bt - 1) & 15);
            if ((bt >> 4) == part) mymask |= 1u << (bt & 15);
        } else {
            if (part == 0) mymask = (2u << bt) - 1u;
        }
        selm[q * 8 + part] = (unsigned short)mymask;
    }
    LDS_FENCE();
#define PARK_ADDR(cg, dt) ((unsigned char*)wl + (16 * (cg) + a.c) * 128 + (((4 * (dt) + a.quad) ^ (((16 * (cg) + a.c) >> 1) & 7)) << 3))
#pragma unroll
    for (int cg = 0; cg < NCG; ++cg) {
        const float gc = GATE(cg, 0) * invl[cg];
#pragma unroll
        for (int dt = 0; dt < 4; ++dt) {
            u32x2 w; w.x = pk2(gc * O[dt][cg].x, gc * O[dt][cg].y); w.y = pk2(gc * O[dt][cg].z, gc * O[dt][cg].w);
            *(u32x2*)PARK_ADDR(cg, dt) = w;
        }
    }
    const bf16_t* kwb = (const bf16_t*)(p.ws + WS_KW) + (size_t)bg * SEQ * 64;
    const bf16_t* vwt = (const bf16_t*)(p.ws + WS_VWT) + (size_t)bg * 64 * SEQ;
    int t0w = s0 - 511; t0w = t0w < 0 ? 0 : t0w; t0w >>= 6;
    const int t1w = (s0 + 63) >> 6;
    auto prime_window = [&](int sb) {
        stage_issue(a, ldsb, sb, kwb, vwt, SEQ, t0w * 64);
        if (t1w > t0w) stage_issue(a, ldsb, sb + 16384, kwb, vwt, SEQ, (t0w + 1) * 64);
    };
    int wbase = 0;
    {
        const bf16_t* ksb = (const bf16_t*)(p.ws + WS_KS) + (size_t)bg * SEQ * 64;
        const bf16_t* vst = (const bf16_t*)(p.ws + WS_VST) + (size_t)bg * 64 * SEQ;
        const float mb_s = mbp[1];
        const bf16_t* ks2 = (const bf16_t*)(p.ws + WS_KS2) + (size_t)bg * SEQ * 64;
        const bf16_t* vs2 = (const bf16_t*)(p.ws + WS_VST2) + (size_t)bg * 64 * SEQ;
        if (bt < 16) {
            ZERO_ACC();
            wbase = tile_stream(a, lds, bt + 1, ks2, vs2, 0, [](int i) { return i * 64; }, [&](const unsigned char* buf, int i_) {
                if (i_ == bt) tile_full_tiled<true, false, 3, 3>(a, buf, i_ * 64, O, L, 3u, mb_s, imp3);
                else tile_full_tiled<true, false, 0, 3>(a, buf, i_ * 64, O, L, 3u, mb_s, imp3);
            }, 0, false, prime_window);
        } else {
            const int wv = __builtin_amdgcn_readfirstlane(a.wid);
            asm volatile("s_waitcnt lgkmcnt(0)" ::: "memory"); __builtin_amdgcn_s_barrier(); asm volatile("" ::: "memory");
#pragma unroll
            for (int cg = 0; cg < NCG; ++cg) {
                const int row = (8 * wv + 4 * cg + (a.c >> 2)) * 4 + hd, qs = ((row >> 1) & 1) | (((row >> 2) & 3) << 1);
                *(bf16x8*)(lds + AT_QS + row * 128 + (((0 + a.quad) ^ qs) << 4)) = a.qf[cg][0];
                *(bf16x8*)(lds + AT_QS + row * 128 + (((4 + a.quad) ^ qs) << 4)) = a.qf[cg][1];
            }
            { u32x4 zz = (u32x4){0u, 0u, 0u, 0u}; asm volatile("" : "+v"(zz));
              for (int i = tid; i < (256 * 65 * 4) / 16; i += NTHR) *(u32x4*)(lds + AT_OACC + i * 16) = zz; }
            if (tid < 256) ((float*)(lds + AT_LACC))[tid] = 0.f;
            if (tid == 0) *(unsigned*)(lds + AT_QUEUE) = 1u;
            asm volatile("s_waitcnt lgkmcnt(0)" ::: "memory"); __builtin_amdgcn_s_barrier(); asm volatile("" ::: "memory");
            {
                const u32x4 mq = *(const u32x4*)(lds + AT_SELM + a.lane * 16);
                const bf16x8 ones = {(short)0x3F00, (short)0x3F00, (short)0x3F00, (short)0x3F00, (short)0x3F00, (short)0x3F00, (short)0x3F00, (short)0x3F00};
                const float cb = 22.0f - mb_s;
                const f32x4 c0 = (f32x4){cb, cb, cb, cb};
                float* oacc = (float*)(lds + AT_OACC);
                float* lacc = (float*)(lds + AT_LACC);
                unsigned* queue = (unsigned*)(lds + AT_QUEUE);
                auto next_blk = [&](unsigned long long& qm) -> int {
                    for (;;) {
                        int j = 0;
                        if (a.lane == 0) j = (int)__hip_atomic_fetch_add(queue, 1u, __ATOMIC_RELAXED, __HIP_MEMORY_SCOPE_WORKGROUP);
                        j = __builtin_amdgcn_readfirstlane(j);
                        if (j > bt - 2) { qm = 0ull; return -1; }
                        const unsigned wsel = (j < 32) ? mq.x : (j < 64) ? mq.y : (j < 96) ? mq.z : mq.w;
                        qm = __ballot((wsel >> (j & 31)) & 1u);
                        if (qm != 0ull) return j;
                    }
                };
                auto groups = [&](const bf16x8 (&kf)[2][2][2], const bf16x8 (&vf)[2][4], unsigned long long qm) {
#pragma unroll 1
                    while (qm != 0ull) {
                        const int q0 = __builtin_ctzll(qm); qm &= qm - 1ull;
                        int q1 = -1, q2 = -1, q3 = -1;
                        if (qm != 0ull) { q1 = __builtin_ctzll(qm); qm &= qm - 1ull; }
                        if (qm != 0ull) { q2 = __builtin_ctzll(qm); qm &= qm - 1ull; }
                        if (qm != 0ull) { q3 = __builtin_ctzll(qm); qm &= qm - 1ull; }
                        const int qi = a.c >> 2;
                        int myq = (qi == 0) ? q0 : (qi == 1) ? q1 : (qi == 2) ? q2 : q3;
                        const bool valid = myq >= 0;
                        myq = valid ? myq : q0;
                        const int row = myq * 4 + hd, qs = ((row >> 1) & 1) | (((row >> 2) & 3) << 1);
                        const unsigned char* qrow = lds + AT_QS + row * 128;
                        const bf16x8 qa = *(const bf16x8*)(qrow + (((0 + a.quad) ^ qs) << 4)), qb = *(const bf16x8*)(qrow + (((4 + a.quad) ^ qs) << 4));
                        f32x4 sa[2][2];
#pragma unroll
                        for (int st = 0; st < 2; ++st)
#pragma unroll
                            for (int T = 0; T < 2; ++T) sa[st][T] = MFMA16(kf[st][T][0], qa, c0);
#pragma unroll
                        for (int st = 0; st < 2; ++st)
#pragma unroll
                            for (int T = 0; T < 2; ++T) sa[st][T] = MFMA16(kf[st][T][1], qb, sa[st][T]);
                        bf16x8 pf[2];
#pragma unroll
                        for (int st = 0; st < 2; ++st) {
                            float pv[8];
#pragma unroll
                            for (int e = 0; e < 8; ++e) pv[e] = __builtin_amdgcn_exp2f(sa[st][e >> 2][e & 3]);
                            u32x4 w; w.x = pk2(pv[0], pv[1]); w.y = pk2(pv[2], pv[3]); w.z = pk2(pv[4], pv[5]); w.w = pk2(pv[6], pv[7]);
                            pf[st] = as_bf16x8(w);
                        }
                        f32x4 Lc = MFMA16(ones, pf[0], ((f32x4){0.f, 0.f, 0.f, 0.f}));
                        Lc = MFMA16(ones, pf[1], Lc);
                        f32x4 Oc[4];
#pragma unroll
                        for (int dt = 0; dt < 4; ++dt) { Oc[dt] = MFMA16(vf[0][dt], pf[0], ((f32x4){0.f, 0.f, 0.f, 0.f})); Oc[dt] = MFMA16(vf[1][dt], pf[1], Oc[dt]); }
                        if (valid) {
                            float* ob = oacc + row * 65 + 4 * a.quad;
#pragma unroll
                            for (int dt = 0; dt < 4; ++dt)
#pragma unroll
                                for (int e = 0; e < 4; ++e) (void)__hip_atomic_fetch_add((int*)(ob + 16 * dt + e), (int)Oc[dt][e], __ATOMIC_RELAXED, __HIP_MEMORY_SCOPE_WORKGROUP);
                            if (a.quad == 0) (void)__hip_atomic_fetch_add((int*)(lacc + row), (int)Lc.x, __ATOMIC_RELAXED, __HIP_MEMORY_SCOPE_WORKGROUP);
                        }
                    }
                };
                bf16x8 kfA[2][2][2], vfA[2][4], kfB[2][2][2], vfB[2][4];
                unsigned long long qmA = 0ull, qmB = 0ull;
                int jA = next_blk(qmA);
                if (jA >= 0) frags_tiled(a, ks2, vs2, jA, kfA, vfA);
#pragma unroll 1
                while (jA >= 0) {
                    const int jB = next_blk(qmB);
                    if (jB >= 0) frags_tiled(a, ks2, vs2, jB, kfB, vfB);
                    groups(kfA, vfA, qmA);
                    if (jB < 0) break;
                    jA = next_blk(qmA);
                    if (jA >= 0) frags_tiled(a, ks2, vs2, jA, kfA, vfA);
                    groups(kfB, vfB, qmB);
                }
            }
            asm volatile("s_waitcnt lgkmcnt(0)" ::: "memory"); __builtin_amdgcn_s_barrier(); asm volatile("" ::: "memory");
            asm volatile("" : "+v"(a.tq0));
#pragma unroll
            for (int cg = 0; cg < NCG; ++cg) {
                const int row = (8 * wv + 4 * cg + (a.c >> 2)) * 4 + hd;
                { const int qs = ((row >> 1) & 1) | (((row >> 2) & 3) << 1);
                  a.qf[cg][0] = *(const bf16x8*)(lds + AT_QS + row * 128 + (((0 + a.quad) ^ qs) << 4));
                  a.qf[cg][1] = *(const bf16x8*)(lds + AT_QS + row * 128 + (((4 + a.quad) ^ qs) << 4)); }
                const int* ob = (const int*)(lds + AT_OACC) + row * 65 + 4 * a.quad;
                const float lv = (float)((const int*)(lds + AT_LACC))[row] * (1.0f / 2097152.0f);
                L[cg] = (f32x4){lv, lv, lv, lv};
#pragma unroll
                for (int dt = 0; dt < 4; ++dt)
#pragma unroll
                    for (int e = 0; e < 4; ++e) O[dt][cg][e] = (float)ob[16 * dt + e] * (1.0f / 4194304.0f);
            }
            wbase = tile_stream(a, lds, 3, ks2, vs2, 0, [bt](int i) { return ((i == 0) ? 0 : bt - 2 + i) * 64; }, [&](const unsigned char* buf, int i_) {
                if (i_ == 2) tile_full_tiled<true, false, 3, 3>(a, buf, bt * 64, O, L, 3u, mb_s, imp3);
                else tile_full_tiled<true, false, 0, 3>(a, buf, ((i_ == 0) ? 0 : bt - 1) * 64, O, L, 3u, mb_s, imp3);
            }, 0, false, prime_window);
        }
#pragma unroll
        for (int cg = 0; cg < NCG; ++cg) {
            const float coef = L[cg].x > 0.f ? GATE(cg, 1) / L[cg].x : 0.f;
#pragma unroll
            for (int dt = 0; dt < 4; ++dt) {
                u32x2* pa = (u32x2*)PARK_ADDR(cg, dt);
                const u32x2 o = *pa;
                u32x2 w;
                w.x = pk2(bflo(o.x) + coef * O[dt][cg].x, bfhi(o.x) + coef * O[dt][cg].y);
                w.y = pk2(bflo(o.y) + coef * O[dt][cg].z, bfhi(o.y) + coef * O[dt][cg].w);
                *pa = w;
            }
        }
    }
    {
        const float mb_w = mbp[2];
        ZERO_ACC();
        {
            const int wv = __builtin_amdgcn_readfirstlane(a.wid);
#pragma unroll
            for (int i = 0; i < 4; ++i) {
                const int r = i * 8 + (a.lane >> 3), ch = a.lane & 7;
                const bf16_t* src = z + ((size_t)b * SEQ + sw + (r >> 2)) * ZW + C_NG + (4 * g + (r & 3)) * 64 + ((ch ^ (r & 7)) << 3);
                __builtin_amdgcn_global_load_lds((const unsigned*)src, (AT_LAS unsigned*)(ldsb + AT_QS + wv * 4096 + i * 1024), 16, 0, 0);
            }
        }
        sbase = tile_stream(a, lds, t1w - t0w + 1, kwb, vwt, SEQ, [t0w](int i) { return (t0w + i) * 64; }, [&](const unsigned char* buf, int i_) {
            const int kb = (t0w + i_) * 64;
            if (kb + 63 > sw - 512 && kb <= sw + 7) {
                if ((kb > sw + 7 - 512) && (kb + 63 <= sw)) tile_full<true, false, 0, 3>(a, buf, kb, O, L, 0u, mb_w, imp3);
                else tile_full<true, false, 1, 3>(a, buf, kb, O, L, 0u, mb_w, imp3);
            }
        }, wbase, true, [&](int sb) {
            if (prime_next) {
                const bf16_t* kc = (const bf16_t*)(p.ws + WS_KC) + (size_t)bg * 512 * 64;
                const bf16_t* vct = (const bf16_t*)(p.ws + WS_VCT) + (size_t)bg * 64 * 512;
                stage_issue(a, ldsb, sb, kc, vct, 512, 0);
                stage_issue(a, ldsb, sb + 16384, kc, vct, 512, 64);
            }
        });
        u32x2 gwv[NCG][4];
        asm volatile("" ::: "memory");
#pragma unroll
        for (int cg = 0; cg < NCG; ++cg) {
            const int row = (4 * cg + (a.c >> 2)) * 4 + hd;
            const unsigned char* ngl = lds + AT_QS + a.wid * 4096 + row * 128 + (a.quad & 1) * 8;
#pragma unroll
            for (int dt = 0; dt < 4; ++dt) gwv[cg][dt] = *(const u32x2*)(ngl + (((2 * dt + (a.quad >> 1)) ^ (row & 7)) << 4));
        }
#pragma unroll
        for (int cg = 0; cg < NCG; ++cg) {
            const float coef = L[cg].x > 0.f ? GATE(cg, 2) / L[cg].x : 0.f;
            bf16_t* yo = (bf16_t*)(p.ws + WS_Y) + TROW(cg) * DM + 512 + (4 * g + hd) * 64 + 4 * a.quad;
#pragma unroll
            for (int dt = 0; dt < 4; ++dt) {
                const u32x2 o = *(const u32x2*)PARK_ADDR(cg, dt);
                const u32x2 gw = gwv[cg][dt];
                float r0 = bflo(o.x) + coef * O[dt][cg].x, r1 = bfhi(o.x) + coef * O[dt][cg].y, r2 = bflo(o.y) + coef * O[dt][cg].z, r3 = bfhi(o.y) + coef * O[dt][cg].w;
                r0 *= siluf_(bflo(gw.x)); r1 *= siluf_(bfhi(gw.x)); r2 *= siluf_(bflo(gw.y)); r3 *= siluf_(bfhi(gw.y));
                u32x2 w; w.x = pk2(r0, r1); w.y = pk2(r2, r3);
                *(u32x2*)(yo + 16 * dt) = w;
            }
        }
    }
    LDS_FENCE();
#undef GATE
#undef TROW
#undef ZERO_ACC
#undef PARK_ADDR
}

template <int NCK>
__device__ __forceinline__ void rgfin_item(const Params& p, int b, int ch, int n, float* wsc  , int lane) {
    const bf16_t* z = (const bf16_t*)(p.ws + WS_Z);
    float hc[NCK];
    {
        const int c = n * 64 + lane;
        const float* sh = (const float*)(p.ws + WS_SUMH) + (size_t)b * NCH * 512 + c;
        const float* sp = (const float*)(p.ws + WS_SUMP) + (size_t)b * NCH * 512 + c;
        float h = 0.f;
        int j = 0;
        for (; j + 32 <= ch; j += 32) {
            float pv[32], hv[32];
#pragma unroll
            for (int u = 0; u < 32; ++u) { pv[u] = sp[(size_t)(j + u) * 512]; hv[u] = sh[(size_t)(j + u) * 512]; }
#pragma unroll
            for (int u = 0; u < 32; ++u) h = pv[u] * h + hv[u];
        }
        {
            float pv[32], hv[32];
#pragma unroll
            for (int u = 0; u < 32; ++u) { const bool ok = j + u < ch; pv[u] = ok ? sp[(size_t)(j + u) * 512] : 1.f; hv[u] = ok ? sh[(size_t)(j + u) * 512] : 0.f; }
#pragma unroll
            for (int u = 0; u < 32; ++u) h = pv[u] * h + hv[u];
        }
        float pn[NCK], hn[NCK];
#pragma unroll
        for (int i = 0; i + 1 < NCK; ++i) { pn[i] = sp[(size_t)(ch + i) * 512]; hn[i] = sh[(size_t)(ch + i) * 512]; }
        hc[0] = h;
#pragma unroll
        for (int i = 0; i + 1 < NCK; ++i) hc[i + 1] = pn[i] * hc[i] + hn[i];
    }
#pragma unroll
    for (int half = 0; half < NCK; ++half, ++ch) {
    wsc[lane] = hc[half];
    LDS_FENCE();
    const int r = lane >> 3, c8 = lane & 7;
    float cr[8];
    { const f32x4 c0 = *(const f32x4*)(wsc + c8 * 8), c1 = *(const f32x4*)(wsc + c8 * 8 + 4); cr[0] = c0.x; cr[1] = c0.y; cr[2] = c0.z; cr[3] = c0.w; cr[4] = c1.x; cr[5] = c1.y; cr[6] = c1.z; cr[7] = c1.w; }
    const size_t t0 = (size_t)b * SEQ + (size_t)ch * 64 + r;
    const int cc = n * 64 + c8 * 8;
    const bf16_t* hl = (const bf16_t*)(p.ws + WS_HLOC) + t0 * 512 + cc;
    const bf16_t* pc = (const bf16_t*)(p.ws + WS_PC) + t0 * 512 + cc;
    const bf16_t* zg = z + t0 * ZW + C_RGG + cc;
    bf16_t* y = (bf16_t*)(p.ws + WS_Y) + t0 * DM + cc;
    u32x4 hwN = *(const u32x4*)hl, pwN = *(const u32x4*)pc, gwN = *(const u32x4*)zg;
#pragma unroll
    for (int it = 0; it < 8; ++it) {
        const u32x4 hw = hwN, pw = pwN, gw = gwN;
        if (it + 1 < 8) {
            hwN = *(const u32x4*)(hl + (size_t)(it + 1) * 8 * 512);
            pwN = *(const u32x4*)(pc + (size_t)(it + 1) * 8 * 512);
            gwN = *(const u32x4*)(zg + (size_t)(it + 1) * 8 * ZW);
        }
        __builtin_amdgcn_sched_barrier(0);
        const unsigned hh[4] = {hw.x, hw.y, hw.z, hw.w}, pp[4] = {pw.x, pw.y, pw.z, pw.w}, gg[4] = {gw.x, gw.y, gw.z, gw.w};
        unsigned o[4];
#pragma unroll
        for (int k = 0; k < 4; ++k) {
            const float v0 = (bflo(hh[k]) + bflo(pp[k]) * cr[2 * k]) * siluf_(bflo(gg[k]));
            const float v1 = (bfhi(hh[k]) + bfhi(pp[k]) * cr[2 * k + 1]) * siluf_(bfhi(gg[k]));
            o[k] = pk2(v0, v1);
        }
        u32x4 ow; ow.x = o[0]; ow.y = o[1]; ow.z = o[2]; ow.w = o[3];
        *(u32x4*)(y + (size_t)it * 8 * DM) = ow;
    }
    LDS_FENCE();
    }
}

__device__ __forceinline__ void phase_attn(const Params& p, int l, unsigned char* lds) {
    const Ids ids = fresh_ids();
    const int wid = ids.tid >> 6, lane = ids.tid & 63, gw = ids.bid * NWAVE + wid, nw = gridDim.x * NWAVE;
    const bool chain = (gridDim.x & 7) == 0;
    int sbase = 0;
    for (int it = ids.bid; it < 1024; it += gridDim.x) {
        const int bg = it & 7, k = it >> 3;
        attn_block_item(p, l, bg, (k < 64) ? 127 - k : k - 64, lds, ids.tid, chain && it != ids.bid, chain && it + (int)gridDim.x < 1024, sbase);
    }
    constexpr int N_RG = NB * NCH * 8;
    float* wsc = (float*)(lds + AT_WAVE_OFF + wid * AT_WAVE_STRIDE);
    if (gridDim.x == 256) {
        const int hw = gw & 1023;
        if (ids.bid < 128) rgfin_item<3>(p, hw / (NCH * 2), 4 * ((hw / 8) % (NCH / 4)), hw & 7, wsc, lane);
        else rgfin_item<1>(p, hw / (NCH * 2), 4 * ((hw / 8) % (NCH / 4)) + 3, hw & 7, wsc, lane);
    }
    else for (int r = gw; r < N_RG / 2; r += nw) rgfin_item<2>(p, r / (NCH * 4), 2 * ((r / 8) % (NCH / 2)), r & 7, wsc, lane);
}

constexpr int LDS_BYTES = NWAVE * 17408;
static_assert(LDS_BYTES >= pg8::STAGE_BYTES && LDS_BYTES >= AT_END && 256 * 65 * 4 <= AT_WAVE_OFF, "lds");

__global__ void __launch_bounds__(512) k_mega(Params p) {
    extern __shared__ __attribute__((aligned(16))) unsigned char lds[];
    unsigned* bar = (unsigned*)(p.ws + WS_BAR);
    volatile unsigned* st = (volatile unsigned*)(lds + LDS_BYTES);
    {
        const Ids ids = fresh_ids();
        if (ids.tid == 0) { st[0] = 0u; st[1] = 0u; (void)xb_add(&bar[XB_XCNT(xb_xcc_id())], 1u); }
    }
    __syncthreads();
    phase_prologue(p, lds);
    grid_barrier(bar, st);
#pragma unroll 1
    for (int l = 0; l < DEPTH; ++l) {
        phase_gemm_in(p, l, lds);
        grid_barrier(bar, st);
        phase_post(p, l, lds);
        grid_barrier(bar, st);
        phase_attn(p, l, lds);
        grid_barrier(bar, st);
        phase_gemm_out(p, l, lds, (l == 0) ? p.x : p.out, p.out);
        if (l + 1 < DEPTH) grid_barrier(bar, st);
    }
}

extern "C" void kernel_launch(void* const* d_in, const int* in_sizes, int n_in, void* d_out, int out_size, void* d_ws, size_t ws_size,
                              hipStream_t stream) {
    static int grid = 0;
    if (grid == 0) {
        if (n_in != 19 || ws_size < WS_END) { fprintf(stderr, "kernel_launch: unexpected n_in %d / ws_size %zu (need %zu)\n", n_in, ws_size, (size_t)WS_END); grid = -1; return; }
        (void)hipFuncSetAttribute((const void*)k_mega, hipFuncAttributeMaxDynamicSharedMemorySize, LDS_BYTES + 16);
        int dev = 0, cus = 0, per_cu = 0;
        (void)hipGetDevice(&dev);
        (void)hipDeviceGetAttribute(&cus, hipDeviceAttributeMultiprocessorCount, dev);
        (void)hipOccupancyMaxActiveBlocksPerMultiprocessor(&per_cu, (const void*)k_mega, NTHR, LDS_BYTES + 16);
        if (per_cu < 1) { fprintf(stderr, "kernel_launch: occupancy query says %d blocks per CU\n", per_cu); grid = -1; return; }
        per_cu = 1;
        grid = cus * per_cu;
    }
    if (grid < 0) return;
    Params p{};
    const float** dst = (const float**)&p;
    for (int i = 0; i < 19; ++i) dst[i] = (const float*)d_in[i];
    p.out = (float*)d_out;
    p.ws = (unsigned char*)d_ws;
    (void)hipMemsetAsync((unsigned char*)d_ws + WS_BAR, 0, 16384, stream);
    hipLaunchKernelGGL(k_mega, dim3(grid), dim3(NTHR), LDS_BYTES + 16, stream, p);
}
```
